# Optimizing an MI355X kernel written in HIP

```python
import math
import jax, jax.numpy as jnp
from jax import lax
import numpy as np

D_MODEL = 1024
BATCH = 16
SEQ = 2048
DEPTH = 2

GRID_W = 64
CTX_LEN = 256
D_BRANCH = D_MODEL // 2
HEAD_DIM = 64
CONV_K = 31
DIFF_D = 64
DIFF_HEADS = D_BRANCH // (2 * DIFF_D)
NAT_HEADS = D_BRANCH // HEAD_DIM
NAT_KR = 8
NAT_KC = 16
N_EXPERTS = 32
TOP_K = 4
D_FF = D_MODEL
SWIGLU_LIMIT = 7.0
SWIGLU_ALPHA = 1.702
ROPE_BASE = 10000.0
Q_BLOCK = 128
LN_EPS = 1e-6
DEEPNORM_ALPHA = (2 * DEPTH) ** 0.25
DEEPNORM_BETA = (8 * DEPTH) ** -0.25
IN_COLS = 2 * D_BRANCH + 3 * D_BRANCH + 3 * D_BRANCH + 3 * D_MODEL

kernel_name = 'hybrid_gated_conv_diffattn_natten_moe_dit'


def layer_norm(x, g=None, b=None):
    xf = x.astype(jnp.float32)
    mu = jnp.mean(xf, axis=-1, keepdims=True)
    var = jnp.mean(jnp.square(xf - mu), axis=-1, keepdims=True)
    y = (xf - mu) * lax.rsqrt(var + LN_EPS)
    if g is not None:
        y = y * g.astype(jnp.float32) + b.astype(jnp.float32)
    return y.astype(x.dtype)


def rms_norm(x, g):
    xf = x.astype(jnp.float32)
    y = xf * lax.rsqrt(jnp.mean(jnp.square(xf), axis=-1, keepdims=True) + LN_EPS)
    return (y * g.astype(jnp.float32)).astype(x.dtype)


def modulate(x, shift, scale):
    return layer_norm(x) * (1.0 + scale) + shift


def axial_rope_angles(n_tokens, dim):
    axis_dim = dim // 2
    inv_freq = ROPE_BASE ** (-jnp.arange(0, axis_dim, 2, dtype=jnp.float32) / axis_dim)
    t = jnp.arange(n_tokens, dtype=jnp.int32)
    row = (t // GRID_W).astype(jnp.float32)
    col = (t % GRID_W).astype(jnp.float32)
    return row[:, None] * inv_freq[None, :], col[:, None] * inv_freq[None, :]


def _rotate(x, ang):
    x1, x2 = jnp.split(x.astype(jnp.float32), 2, axis=-1)
    cos, sin = jnp.cos(ang), jnp.sin(ang)
    return jnp.concatenate([x1 * cos - x2 * sin, x2 * cos + x1 * sin], axis=-1)


def apply_axial_rope(x, ang_row, ang_col):
    h = x.shape[-1] // 2
    return jnp.concatenate([_rotate(x[..., :h], ang_row), _rotate(x[..., h:], ang_col)], axis=-1).astype(x.dtype)


def split_cols(u):
    sizes = [2 * D_BRANCH] + [D_BRANCH] * 6 + [3 * D_MODEL]
    return jnp.split(u, np.cumsum(sizes)[:-1].tolist(), axis=-1)


def to_heads(t, n_heads):
    b, l, _ = t.shape
    return t.reshape(b, l, n_heads, -1).transpose(0, 2, 1, 3)


def from_heads(o):
    b, h, l, d = o.shape
    return o.transpose(0, 2, 1, 3).reshape(b, l, h * d)


def conformer_conv(u, dw_w, dw_b, ln_g, ln_b):
    val, gate = jnp.split(u, 2, axis=-1)
    h = val * jax.nn.sigmoid(gate)
    h = lax.conv_general_dilated(h, dw_w[:, None, :], (1,), [(CONV_K // 2, CONV_K // 2)],
                                 dimension_numbers=('NWC', 'WIO', 'NWC'),
                                 feature_group_count=h.shape[-1]) + dw_b
    return jax.nn.silu(layer_norm(h, ln_g, ln_b))


def diff_attend(q1, q2, k1, k2, v, lam):
    scale = DIFF_D ** -0.5
    s1 = jnp.einsum('bhqd,bhkd->bhqk', q1, k1).astype(jnp.float32) * scale
    s2 = jnp.einsum('bhqd,bhkd->bhqk', q2, k2).astype(jnp.float32) * scale
    a = jax.nn.softmax(s1, axis=-1) - lam * jax.nn.softmax(s2, axis=-1)
    return jnp.einsum('bhqk,bhkd->bhqd', a.astype(v.dtype), v)


def diff_head_out(o, subln_g, lam_init):
    return from_heads(rms_norm(o, subln_g) * (1.0 - lam_init))


def softmax_attend(q, k, v):
    s = jnp.einsum('bhqd,bhkd->bhqk', q, k).astype(jnp.float32) * (q.shape[-1] ** -0.5)
    return jnp.einsum('bhqk,bhkd->bhqd', jax.nn.softmax(s, axis=-1).astype(v.dtype), v)


def neighbourhood_attention(q, k, v, k_ctx, v_ctx, rpb):
    b, h, l, dh = q.shape
    rows = l // GRID_W
    kr = min(NAT_KR, rows)
    kc = NAT_KC
    qg = q.reshape(b, h, rows, GRID_W, dh)
    kg = k.reshape(b, h, rows, GRID_W, dh)
    vg = v.reshape(b, h, rows, GRID_W, dh)
    cols = np.arange(GRID_W)
    col_start = np.clip(cols - kc // 2, 0, GRID_W - kc)
    col_idx = col_start[:, None] + np.arange(kc)[None, :]
    col_off = col_idx - cols[:, None] + (NAT_KC - 1)
    rpb_c = rpb[:, :, col_off]
    scale = dh ** -0.5
    n_loc = kr * kc

    def one_row(r):
        rs = jnp.clip(r - kr // 2, 0, rows - kr)
        ks = lax.dynamic_slice_in_dim(kg, rs, kr, axis=2)[:, :, :, col_idx]
        vs = lax.dynamic_slice_in_dim(vg, rs, kr, axis=2)[:, :, :, col_idx]
        qr = lax.dynamic_index_in_dim(qg, r, axis=2, keepdims=False)
        s_loc = jnp.einsum('bhwd,bhiwjd->bhwij', qr, ks).astype(jnp.float32) * scale
        row_off = rs + jnp.arange(kr) - r + (NAT_KR - 1)
        bias = jnp.take(rpb_c, row_off, axis=1).transpose(0, 2, 1, 3)
        s_loc = s_loc + bias[None].astype(jnp.float32)
        s_ctx = jnp.einsum('bhwd,bhcd->bhwc', qr, k_ctx).astype(jnp.float32) * scale
        p = jax.nn.softmax(jnp.concatenate([s_loc.reshape(b, h, GRID_W, n_loc), s_ctx], axis=-1), axis=-1)
        p_loc = p[..., :n_loc].reshape(b, h, GRID_W, kr, kc).astype(v.dtype)
        p_ctx = p[..., n_loc:].astype(v.dtype)
        return (jnp.einsum('bhwij,bhiwjd->bhwd', p_loc, vs)
                + jnp.einsum('bhwc,bhcd->bhwd', p_ctx, v_ctx))

    out = lax.map(one_row, jnp.arange(rows))
    return out.transpose(1, 2, 0, 3, 4).reshape(b, h, l, dh)


def merge_branches(ya, yb, yc, g, w_branch, w_out):
    ga, gb, gc = jnp.split(jax.nn.sigmoid(g), 3, axis=-1)
    m = ga * (ya @ w_branch[0]) + gb * (yb @ w_branch[1]) + gc * (yc @ w_branch[2])
    return m @ w_out


def mixing_sublayer(h_lat, h_ctx, w_in, dw_w, dw_b, cln_g, cln_b, lam, lam_init, subln_g, rpb,
                    w_branch, w_out, with_ctx):
    b, l, _ = h_lat.shape
    ang_r, ang_c = axial_rope_angles(l, DIFF_D)
    a_l, bq_l, bk_l, bv_l, cq_l, ck_l, cv_l, g_l = split_cols(h_lat @ w_in)
    a_c, bq_c, bk_c, bv_c, cq_c, ck_c, cv_c, g_c = split_cols(h_ctx @ w_in)

    q_l, k_l, v_l = to_heads(bq_l, DIFF_HEADS), to_heads(bk_l, DIFF_HEADS), to_heads(bv_l, DIFF_HEADS)
    q_c, k_c, v_c = to_heads(bq_c, DIFF_HEADS), to_heads(bk_c, DIFF_HEADS), to_heads(bv_c, DIFF_HEADS)
    q1_l = apply_axial_rope(q_l[..., :DIFF_D], ang_r, ang_c)
    q2_l = apply_axial_rope(q_l[..., DIFF_D:], ang_r, ang_c)
    k1_all = jnp.concatenate([k_c[..., :DIFF_D], apply_axial_rope(k_l[..., :DIFF_D], ang_r, ang_c)], axis=2)
    k2_all = jnp.concatenate([k_c[..., DIFF_D:], apply_axial_rope(k_l[..., DIFF_D:], ang_r, ang_c)], axis=2)
    v_all = jnp.concatenate([v_c, v_l], axis=2)
    nb = l // Q_BLOCK

    def blocks(t):
        return t.reshape(b, DIFF_HEADS, nb, Q_BLOCK, DIFF_D).transpose(2, 0, 1, 3, 4)

    ob = lax.map(lambda qq: diff_attend(qq[0], qq[1], k1_all, k2_all, v_all, lam), (blocks(q1_l), blocks(q2_l)))
    ob = ob.transpose(1, 2, 0, 3, 4).reshape(b, DIFF_HEADS, l, 2 * DIFF_D)
    yb_l = diff_head_out(ob, subln_g, lam_init)

    nk_c, nv_c = to_heads(ck_c, NAT_HEADS), to_heads(cv_c, NAT_HEADS)
    yc_l = from_heads(neighbourhood_attention(to_heads(cq_l, NAT_HEADS), to_heads(ck_l, NAT_HEADS),
                                              to_heads(cv_l, NAT_HEADS), nk_c, nv_c, rpb))
    ya_l = conformer_conv(a_l, dw_w, dw_b, cln_g, cln_b)
    y_lat = merge_branches(ya_l, yb_l, yc_l, g_l, w_branch, w_out)
    if not with_ctx:
        return y_lat, None

    ya_c = conformer_conv(a_c, dw_w, dw_b, cln_g, cln_b)
    yb_c = diff_head_out(diff_attend(q_c[..., :DIFF_D], q_c[..., DIFF_D:], k_c[..., :DIFF_D], k_c[..., DIFF_D:],
                                     v_c, lam), subln_g, lam_init)
    yc_c = from_heads(softmax_attend(to_heads(cq_c, NAT_HEADS), nk_c, nv_c))
    y_ctx = merge_branches(ya_c, yb_c, yc_c, g_c, w_branch, w_out)
    return y_lat, y_ctx


def routed_moe(t, w_r, b_r, w1, b1, w2, b2):
    logits = (t @ w_r).astype(jnp.float32) + b_r.astype(jnp.float32)
    top_v, top_i = lax.top_k(logits, TOP_K)
    top_w = jax.nn.softmax(top_v, axis=-1)
    combine = jnp.sum(jax.nn.one_hot(top_i, N_EXPERTS, dtype=jnp.float32) * top_w[..., None], axis=1)
    out = jnp.zeros(t.shape, jnp.float32)
    for e in range(N_EXPERTS):
        hh = t @ w1[e] + b1[e]
        glu = jnp.minimum(hh[:, :D_FF], SWIGLU_LIMIT)
        lin = jnp.clip(hh[:, D_FF:], -SWIGLU_LIMIT, SWIGLU_LIMIT)
        act = glu * jax.nn.sigmoid(SWIGLU_ALPHA * glu) * (lin + 1.0)
        out = out + combine[:, e:e + 1] * (act @ w2[e] + b2[e]).astype(jnp.float32)
    return out.astype(t.dtype)


def setup_inputs(seed: int = 0) -> dict:
    key = jax.random.key(seed)
    ks = jax.random.split(key, 32)
    D = D_MODEL

    def nrm(k, shape, s):
        return jax.random.normal(k, shape, jnp.float32) * s

    return {
        'x': nrm(ks[0], (BATCH, SEQ, D), 1.0),
        'c': nrm(ks[1], (BATCH, D), 1.0),
        'ctx': nrm(ks[2], (BATCH, CTX_LEN, D), 1.0),
        'c_ctx': nrm(ks[3], (D,), 1.0),
        'w_ada': nrm(ks[4], (DEPTH, D, 6 * D), 0.5 * D ** -0.5),
        'b_ada': nrm(ks[5], (DEPTH, 6 * D), 0.02),
        'w_in': nrm(ks[6], (DEPTH, D, IN_COLS), D ** -0.5),
        'conv_dw_w': nrm(ks[7], (DEPTH, CONV_K, D_BRANCH), CONV_K ** -0.5),
        'conv_dw_b': nrm(ks[8], (DEPTH, D_BRANCH), 0.02),
        'conv_ln_g': 1.0 + nrm(ks[9], (DEPTH, D_BRANCH), 0.02),
        'conv_ln_b': nrm(ks[10], (DEPTH, D_BRANCH), 0.02),
        'lam_q1': nrm(ks[11], (DEPTH, DIFF_D), 0.1),
        'lam_k1': nrm(ks[12], (DEPTH, DIFF_D), 0.1),
        'lam_q2': nrm(ks[13], (DEPTH, DIFF_D), 0.1),
        'lam_k2': nrm(ks[14], (DEPTH, DIFF_D), 0.1),
        'diff_subln_g': 1.0 + nrm(ks[15], (DEPTH, 2 * DIFF_D), 0.02),
        'nat_rpb': nrm(ks[16], (DEPTH, NAT_HEADS, 2 * NAT_KR - 1, 2 * NAT_KC - 1), 0.05),
        'w_branch': nrm(ks[17], (DEPTH, 3, D_BRANCH, D), D_BRANCH ** -0.5),
        'w_out': nrm(ks[18], (DEPTH, D, D), DEEPNORM_BETA * D ** -0.5),
        'ln1_g': 1.0 + nrm(ks[19], (DEPTH, D), 0.02),
        'ln1_b': nrm(ks[20], (DEPTH, D), 0.02),
        'router_w': nrm(ks[21], (DEPTH, D, N_EXPERTS), D ** -0.5),
        'router_b': nrm(ks[22], (DEPTH, N_EXPERTS), 0.01),
        'exp_w1': nrm(ks[23], (DEPTH, N_EXPERTS, D, 2 * D_FF), D ** -0.5),
        'exp_b1': nrm(ks[24], (DEPTH, N_EXPERTS, 2 * D_FF), 0.02),
        'exp_w2': nrm(ks[25], (DEPTH, N_EXPERTS, D_FF, D), DEEPNORM_BETA * D_FF ** -0.5),
        'exp_b2': nrm(ks[26], (DEPTH, N_EXPERTS, D), 0.02),
        'ln2_g': 1.0 + nrm(ks[27], (DEPTH, D), 0.02),
        'ln2_b': nrm(ks[28], (DEPTH, D), 0.02),
    }


def reference(x, c, ctx, c_ctx, w_ada, b_ada, w_in, conv_dw_w, conv_dw_b, conv_ln_g, conv_ln_b,
              lam_q1, lam_k1, lam_q2, lam_k2, diff_subln_g, nat_rpb, w_branch, w_out, ln1_g, ln1_b,
              router_w, router_b, exp_w1, exp_b1, exp_w2, exp_b2, ln2_g, ln2_b):
    b, l, d = x.shape
    n_ctx = ctx.shape[1]
    xc = ctx
    for i in range(DEPTH):
        with_ctx = i < DEPTH - 1
        lam_init = 0.8 - 0.6 * math.exp(-0.3 * i)
        lam = (jnp.exp(jnp.sum(lam_q1[i].astype(jnp.float32) * lam_k1[i].astype(jnp.float32)))
               - jnp.exp(jnp.sum(lam_q2[i].astype(jnp.float32) * lam_k2[i].astype(jnp.float32))) + lam_init)
        mod_l = (jax.nn.silu(c) @ w_ada[i] + b_ada[i])[:, None, :]
        mod_c = (jax.nn.silu(c_ctx) @ w_ada[i] + b_ada[i])[None, None, :]
        sh1, sc1, g1, sh2, sc2, g2 = jnp.split(mod_l, 6, axis=-1)
        csh1, csc1, cg1, csh2, csc2, cg2 = jnp.split(mod_c, 6, axis=-1)

        y_lat, y_ctx = mixing_sublayer(modulate(x, sh1, sc1), modulate(xc, csh1, csc1), w_in[i],
                                       conv_dw_w[i], conv_dw_b[i], conv_ln_g[i], conv_ln_b[i], lam, lam_init,
                                       diff_subln_g[i], nat_rpb[i], w_branch[i], w_out[i], with_ctx)
        x = layer_norm(DEEPNORM_ALPHA * x + g1 * y_lat, ln1_g[i], ln1_b[i])
        if with_ctx:
            xc = layer_norm(DEEPNORM_ALPHA * xc + cg1 * y_ctx, ln1_g[i], ln1_b[i])

        tok = modulate(x, sh2, sc2).reshape(b * l, d)
        if with_ctx:
            tok = jnp.concatenate([tok, modulate(xc, csh2, csc2).reshape(b * n_ctx, d)], axis=0)
        y = routed_moe(tok, router_w[i], router_b[i], exp_w1[i], exp_b1[i], exp_w2[i], exp_b2[i])
        x = layer_norm(DEEPNORM_ALPHA * x + g2 * y[:b * l].reshape(b, l, d), ln2_g[i], ln2_b[i])
        if with_ctx:
            xc = layer_norm(DEEPNORM_ALPHA * xc + cg2 * y[b * l:].reshape(b, n_ctx, d), ln2_g[i], ln2_b[i])
    return x
```

```cpp
#include <hip/hip_runtime.h>
#include <cstdio>
#include <cstdint>

#define DIAG_GATEPLAIN 0
#ifndef ABL
#define ABL 0
#endif
#ifndef DIAG_STOP
#define DIAG_STOP 0
#endif
#ifndef MK_ONE_LAUNCH
#define MK_ONE_LAUNCH 1
#endif

#define LAS __attribute__((address_space(3)))
#define GAS __attribute__((address_space(1)))
typedef unsigned short bf16;
typedef short bf16x8 __attribute__((ext_vector_type(8)));
typedef float f32x4 __attribute__((ext_vector_type(4)));
typedef float f32x2 __attribute__((ext_vector_type(2)));
typedef float f32x16 __attribute__((ext_vector_type(16)));
typedef unsigned u32x4 __attribute__((ext_vector_type(4)));
typedef unsigned u32x2 __attribute__((ext_vector_type(2)));
typedef GAS unsigned gu32;

constexpr int NB = 16, SEQ = 2048, NCTX = 256, DM = 1024, DB = 512, DEPTH = 2;
constexpr int T_LAT = NB * SEQ, T_CTX = NB * NCTX, T_ALL = T_LAT + T_CTX;
constexpr int INC = 7168, NE = 32, TOPK = 4, DFF = 1024, CONVK = 31;
constexpr int KEYS = NCTX + SEQ;
constexpr int C_DQ = 1024, C_DK = 1536, C_DV = 2048, C_NQ = 2560, C_NK = 3072, C_NV = 3584, C_G = 4096;
constexpr float LN_EPS = 1e-6f, ALPHA = 1.4142135623730951f, LOG2E = 1.4426950408889634f;
constexpr float QSCALE = 0.125f * LOG2E;
constexpr int LIST_CAP = T_ALL;

constexpr size_t MiB = 1u << 20;
constexpr size_t WS_CTL = 0, CTL_ZERO_BYTES = 1 * MiB;
constexpr size_t WS_MOD = 1 * MiB;
constexpr size_t WS_ROPE = 3 * MiB;
constexpr size_t WS_LIST = 4 * MiB;
constexpr size_t WS_WIN = 16 * MiB;
constexpr size_t WS_WBR = WS_WIN + 28 * MiB;
constexpr size_t WS_WOUT = WS_WBR + 6 * MiB;
constexpr size_t WS_W1 = WS_WOUT + 4 * MiB;
constexpr size_t WS_W2 = WS_W1 + 128 * MiB;
constexpr size_t WS_WIN8 = WS_W2 + 64 * MiB;
constexpr size_t WS_H8 = WS_WIN8 + 8 * MiB;
constexpr size_t WS_H = WS_H8 + 36 * MiB;
constexpr size_t WS_X = WS_H + 72 * MiB;
constexpr size_t WS_U = WS_X + 144 * MiB;
constexpr size_t WS_MV = WS_U;
constexpr size_t WS_YA = WS_U + 504 * MiB;
constexpr size_t WS_YB = WS_YA + 36 * MiB;
constexpr size_t WS_YC = WS_YB + 36 * MiB;
constexpr size_t WS_MB = WS_YC + 36 * MiB;
constexpr size_t WS_Z = WS_MB;
constexpr size_t WS_YK = WS_YA;
constexpr size_t WS_VTD = WS_Z + 216 * MiB;
constexpr size_t WS_VTN = WS_VTD + 36 * MiB;
constexpr size_t WS_END = WS_VTN + 36 * MiB;
static_assert(WS_END <= 2048 * MiB, "workspace map");
constexpr int MAX_TILES = 608;

constexpr int CW_TMO = 0, CW_CODE = 1;
constexpr int CW_BAR = 4096;
constexpr int CW_ECNT = 16384;

constexpr int RING_BYTES = 131072;
constexpr int IDX_OFF = RING_BYTES;
constexpr int TILE_OFF = IDX_OFF + 24 * 512;
constexpr int MISC_OFF = TILE_OFF + 24 * 32;
constexpr int LDS_BYTES = 147456;
static_assert(MISC_OFF + 2048 <= LDS_BYTES, "LDS map");
constexpr int NWAVES = 8, NTHR = 512;

__device__ __forceinline__ unsigned f2bf(float f) { unsigned u = __builtin_bit_cast(unsigned, f); return (u + 0x7fffu + ((u >> 16) & 1u)) >> 16; }
typedef __bf16 bf16x2_t __attribute__((ext_vector_type(2)));
__device__ __forceinline__ unsigned pk2(float lo, float hi) { const f32x2 v = {lo, hi}; const bf16x2_t b = __builtin_convertvector(v, bf16x2_t); return __builtin_bit_cast(unsigned, b); }
__device__ __forceinline__ float bf2f(unsigned short b) { return __builtin_bit_cast(float, (unsigned)b << 16); }
__device__ __forceinline__ float bflo(unsigned w) { return __builtin_bit_cast(float, w << 16); }
__device__ __forceinline__ float bfhi(unsigned w) { return __builtin_bit_cast(float, w & 0xffff0000u); }
__device__ __forceinline__ float fsigmoid(float x) { return __builtin_amdgcn_rcpf(1.0f + __builtin_amdgcn_exp2f(-x * LOG2E)); }
__device__ __forceinline__ int lane_now() { int l; asm volatile("v_mbcnt_lo_u32_b32 %0, -1, 0\n\tv_mbcnt_hi_u32_b32 %0, -1, %0" : "=v"(l)); return l; }
__device__ __forceinline__ float sx(float v, int m) { return __builtin_bit_cast(float, __builtin_amdgcn_ds_bpermute((lane_now() ^ m) << 2, __builtin_bit_cast(int, v))); }
__device__ __forceinline__ void swap32(unsigned& x, unsigned& y) { const auto r = __builtin_amdgcn_permlane32_swap(x, y, false, false); x = r[0]; y = r[1]; }
template <int CTRL> __device__ __forceinline__ float dppx(float v) { return __builtin_bit_cast(float, __builtin_amdgcn_update_dpp(0, __builtin_bit_cast(int, v), CTRL, 0xF, 0xF, false)); }
template <int CTRL> __device__ __forceinline__ int dppxi(int v) { return __builtin_amdgcn_update_dpp(0, v, CTRL, 0xF, 0xF, false); }
__device__ __forceinline__ float wave_sum(float v) {
    v += dppx<0xB1>(v); v += dppx<0x4E>(v); v += dppx<0x141>(v); v += dppx<0x140>(v);
    { const unsigned b = __builtin_bit_cast(unsigned, v); const auto r = __builtin_amdgcn_permlane16_swap(b, b, false, false); v = __builtin_bit_cast(float, (unsigned)r[0]) + __builtin_bit_cast(float, (unsigned)r[1]); }
    { const unsigned b = __builtin_bit_cast(unsigned, v); const auto r = __builtin_amdgcn_permlane32_swap(b, b, false, false); v = __builtin_bit_cast(float, (unsigned)r[0]) + __builtin_bit_cast(float, (unsigned)r[1]); }
    return v;
}
#define LDS_WAIT() asm volatile("s_waitcnt lgkmcnt(0)" ::: "memory")
#define VM_WAIT() asm volatile("s_waitcnt vmcnt(0)" ::: "memory")
#define RLX_AGENT __ATOMIC_RELAXED, __HIP_MEMORY_SCOPE_AGENT

#define XB_TMO      128
#define XB_XCNT(j)  (256  + 64 * (j))
#define XB_XSUB(j)  (1280 + 64 * (j))
#define XB_XGEN(j)  (2304 + 64 * (j))
#define XB_TOP      3328
#define XB_TOPGEN   3392
#define XCD_BAR_WORDS 3456
#define XB_SPIN_CAP (1u << 22)
__device__ __forceinline__ unsigned xb_ld(unsigned* p)              { return __hip_atomic_load(p, __ATOMIC_RELAXED, __HIP_MEMORY_SCOPE_AGENT); }
__device__ __forceinline__ unsigned xb_add(unsigned* p, unsigned v) { return __hip_atomic_fetch_add(p, v, __ATOMIC_RELAXED, __HIP_MEMORY_SCOPE_AGENT); }
__device__ __forceinline__ unsigned xb_xcc_id() { return (unsigned)__builtin_amdgcn_s_getreg((3 << 11) | 20) & 0xFu; }
#define XB_SPIN(cond, bar) do { unsigned _sp = 0; while (cond) { __builtin_amdgcn_s_sleep(1); \
    if ((++_sp & 255u) == 0u) { if (xb_ld(&(bar)[XB_TMO])) break; if (_sp > XB_SPIN_CAP) { atomicAdd(&(bar)[XB_TMO], 1u); break; } } } } while (0)
struct XcdBarrier { unsigned* bar; unsigned x; volatile LAS unsigned* st; int w0; };
__device__ __forceinline__ XcdBarrier xcd_barrier_post(unsigned* bar, volatile LAS unsigned* st) {
    XcdBarrier b; b.bar = bar; b.x = xb_xcc_id(); b.st = st;
    if (threadIdx.x == 0) (void)xb_add(&bar[XB_XCNT(b.x)], 1u);
    return b;
}
__device__ __forceinline__ void xcd_barrier_complete(unsigned* bar, unsigned x, unsigned& nloc, unsigned& nx) {
    const unsigned G = gridDim.x * gridDim.y * gridDim.z;
    unsigned sum, cnt, mine, sp = 0u;
    for (;;) {
        sum = 0u; cnt = 0u; mine = 0u;
#pragma unroll
        for (unsigned j = 0; j < 16; ++j) { const unsigned c = xb_ld(&bar[XB_XCNT(j)]); sum += c; cnt += (c > 0u) ? 1u : 0u; mine = (j == x) ? c : mine; }
        if (sum == G) break;
        __builtin_amdgcn_s_sleep(1);
        if ((++sp & 255u) == 0u) { if (xb_ld(&bar[XB_TMO])) break; if (sp > XB_SPIN_CAP) { atomicAdd(&bar[XB_TMO], 1u); break; } }
    }
    nloc = mine > 0u ? mine : 1u; nx = cnt > 0u ? cnt : 1u;
}
__device__ __forceinline__ void xcd_barrier(const XcdBarrier& b) {
    asm volatile("s_waitcnt vmcnt(0)" ::: "memory");
    __syncthreads();
    if (b.w0 == 0 && lane_now() == 0) {
        unsigned* bar = b.bar;
        __builtin_amdgcn_s_waitcnt(0);
        unsigned nloc = b.st[0], nx = b.st[1];
        if (nloc == 0u) { xcd_barrier_complete(bar, b.x, nloc, nx); b.st[0] = nloc; b.st[1] = nx; }
        const unsigned old = xb_add(&bar[XB_XSUB(b.x)], 1u);
        const unsigned gen = old / nloc;
        if (old + 1u == (gen + 1u) * nloc) {
            __builtin_amdgcn_fence(__ATOMIC_RELEASE, "agent");
            asm volatile("s_waitcnt vmcnt(0)" ::: "memory");
            const unsigned og = xb_add(&bar[XB_TOP], 1u);
            const unsigned tg = og / nx;
            if (og + 1u == (tg + 1u) * nx) xb_add(&bar[XB_TOPGEN], 1u);
            else XB_SPIN(xb_ld(&bar[XB_TOPGEN]) == tg, bar);
            __builtin_amdgcn_fence(__ATOMIC_ACQUIRE, "agent");
            xb_add(&bar[XB_XGEN(b.x)], 1u);
            asm volatile("s_waitcnt vmcnt(0)" ::: "memory");
        } else {
            XB_SPIN(xb_ld(&bar[XB_XGEN(b.x)]) == gen, bar);
            __builtin_amdgcn_fence(__ATOMIC_ACQUIRE, "agent");
            asm volatile("s_waitcnt vmcnt(0)" ::: "memory");
        }
    }
    __syncthreads();
}

namespace pg8 {
typedef int v8i_t __attribute__((ext_vector_type(8)));
typedef int v4i_t __attribute__((ext_vector_type(4)));
constexpr int BM = 256, BK = 64, HALF = 128, HTB = HALF * BK * 2, STAGE_BYTES = 8 * HTB, NXCD = 8, WGM = 8;
__host__ __device__ __forceinline__ int lds_byte(int r, int c) { const int st = (r >> 4) * 2 + (c >> 5), rr = r & 15, cc = c & 31, ob = rr * 64 + cc * 2; return st * 1024 + (ob ^ (((ob >> 9) & 1) << 5)); }
__host__ __device__ __forceinline__ void stage_rc(int b, int& R, int& C) { const int st = b / 1024, sb = b % 1024, swz = sb ^ (((sb >> 9) & 1) << 5); R = (st >> 1) * 16 + swz / 64; C = (st & 1) * 32 + (swz % 64) / 2; }
__host__ __device__ __forceinline__ int perm32(int rho) { const int n = rho >> 4, i = rho & 15; return 8 * (i >> 2) + 4 * n + (i & 3); }

struct Unit { const char* pa; const char* pb; int pm, pn, e, nrows, ti, slot; };

struct StaticOrder {
    static constexpr bool GATHER = false;
    const char* A; const char* Bt; int lda, K; int nM, nN, nwg, G, c;
    __device__ __forceinline__ void init(const bf16* A_, int lda_, const bf16* Bt_, int K_, int M, int N, int G_, int c_) { A = (const char*)A_; Bt = (const char*)Bt_; lda = lda_ * 2; K = K_ * 2; nM = M / BM; nN = N / BM; nwg = nM * nN; G = G_; c = c_; }
    __device__ __forceinline__ void init_bytes(const void* A_, int ldab, const void* Bt_, int Kb, int M, int N, int G_, int c_) { A = (const char*)A_; Bt = (const char*)Bt_; lda = ldab; K = Kb; nM = M / BM; nN = N / BM; nwg = nM * nN; G = G_; c = c_; }
    __device__ __forceinline__ bool next(int i, Unit& u) const {
        const long L = (long)i * G + c; if (L >= nwg) return false;
        int wgid = (int)L; { const int q = nwg / NXCD, r = nwg % NXCD, xcd = wgid % NXCD, off = wgid / NXCD; wgid = (xcd < r ? xcd * (q + 1) : r * (q + 1) + (xcd - r) * q) + off; }
        const int nig = WGM * nN, gid = wgid / nig, fm = gid * WGM, gsz = (nM - fm) < WGM ? (nM - fm) : WGM;
        u.pm = fm + ((wgid % nig) % gsz); u.pn = (wgid % nig) / gsz; u.e = 0; u.nrows = 256; u.ti = u.pm; u.slot = 0;
        u.pa = A + (size_t)u.pm * BM * lda; u.pb = Bt + (size_t)u.pn * BM * K; return true;
    }
    __device__ __forceinline__ unsigned arow(const Unit&, int R) const { return (unsigned)R; }
};

template <class Epi, class Sched, bool FP8 = false>
__device__ __forceinline__ void gemm_phase(LAS unsigned char* lds, const int wid, const int Kb, const int ldab, const Sched& S, const Epi& E) {
    const int lane = lane_now(), tid = (wid << 6) | lane, wr = wid >> 2, wc = wid & 3, fr = lane & 15, fq = lane >> 4;
    int sc7f = 0x7f7f7f7f; if (FP8) asm volatile("" : "+v"(sc7f));
    int nt = Kb / 128; asm volatile("" : "+s"(nt));
    unsigned voffB[1]; const size_t row64B = (size_t)64 * Kb;
    { int R0, C0; stage_rc(tid * 16, R0, C0); const int Rb = Epi::PERM ? ((R0 & ~31) + perm32(R0 & 31)) : R0; voffB[0] = (unsigned)(Rb * Kb + C0 * 2); }
    const size_t kstep = (size_t)(BK * 2);
    const size_t hstepB = (size_t)HALF * Kb;
    const unsigned ldsw = (unsigned)wid * 1024u;
    const int aoff = lds_byte(wr * 64 + fr, fq * 8), boff = lds_byte(wc * 32 + fr, fq * 8);
#define PG8_SA(b, h) (((b) * 2 + (h)) * HTB)
#define PG8_SB(b, h) ((4 + (b) * 2 + (h)) * HTB)
#define PG8_STAGE(bufoff, gbase, v0, v1) do { const char* gb_ = (const char*)(gbase); const unsigned l0_ = (unsigned)(unsigned long)lds + (unsigned)(bufoff) + ldsw, l1_ = l0_ + 8192u; unsigned keep_; \
        asm volatile("s_mov_b32 %0, m0\n\ts_mov_b32 m0, %4\n\ts_nop 0\n\tglobal_load_lds_dwordx4 %1, %3\n\ts_mov_b32 m0, %5\n\ts_nop 0\n\tglobal_load_lds_dwordx4 %2, %3\n\ts_mov_b32 m0, %0" \
                     : "=&s"(keep_) : "v"(v0), "v"(v1), "s"(gb_), "s"(l0_), "s"(l1_) : "memory"); } while (0)
#define PG8_STB(bufoff, gbase) do { const char* gb_ = (const char*)(gbase); const char* gc_ = gb_ + row64B; const unsigned l0_ = (unsigned)(unsigned long)lds + (unsigned)(bufoff) + ldsw, l1_ = l0_ + 8192u; unsigned keep_; \
        asm volatile("s_mov_b32 %0, m0\n\ts_mov_b32 m0, %4\n\ts_nop 0\n\tglobal_load_lds_dwordx4 %1, %2\n\ts_mov_b32 m0, %5\n\ts_nop 0\n\tglobal_load_lds_dwordx4 %1, %3\n\ts_mov_b32 m0, %0" \
                     : "=&s"(keep_) : "v"(voffB[0]), "s"(gb_), "s"(gc_), "s"(l0_), "s"(l1_) : "memory"); } while (0)
#define PG8_LDA(dst, b, h) do { if constexpr (FP8) { _Pragma("unroll") for (int m = 0; m < 4; ++m) { const v4i_t lo_ = *(const LAS v4i_t*)(lds + PG8_SA(b, h) + aoff + m * 2048), hi_ = *(const LAS v4i_t*)(lds + PG8_SA(b, h) + aoff + m * 2048 + 1024); dst##8[m] = __builtin_shufflevector(lo_, hi_, 0, 1, 2, 3, 4, 5, 6, 7); } } \
        else { _Pragma("unroll") for (int m = 0; m < 4; ++m) _Pragma("unroll") for (int k = 0; k < 2; ++k) dst[m][k] = *(const LAS bf16x8*)(lds + PG8_SA(b, h) + aoff + m * 2048 + k * 1024); } } while (0)
#define PG8_LDB(dst, b, h) do { if constexpr (FP8) { _Pragma("unroll") for (int n = 0; n < 2; ++n) { const v4i_t lo_ = *(const LAS v4i_t*)(lds + PG8_SB(b, h) + boff + n * 2048), hi_ = *(const LAS v4i_t*)(lds + PG8_SB(b, h) + boff + n * 2048 + 1024); dst##8[n] = __builtin_shufflevector(lo_, hi_, 0, 1, 2, 3, 4, 5, 6, 7); } } \
        else { _Pragma("unroll") for (int n = 0; n < 2; ++n) _Pragma("unroll") for (int k = 0; k < 2; ++k) dst[n][k] = *(const LAS bf16x8*)(lds + PG8_SB(b, h) + boff + n * 2048 + k * 1024); } } while (0)
#define PG8_MMA(ai, bj, At, Bt) do { __builtin_amdgcn_s_setprio(1); if constexpr (FP8) { _Pragma("unroll") for (int m = 0; m < 4; ++m) _Pragma("unroll") for (int n = 0; n < 2; ++n) \
        acc[ai][bj][m][n] = __builtin_amdgcn_mfma_scale_f32_16x16x128_f8f6f4(Bt##8[n], At##8[m], acc[ai][bj][m][n], 0, 0, 0, sc7f, 0, sc7f); } else { \
        _Pragma("unroll") for (int m = 0; m < 4; ++m) _Pragma("unroll") for (int n = 0; n < 2; ++n) _Pragma("unroll") for (int k = 0; k < 2; ++k) \
        acc[ai][bj][m][n] = __builtin_amdgcn_mfma_f32_16x16x32_bf16(Bt[n][k], At[m][k], acc[ai][bj][m][n], 0, 0, 0); } __builtin_amdgcn_s_setprio(0); } while (0)
#define PG8_WAIT_V(n) asm volatile("s_waitcnt vmcnt(" #n ")" ::: "memory")
#define PG8_WAIT_L(n) asm volatile("s_waitcnt lgkmcnt(" #n ")" ::: "memory")
#define PG8_BAR __builtin_amdgcn_s_barrier()
#define PG8_SCHED __builtin_amdgcn_sched_barrier(0)
#define PG8_VOFF(dst, u) do { const int t2_ = Sched::GATHER ? ((wid << 6) | lane_now()) : tid; _Pragma("unroll") for (int i = 0; i < 2; ++i) { int R_, C_; stage_rc(t2_ * 16 + i * 8192, R_, C_); \
        _Pragma("unroll") for (int h = 0; h < 2; ++h) dst[h][i] = (unsigned)(S.arow(u, h * HALF + R_) * (unsigned)ldab + (unsigned)C_ * 2u); } } while (0)
    Unit cur, nxt; int ui = 0;
    if (!S.next(0, cur)) return;
    f32x4 acc[2][2][4][2];
#pragma unroll
    for (int a = 0; a < 2; ++a)
#pragma unroll
        for (int b = 0; b < 2; ++b)
#pragma unroll
            for (int m = 0; m < 4; ++m)
#pragma unroll
                for (int n = 0; n < 2; ++n) acc[a][b][m][n] = (f32x4){0.f, 0.f, 0.f, 0.f};
    bf16x8 At[4][2], B0[2][2], B1[2][2]; v8i_t At8[4], B08[2], B18[2];
    unsigned vc[2][2];
    PG8_VOFF(vc, cur);
    const char* cA = cur.pa; const char* cB = cur.pb;
    PG8_STB(PG8_SB(0, 0), cB); PG8_STB(PG8_SB(0, 1), cB + hstepB); PG8_STAGE(PG8_SA(0, 0), cA, vc[0][0], vc[0][1]); PG8_STAGE(PG8_SA(0, 1), cA, vc[1][0], vc[1][1]);
    if (wr == 1) PG8_BAR;
    PG8_WAIT_V(2); PG8_BAR;
    PG8_STB(PG8_SB(1, 0), cB + kstep); PG8_STAGE(PG8_SA(1, 0), cA + kstep, vc[0][0], vc[0][1]); PG8_STB(PG8_SB(1, 1), cB + hstepB + kstep);
    PG8_WAIT_V(6); PG8_BAR;
    for (;;) {
        const bool has_next = S.next(ui + 1, nxt);
        const char* nA = has_next ? nxt.pa : cA; const char* nB = has_next ? nxt.pb : cB;
#pragma nounroll
        for (int t = 0; t < nt; t += 2) {
            const bool last = (t == nt - 2);
            const char* a1 = cA + (size_t)(t + 1) * kstep;
            const char* a2 = last ? nA : cA + (size_t)(t + 2) * kstep; const char* b2 = last ? nB : cB + (size_t)(t + 2) * kstep;
            const char* a3 = a2 + kstep; const char* b3 = b2 + kstep;
            unsigned v2_00 = vc[0][0], v2_01 = vc[0][1], v2_10 = vc[1][0], v2_11 = vc[1][1];
            if (Sched::GATHER && last && has_next) { unsigned vn[2][2]; PG8_VOFF(vn, nxt); v2_00 = vn[0][0]; v2_01 = vn[0][1]; v2_10 = vn[1][0]; v2_11 = vn[1][1]; }
            PG8_LDB(B0, 0, 0); PG8_LDB(B1, 0, 1); PG8_SCHED; PG8_LDA(At, 0, 0); PG8_STAGE(PG8_SA(1, 1), a1, vc[1][0], vc[1][1]);
            PG8_WAIT_V(8); PG8_WAIT_L(0); PG8_BAR; PG8_MMA(0, 0, At, B0); PG8_MMA(0, 1, At, B1); PG8_BAR; PG8_SCHED;
            PG8_LDA(At, 0, 1); PG8_STB(PG8_SB(0, 0), b2); PG8_STB(PG8_SB(0, 1), b2 + hstepB); PG8_STAGE(PG8_SA(0, 0), a2, v2_00, v2_01);
            PG8_WAIT_V(8); PG8_WAIT_L(0); PG8_BAR; PG8_MMA(1, 0, At, B0); PG8_MMA(1, 1, At, B1); PG8_BAR; PG8_SCHED;
            PG8_LDB(B0, 1, 0); PG8_LDB(B1, 1, 1); PG8_SCHED; PG8_LDA(At, 1, 0); PG8_STAGE(PG8_SA(0, 1), a2, v2_10, v2_11);
            PG8_WAIT_V(8); PG8_WAIT_L(0); PG8_BAR; PG8_MMA(0, 0, At, B0); PG8_MMA(0, 1, At, B1); PG8_BAR; PG8_SCHED;
            PG8_LDA(At, 1, 1); PG8_STB(PG8_SB(1, 0), b3); PG8_STB(PG8_SB(1, 1), b3 + hstepB); PG8_STAGE(PG8_SA(1, 0), a3, v2_00, v2_01);
            PG8_WAIT_V(8); PG8_WAIT_L(0); PG8_BAR; PG8_MMA(1, 0, At, B0); PG8_MMA(1, 1, At, B1); PG8_BAR; PG8_SCHED;
        }
        if (wr == 0) PG8_BAR;
        { const int l_ = lane_now(); E(acc, cur, wr, wc, l_ & 15, l_ >> 4); }
        if (!has_next) break;
        if (!E.carry(cur)) {
#pragma unroll
        for (int a = 0; a < 2; ++a)
#pragma unroll
            for (int b = 0; b < 2; ++b)
#pragma unroll
                for (int m = 0; m < 4; ++m)
#pragma unroll
                    for (int n = 0; n < 2; ++n) acc[a][b][m][n] = (f32x4){0.f, 0.f, 0.f, 0.f};
        }
        cur = nxt; cA = nA; cB = nB; ++ui;
        if (Sched::GATHER) { PG8_VOFF(vc, cur); }
        if (wr == 1) PG8_BAR;
    }
    PG8_WAIT_V(0);
    PG8_BAR;
#undef PG8_SA
#undef PG8_SB
#undef PG8_STAGE
#undef PG8_STB
#undef PG8_LDA
#undef PG8_LDB
#undef PG8_MMA
#undef PG8_WAIT_V
#undef PG8_WAIT_L
#undef PG8_BAR
#undef PG8_SCHED
#undef PG8_VOFF
}
}

struct Frame {
    LAS unsigned char* lds;
    volatile LAS unsigned* MISC;
    gu32* ctl;
    int tid, lane, wave, G, bid, wave0;
    const float* const* in;
    GAS float* out; GAS unsigned char* ws;
};

constexpr int MI_BAR = 8;
constexpr int MI_NUNITS = 16;
constexpr int MI_NREC = 17;
constexpr int MI_LCNT = 32;
constexpr int MI_LBASE = 64;

constexpr float W8_SCALE = 64.0f, W8_INV = 1.0f / 64.0f;
__device__ __forceinline__ u32x2 pack8_f8(const float (&x)[8]) { u32x2 w; int a = 0, b = 0; a = __builtin_amdgcn_cvt_pk_fp8_f32(x[0], x[1], a, false); a = __builtin_amdgcn_cvt_pk_fp8_f32(x[2], x[3], a, true); b = __builtin_amdgcn_cvt_pk_fp8_f32(x[4], x[5], b, false); b = __builtin_amdgcn_cvt_pk_fp8_f32(x[6], x[7], b, true); w.x = (unsigned)a; w.y = (unsigned)b; return w; }
__device__ __forceinline__ u32x4 pack8(const float (&x)[8]) { u32x4 w; w.x = pk2(x[0], x[1]); w.y = pk2(x[2], x[3]); w.z = pk2(x[4], x[5]); w.w = pk2(x[6], x[7]); return w; }
#define ACC8(x, A, ai, bj, m) do { const f32x4 _a = A[ai][bj][m][0], _b = A[ai][bj][m][1]; x[0] = _a[0]; x[1] = _a[1]; x[2] = _a[2]; x[3] = _a[3]; x[4] = _b[0]; x[5] = _b[1]; x[6] = _b[2]; x[7] = _b[3]; } while (0)

struct EpiWin {
    static constexpr bool PERM = true;
    __device__ __forceinline__ bool carry(const pg8::Unit&) const { return false; }
    GAS unsigned char* ws; float asc;
    __device__ __forceinline__ void operator()(const f32x4 (&acc)[2][2][4][2], const pg8::Unit& u, int wr, int wc, int fr, int fq) const {
        bf16* const U = (bf16*)(ws + WS_U); bf16* const VTD = (bf16*)(ws + WS_VTD); bf16* const VTN = (bf16*)(ws + WS_VTN); const f32x2* const rope = (const f32x2*)(ws + WS_ROPE);
        const int pn = u.pn; const int row0 = u.pm * 256 + wr * 64 + fr; const int cw = wc * 32 + 8 * fq;
        if (pn < 4) {
#pragma unroll
            for (int ai = 0; ai < 2; ++ai)
#pragma unroll
                for (int m = 0; m < 4; ++m) { const int row = row0 + ai * 128 + m * 16; float v[8], g[8]; ACC8(v, acc, ai, 0, m); ACC8(g, acc, ai, 1, m);
#pragma unroll
                    for (int j = 0; j < 8; ++j) v[j] = (v[j] * asc) * fsigmoid(g[j] * asc);
                    *(u32x4*)(U + (size_t)row * INC + 128 * pn + cw) = pack8(v); }
        } else if (pn < 8) {
            const bool latent = u.pm < 128; const float sc = ((pn < 6) ? QSCALE : 1.f) * asc;
#pragma unroll
            for (int ai = 0; ai < 2; ++ai)
#pragma unroll
                for (int m = 0; m < 4; ++m) { const int row = row0 + ai * 128 + m * 16; const int l = row & 2047; const int pos = (wc & 1) ? (l & 63) : (l >> 6);
#pragma unroll
                    for (int bj = 0; bj < 2; ++bj) { float x[8]; ACC8(x, acc, ai, bj, m);
                        if (latent) {
                            const f32x4* rp = (const f32x4*)(rope + pos * 16 + 8 * (fq & 1));
                            const f32x4 r0 = rp[0], r1 = rp[1], r2 = rp[2], r3 = rp[3];
                            const float cs[8] = {r0[0], r0[2], r1[0], r1[2], r2[0], r2[2], r3[0], r3[2]}, sn[8] = {r0[1], r0[3], r1[1], r1[3], r2[1], r2[3], r3[1], r3[3]};
#pragma unroll
                            for (int j = 0; j < 8; ++j) { const unsigned xb = __builtin_bit_cast(unsigned, x[j]); const auto sw = __builtin_amdgcn_permlane32_swap(xb, xb, false, false);
                                const float p = (fq < 2) ? -__builtin_bit_cast(float, (unsigned)sw[1]) : __builtin_bit_cast(float, (unsigned)sw[0]); x[j] = x[j] * cs[j] + p * sn[j]; }
                        }
#pragma unroll
                        for (int j = 0; j < 8; ++j) x[j] *= sc;
                        *(u32x4*)(U + (size_t)row * INC + 256 * pn + 128 * bj + cw) = pack8(x); } }
        } else if (pn == 8 || pn == 9 || pn == 14 || pn == 15) {
            const bool isd = pn < 10;
#pragma unroll
            for (int ai = 0; ai < 2; ++ai)
#pragma unroll
                for (int m = 0; m < 4; ++m) { const int row = row0 + ai * 128 + m * 16; int b, key;
                    if (row < T_LAT) { b = row >> 11; key = NCTX + (row & 2047); } else { const int rc = row - T_LAT; b = rc >> 8; key = rc & 255; }
#pragma unroll
                    for (int bj = 0; bj < 2; ++bj) { float x[8]; ACC8(x, acc, ai, bj, m);
                        bf16* dst;
                        if (isd) { const int head = (pn - 8) * 2 + bj; dst = VTD + ((size_t)((b * 4 + head) * 128 + cw)) * KEYS + key; }
                        else { const int head = (pn - 14) * 4 + bj * 2 + (wc >> 1); dst = VTN + ((size_t)((b * 8 + head) * 64 + (cw & 63))) * KEYS + key; }
#pragma unroll
                        for (int j = 0; j < 8; ++j) dst[(size_t)j * KEYS] = (bf16)f2bf(x[j] * asc); } }
        } else if (pn < 14 || DIAG_GATEPLAIN) {
            const float sc = ((pn < 12) ? QSCALE : 1.f) * asc;
#pragma unroll
            for (int ai = 0; ai < 2; ++ai)
#pragma unroll
                for (int m = 0; m < 4; ++m) { const int row = row0 + ai * 128 + m * 16;
#pragma unroll
                    for (int bj = 0; bj < 2; ++bj) { float x[8]; ACC8(x, acc, ai, bj, m);
#pragma unroll
                        for (int j = 0; j < 8; ++j) x[j] *= sc;
                        *(u32x4*)(U + (size_t)row * INC + 256 * pn + 128 * bj + cw) = pack8(x); } }
        } else {
#pragma unroll
            for (int ai = 0; ai < 2; ++ai)
#pragma unroll
                for (int m = 0; m < 4; ++m) { const int row = row0 + ai * 128 + m * 16;
#pragma unroll
                    for (int bj = 0; bj < 2; ++bj) { float x[8]; ACC8(x, acc, ai, bj, m);
#pragma unroll
                        for (int j = 0; j < 8; ++j) x[j] = fsigmoid(x[j] * asc);
                        *(u32x4*)(U + (size_t)row * INC + 256 * pn + 128 * bj + cw) = pack8(x); } }
        }
    }
};

struct EpiMB {
    static constexpr bool PERM = true;
    const bf16* U; bf16* MB;
    __device__ __forceinline__ bool carry(const pg8::Unit& u) const { return u.e < 2; }
    __device__ __forceinline__ void operator()(f32x4 (&acc)[2][2][4][2], const pg8::Unit& u, int wr, int wc, int fr, int fq) const {
        const int row0 = u.pm * 256 + wr * 64 + fr; const int cw = wc * 32 + 8 * fq; const int j = u.e;
#pragma unroll
        for (int ai = 0; ai < 2; ++ai) {
            u32x4 gw[4][2], gn[4][2];
#pragma unroll
            for (int m = 0; m < 4; ++m)
#pragma unroll
                for (int bj = 0; bj < 2; ++bj) { const int row = row0 + ai * 128 + m * 16, col = 256 * u.pn + 128 * bj + cw; const bf16* gp = U + (size_t)row * INC + C_G + 1024 * j + col;
                    gw[m][bj] = *(const u32x4*)gp; gn[m][bj] = (j < 2) ? *(const u32x4*)(gp + 1024) : (u32x4){0u, 0u, 0u, 0u}; }
#pragma unroll
            for (int m = 0; m < 4; ++m)
#pragma unroll
                for (int bj = 0; bj < 2; ++bj) { const int row = row0 + ai * 128 + m * 16, col = 256 * u.pn + 128 * bj + cw;
                    const u32x4 g4 = gw[m][bj], n4 = gn[m][bj];
                    float g[8] = {bflo(g4.x), bfhi(g4.x), bflo(g4.y), bfhi(g4.y), bflo(g4.z), bfhi(g4.z), bflo(g4.w), bfhi(g4.w)};
                    const float gx[8] = {bflo(n4.x), bfhi(n4.x), bflo(n4.y), bfhi(n4.y), bflo(n4.z), bfhi(n4.z), bflo(n4.w), bfhi(n4.w)};
                    if (j > 0) {
#pragma unroll
                        for (int q = 0; q < 8; ++q) g[q] = fmaxf(g[q], 1.0e-12f); }
                    float x[8]; ACC8(x, acc, ai, bj, m);
                    if (j < 2) {
#pragma unroll
                        for (int q = 0; q < 8; ++q) x[q] = (x[q] * g[q]) * __builtin_amdgcn_rcpf(fmaxf(gx[q], 1.0e-12f));
                        acc[ai][bj][m][0] = (f32x4){x[0], x[1], x[2], x[3]}; acc[ai][bj][m][1] = (f32x4){x[4], x[5], x[6], x[7]};
                    } else {
#pragma unroll
                        for (int q = 0; q < 8; ++q) x[q] *= g[q];
                        *(u32x4*)(MB + (size_t)row * DM + col) = pack8(x); } }
        }
    }
};
struct MergeOrder {
    static constexpr bool GATHER = false;
    const char* Y; const char* W; pg8::StaticOrder T;
    __device__ __forceinline__ bool next(int i, pg8::Unit& u) const {
        const int t = i / 3, j = i - 3 * t; if (!T.next(t, u)) return false;
        u.e = j; u.pa = Y + (size_t)j * (36 * MiB) + (size_t)u.pm * 256 * (DB * 2); u.pb = W + ((size_t)j * DM + (size_t)u.pn * 256) * (DB * 2); return true; }
    __device__ __forceinline__ unsigned arow(const pg8::Unit&, int R) const { return (unsigned)R; }
};

struct EpiWout {
    static constexpr bool PERM = true;
    __device__ __forceinline__ bool carry(const pg8::Unit&) const { return false; }
    const float* g1base; bf16* YG;
    __device__ __forceinline__ void operator()(const f32x4 (&acc)[2][2][4][2], const pg8::Unit& u, int wr, int wc, int fr, int fq) const {
        const int row0 = u.pm * 256 + wr * 64 + fr; const int cw = wc * 32 + 8 * fq;
        const bool latent = u.pm < 128; const int mi = latent ? (u.pm >> 3) : 16;
        const float* g1 = g1base + (size_t)mi * 6144;
        f32x4 gv[2][2];
#pragma unroll
        for (int bj = 0; bj < 2; ++bj) { const int col = 256 * u.pn + 128 * bj + cw; gv[bj][0] = *(const f32x4*)(g1 + col); gv[bj][1] = *(const f32x4*)(g1 + col + 4); }
#pragma unroll
        for (int ai = 0; ai < 2; ++ai)
#pragma unroll
            for (int m = 0; m < 4; ++m) { const int row = row0 + ai * 128 + m * 16;
#pragma unroll
                for (int bj = 0; bj < 2; ++bj) { const int col = 256 * u.pn + 128 * bj + cw; float x[8]; ACC8(x, acc, ai, bj, m);
#pragma unroll
                    for (int q = 0; q < 4; ++q) { x[q] *= gv[bj][0][q]; x[4 + q] *= gv[bj][1][q]; }
                    *(u32x4*)(YG + (size_t)row * DM + col) = pack8(x); } }
    }
};

struct EpiMoe1 {
    static constexpr bool PERM = true;
    __device__ __forceinline__ bool carry(const pg8::Unit&) const { return false; }
    unsigned char* ACT; const float* b1;
    __device__ __forceinline__ void operator()(const f32x4 (&acc)[2][2][4][2], const pg8::Unit& u, int wr, int wc, int fr, int fq) const {
        const int cw = wc * 32 + 8 * fq; const int col = 128 * u.pn + cw;
        const float* bg = b1 + (size_t)u.e * 2048 + col; const float* bl = bg + 1024;
        const f32x4 bga = *(const f32x4*)bg, bgb = *(const f32x4*)(bg + 4), bla = *(const f32x4*)bl, blb = *(const f32x4*)(bl + 4);
        const float bgv[8] = {bga[0], bga[1], bga[2], bga[3], bgb[0], bgb[1], bgb[2], bgb[3]}, blv[8] = {bla[0], bla[1], bla[2], bla[3], blb[0], blb[1], blb[2], blb[3]};
#pragma unroll
        for (int ai = 0; ai < 2; ++ai)
#pragma unroll
            for (int m = 0; m < 4; ++m) { const int R = ai * 128 + wr * 64 + m * 16 + fr; float g[8], l[8]; ACC8(g, acc, ai, 0, m); ACC8(l, acc, ai, 1, m);
#pragma unroll
                for (int j = 0; j < 8; ++j) { const float gl = fminf(g[j] * W8_INV + bgv[j], 7.0f); const float li = fminf(fmaxf(l[j] * W8_INV + blv[j], -7.0f), 7.0f); g[j] = gl * fsigmoid(1.702f * gl) * (li + 1.0f); }
                *(u32x2*)(ACT + ((size_t)u.ti * 256 + R) * DFF + col) = pack8_f8(g); }
    }
};

struct EpiMoe2 {
    static constexpr bool PERM = true;
    __device__ __forceinline__ bool carry(const pg8::Unit&) const { return false; }
    unsigned char* YK; const float* b2; const u32x2* LIST;
    __device__ __forceinline__ void operator()(const f32x4 (&acc)[2][2][4][2], const pg8::Unit& u, int wr, int wc, int fr, int fq) const {
        const int cw = wc * 32 + 8 * fq;
        const u32x2* lst = LIST + (size_t)u.e * LIST_CAP + u.pm * 256;
        u32x2 ent[2][4];
#pragma unroll
        for (int ai = 0; ai < 2; ++ai)
#pragma unroll
            for (int m = 0; m < 4; ++m) { const int R = ai * 128 + wr * 64 + m * 16 + fr; ent[ai][m] = lst[R < u.nrows ? R : u.nrows - 1]; }
        f32x4 bv[2][2];
#pragma unroll
        for (int bj = 0; bj < 2; ++bj) { const float* bb = b2 + (size_t)u.e * DM + 256 * u.pn + 128 * bj + cw; bv[bj][0] = *(const f32x4*)bb; bv[bj][1] = *(const f32x4*)(bb + 4); }
#pragma unroll
        for (int ai = 0; ai < 2; ++ai)
#pragma unroll
            for (int m = 0; m < 4; ++m) { const int R = ai * 128 + wr * 64 + m * 16 + fr;
                if (R < u.nrows) { const unsigned tokslot = ent[ai][m].x, wbits = ent[ai][m].y; const float w = __uint_as_float(wbits);
#pragma unroll
                    for (int bj = 0; bj < 2; ++bj) { const int col = 256 * u.pn + 128 * bj + cw; float x[8]; ACC8(x, acc, ai, bj, m);
#pragma unroll
                        for (int j = 0; j < 4; ++j) { x[j] = w * (x[j] * W8_INV + bv[bj][0][j]); x[4 + j] = w * (x[4 + j] * W8_INV + bv[bj][1][j]); }
                        *(u32x2*)(YK + (size_t)tokslot * DM + col) = pack8_f8(x); } } }
    }
};

__device__ __forceinline__ void moe_build_tiles(Frame& F, int layer, int NPN, bool gather) {
    LAS int* tile = (LAS int*)(F.lds + TILE_OFF); LAS unsigned short* idx = (LAS unsigned short*)(F.lds + IDX_OFF);
    if (F.tid == 0) F.MISC[MI_NUNITS] = 0u;
    if (F.tid < NE) F.MISC[MI_LCNT + F.tid] = __hip_atomic_load(F.ctl + CW_ECNT + (layer * 32 + F.tid) * 64, RLX_AGENT);
    __syncthreads();
    if (F.tid < 24) {
        const int gx = F.G >> 3, v = (F.bid >> 3) + gx * F.tid; const int ti = (F.bid & 7) + 8 * (v / NPN), pn = v % NPN;
        int accum = 0, fe = -1, fpm = 0, fn = 0;
        for (int e = 0; e < NE; ++e) { const int cnt = (int)F.MISC[MI_LCNT + e]; const int te = (cnt + 255) >> 8;
            if (fe < 0 && ti < accum + te) { fe = e; fpm = ti - accum; fn = cnt - 256 * fpm; if (fn > 256) fn = 256; } accum += te; }
        LAS int* t = tile + F.tid * 8; t[0] = fe < 0 ? 0 : fe; t[1] = fpm; t[2] = fn; t[3] = pn; t[4] = ti; t[5] = fe >= 0 ? 1 : 0;
        if (fe >= 0) __hip_atomic_fetch_add((LAS unsigned*)&F.MISC[MI_NUNITS], 1u, __ATOMIC_RELAXED, __HIP_MEMORY_SCOPE_WORKGROUP);
    }
    __syncthreads();
    if (gather) {
        const int nu = (int)F.MISC[MI_NUNITS];
        for (int k0 = 0; k0 < nu * 256; k0 += 12 * NTHR) {
            unsigned tk[12];
#pragma unroll
            for (int q = 0; q < 12; ++q) { const int k = k0 + q * NTHR + F.tid; tk[q] = 0u;
                if (k < nu * 256) { const int i = k >> 8, R = k & 255; const LAS int* t = tile + i * 8; const int n = t[2]; const int Rc = R < n ? R : n - 1; tk[q] = ((u32x2*)(F.ws + WS_LIST))[(size_t)t[0] * LIST_CAP + t[1] * 256 + Rc].x; } }
#pragma unroll
            for (int q = 0; q < 12; ++q) { const int k = k0 + q * NTHR + F.tid; if (k < nu * 256) idx[k] = (unsigned short)(tk[q] >> 2); }
        }
        __syncthreads();
    }
}
struct MoeSched1 {
    static constexpr bool GATHER = true;
    const char* A; const char* W; LAS const int* tile; LAS const unsigned short* idx; int nunits;
    __device__ __forceinline__ bool next(int i, pg8::Unit& u) const {
        if (i >= nunits) return false; const LAS int* t = tile + i * 8;
        u.e = __builtin_amdgcn_readfirstlane(t[0]); u.pm = __builtin_amdgcn_readfirstlane(t[1]); u.nrows = __builtin_amdgcn_readfirstlane(t[2]); u.pn = __builtin_amdgcn_readfirstlane(t[3]); u.ti = __builtin_amdgcn_readfirstlane(t[4]); u.slot = i;
        u.pa = A; u.pb = W + ((size_t)u.e * 2048 + (size_t)u.pn * 256) * DM; return true; }
    __device__ __forceinline__ unsigned arow(const pg8::Unit& u, int R) const { return (unsigned)idx[u.slot * 256 + R]; }
};
struct MoeSched2 {
    static constexpr bool GATHER = false;
    const char* A; const char* W; LAS const int* tile; int nunits;
    __device__ __forceinline__ bool next(int i, pg8::Unit& u) const {
        if (i >= nunits) return false; const LAS int* t = tile + i * 8;
        u.e = __builtin_amdgcn_readfirstlane(t[0]); u.pm = __builtin_amdgcn_readfirstlane(t[1]); u.nrows = __builtin_amdgcn_readfirstlane(t[2]); u.pn = __builtin_amdgcn_readfirstlane(t[3]); u.ti = __builtin_amdgcn_readfirstlane(t[4]); u.slot = i;
        u.pa = A + (size_t)u.ti * 256 * DFF; u.pb = W + ((size_t)u.e * 1024 + (size_t)u.pn * 256) * DFF; return true; }
    __device__ __forceinline__ unsigned arow(const pg8::Unit&, int R) const { return (unsigned)R; }
};

__device__ __forceinline__ void p0_transpose_item(const float* W, int K, int N, bf16* WT, int glu_half, LAS float* scr, int item, int lane, int ldt, int nrep) {
    const int nblk = N / 32, kb = item / nblk, nb = item % nblk, k0 = 64 * kb, n0 = 32 * nb;
    int d0 = n0;
    if (glu_half && n0 < 2 * glu_half) { const int part = n0 / glu_half, ix = n0 % glu_half; d0 = (ix >> 7) * 256 + part * 128 + (ix & 127); }
    { float wv_[32];
#pragma unroll
      for (int i = 0; i < 32; ++i) wv_[i] = W[(size_t)(k0 + 2 * i + (lane >> 5)) * N + n0 + (lane & 31)];
#pragma unroll
      for (int i = 0; i < 32; ++i) scr[(2 * i + (lane >> 5)) * 33 + (lane & 31)] = wv_[i]; }
    LDS_WAIT(); asm volatile("" ::: "memory");
    const int c = lane & 7;
#pragma unroll
    for (int j = 0; j < 4; ++j) { const int n = (lane >> 3) + 8 * j; const LAS float* s = scr + (8 * c) * 33 + n;
        u32x4 o; o.x = f2bf(s[0 * 33]) | (f2bf(s[1 * 33]) << 16); o.y = f2bf(s[2 * 33]) | (f2bf(s[3 * 33]) << 16); o.z = f2bf(s[4 * 33]) | (f2bf(s[5 * 33]) << 16); o.w = f2bf(s[6 * 33]) | (f2bf(s[7 * 33]) << 16);
        for (int rp = 0; rp < nrep; ++rp) *(u32x4*)(WT + (size_t)(d0 + n) * ldt + rp * K + k0 + 8 * c) = o; }
    LDS_WAIT(); asm volatile("" ::: "memory");
}
__device__ __forceinline__ void p0_transpose_item_f8(const float* W, int K, int N, unsigned char* WT, int glu_half, LAS float* scr, int item, int lane, int drow = 0) {
    const int nblk = N / 32, kb = item / nblk, nb = item % nblk, k0 = 64 * kb, n0 = 32 * nb;
    int d0 = n0;
    if (glu_half && n0 < 2 * glu_half) { const int part = n0 / glu_half, ix = n0 % glu_half; d0 = (ix >> 7) * 256 + part * 128 + (ix & 127); }
    { float wv_[32];
#pragma unroll
      for (int i = 0; i < 32; ++i) wv_[i] = W[(size_t)(k0 + 2 * i + (lane >> 5)) * N + n0 + (lane & 31)];
#pragma unroll
      for (int i = 0; i < 32; ++i) scr[(2 * i + (lane >> 5)) * 33 + (lane & 31)] = wv_[i]; }
    LDS_WAIT(); asm volatile("" ::: "memory");
    const int n = lane >> 1, kh = (lane & 1) * 32; const LAS float* sp = scr + kh * 33 + n;
    unsigned w[8];
#pragma unroll
    for (int q = 0; q < 8; ++q) { int a = 0; a = __builtin_amdgcn_cvt_pk_fp8_f32(sp[(4 * q) * 33] * W8_SCALE, sp[(4 * q + 1) * 33] * W8_SCALE, a, false); a = __builtin_amdgcn_cvt_pk_fp8_f32(sp[(4 * q + 2) * 33] * W8_SCALE, sp[(4 * q + 3) * 33] * W8_SCALE, a, true); w[q] = (unsigned)a; }
    unsigned char* dst = WT + (size_t)(d0 + drow + n) * K + k0 + kh;
    *(u32x4*)dst = (u32x4){w[0], w[1], w[2], w[3]}; *(u32x4*)(dst + 16) = (u32x4){w[4], w[5], w[6], w[7]};
    LDS_WAIT(); asm volatile("" ::: "memory");
}
constexpr int CV_WIN = 16 * 224, CV_WBR = 3 * 8 * 32, CV_WOUT = 16 * 32, CV_W1 = 32 * 16 * 64, CV_W2 = 32 * 16 * 32, CV_LAYER = CV_WIN + CV_WBR + CV_WOUT + CV_W1 + CV_W2;
constexpr int CV_SLOT_A = 34000, CV_SLOT_B = 14000, CV_P0_L1 = CV_LAYER - CV_SLOT_A - CV_SLOT_B;
__device__ __forceinline__ void convert_items(Frame& F, int it0, int it1, int first, int stride) {
    LAS float* scr = (LAS float*)(F.lds + F.wave * 16384);
    for (int it = it0 + first; it < it1; it += stride) {
        const int l = it / CV_LAYER; int r = it - l * CV_LAYER;
        if (r < CV_WIN) { p0_transpose_item_f8(F.in[6] + (size_t)l * DM * INC, DM, INC, (unsigned char*)(F.ws + WS_WIN) + (size_t)l * INC * DM, 512, scr, r, F.lane); continue; } r -= CV_WIN;
        if (r < CV_WBR) { const int m = l * 3 + r / 256; p0_transpose_item(F.in[17] + (size_t)m * DB * DM, DB, DM, ((bf16*)(F.ws + WS_WBR)) + (size_t)m * DM * DB, 0, scr, r % 256, F.lane, DB, 1); continue; } r -= CV_WBR;
        if (r < CV_WOUT) { p0_transpose_item(F.in[18] + (size_t)l * DM * DM, DM, DM, ((bf16*)(F.ws + WS_WOUT)) + (size_t)l * DM * DM, 0, scr, r, F.lane, DM, 1); continue; } r -= CV_WOUT;
        if (r < CV_W1) { const int m = l * 32 + r / 1024; p0_transpose_item_f8(F.in[23] + (size_t)m * DM * 2048, DM, 2048, (unsigned char*)(F.ws + WS_W1) + (size_t)m * 2048 * DM, 1024, scr, r % 1024, F.lane); continue; } r -= CV_W1;
        { const int m = l * 32 + r / 512; p0_transpose_item_f8(F.in[25] + (size_t)m * DFF * DM, DFF, DM, (unsigned char*)(F.ws + WS_W2) + (size_t)m * DM * DFF, 0, scr, r % 512, F.lane); }
    }
}
__device__ __forceinline__ float fsilu(float x) { return x * fsigmoid(x); }
__device__ __forceinline__ void p0_prologue(Frame& F) {
    if (F.bid < 192) {
        LAS float* s = (LAS float*)F.lds;
        LAS float* red = (LAS float*)(F.lds + 17 * 4096);
        for (int i = F.tid; i < 17 * 1024; i += NTHR) { const int mi = i >> 10, k = i & 1023; s[i] = fsilu(mi < 16 ? F.in[1][mi * 1024 + k] : F.in[3][k]); }
        __syncthreads();
        const int layer = F.bid / 96, cg = F.bid % 96;
        const float* W = F.in[4] + (size_t)layer * DM * 6144 + cg * 64 + F.lane;
        float acc[17];
#pragma unroll
        for (int b = 0; b < 17; ++b) acc[b] = 0.f;
#pragma unroll 4
        for (int k = F.wave * 128; k < F.wave * 128 + 128; k += 4) {
            const float w0 = W[(size_t)k * 6144], w1 = W[(size_t)(k + 1) * 6144], w2 = W[(size_t)(k + 2) * 6144], w3 = W[(size_t)(k + 3) * 6144];
#pragma unroll
            for (int b = 0; b < 17; ++b) { const f32x4 sv = *(const LAS f32x4*)(s + b * 1024 + k); acc[b] += sv[0] * w0 + sv[1] * w1 + sv[2] * w2 + sv[3] * w3; }
        }
#pragma unroll
        for (int b = 0; b < 17; ++b) red[(F.wave * 17 + b) * 64 + F.lane] = acc[b];
        __syncthreads();
        for (int i = F.tid; i < 17 * 64; i += NTHR) { const int b = i >> 6, cl = i & 63; float t = 0.f;
#pragma unroll
            for (int w = 0; w < 8; ++w) t += red[(w * 17 + b) * 64 + cl];
            ((float*)(F.ws + WS_MOD))[((size_t)layer * 17 + b) * 6144 + cg * 64 + cl] = t + F.in[5][layer * 6144 + cg * 64 + cl]; }
        __syncthreads();
    } else if (F.bid == 255) {
        for (int i = F.tid; i < 1024; i += NTHR) { const int pos = i >> 4, fi = i & 15;
            double invf = 1.0; for (int q = 0; q < fi; ++q) invf *= 0.5623413251903491;
            const float ang = (float)pos * (float)invf;
            double a = (double)ang; const double tw = 6.283185307179586476925; a -= tw * __builtin_rint(a / tw);
            const double a2 = a * a; double sn = a, cs = 1.0, ts = a, tc = 1.0;
            for (int q = 1; q < 14; ++q) { tc *= -a2 / (double)((2 * q - 1) * (2 * q)); ts *= -a2 / (double)((2 * q) * (2 * q + 1)); cs += tc; sn += ts; }
            ((f32x2*)(F.ws + WS_ROPE))[i] = (f32x2){(float)cs, (float)sn}; }
    }
    __syncthreads();
    convert_items(F, 0, F.G == 256 ? CV_LAYER + CV_P0_L1 : 2 * CV_LAYER, F.bid * NWAVES + F.wave, F.G * NWAVES);
}
__device__ __forceinline__ void row_load(const float* p, int lane, f32x4 (&v)[4]) {
#pragma unroll
    for (int j = 0; j < 4; ++j) v[j] = ((const f32x4*)p)[lane + 64 * j];
}
__device__ __forceinline__ void row_ln(f32x4 (&v)[4]) {
    float s = 0.f;
#pragma unroll
    for (int j = 0; j < 4; ++j) s += (v[j][0] + v[j][1]) + (v[j][2] + v[j][3]);
    const float mean = wave_sum(s) * (1.f / DM); float q = 0.f;
#pragma unroll
    for (int j = 0; j < 4; ++j) { v[j] = v[j] - mean; q += (v[j][0] * v[j][0] + v[j][1] * v[j][1]) + (v[j][2] * v[j][2] + v[j][3] * v[j][3]); }
    const float rstd = 1.0f / sqrtf(wave_sum(q) * (1.f / DM) + LN_EPS);
#pragma unroll
    for (int j = 0; j < 4; ++j) v[j] = v[j] * rstd;
}
__device__ __forceinline__ void row_affine(f32x4 (&v)[4], const float* g, const float* b, int lane, bool plus1) {
#pragma unroll
    for (int j = 0; j < 4; ++j) { f32x4 gv = ((const f32x4*)g)[lane + 64 * j]; const f32x4 bv = ((const f32x4*)b)[lane + 64 * j]; if (plus1) gv = gv + 1.0f; v[j] = v[j] * gv + bv; }
}
__device__ __forceinline__ void row_store_bf16(bf16* p, int lane, const f32x4 (&v)[4]) {
#pragma unroll
    for (int j = 0; j < 4; ++j) { u32x2 w; w.x = f2bf(v[j][0]) | (f2bf(v[j][1]) << 16); w.y = f2bf(v[j][2]) | (f2bf(v[j][3]) << 16); ((u32x2*)p)[lane + 64 * j] = w; }
}
__device__ __forceinline__ void row_store_f8(unsigned char* p, int lane, const f32x4 (&v)[4]) {
#pragma unroll
    for (int j = 0; j < 4; ++j) { int a = 0; a = __builtin_amdgcn_cvt_pk_fp8_f32(v[j][0], v[j][1], a, false); a = __builtin_amdgcn_cvt_pk_fp8_f32(v[j][2], v[j][3], a, true); ((unsigned*)p)[lane + 64 * j] = (unsigned)a; }
}
__device__ __forceinline__ void row_store_f32(float* p, int lane, const f32x4 (&v)[4]) {
#pragma unroll
    for (int j = 0; j < 4; ++j) ((f32x4*)p)[lane + 64 * j] = v[j];
}
__device__ __forceinline__ int row_mi(int row) { return row < T_LAT ? (row >> 11) : 16; }

__device__ __forceinline__ void p1_modulate0(Frame& F) {
    const int gw = F.bid * NWAVES + F.wave, NGW = F.G * NWAVES;
    for (int row = gw; row < T_ALL; row += NGW) {
        f32x4 v[4]; row_load(row < T_LAT ? F.in[0] + (size_t)row * DM : F.in[2] + (size_t)(row - T_LAT) * DM, F.lane, v);
        row_ln(v); const float* md = ((float*)(F.ws + WS_MOD)) + (size_t)row_mi(row) * 6144; row_affine(v, md + 1024, md, F.lane, true);
        row_store_f8((unsigned char*)(F.ws + WS_H8) + (size_t)row * DM, F.lane, v);
    }
}
__device__ __forceinline__ void p8_final(Frame& F, int layer, int nrows) {
    const int gw = F.bid * NWAVES + F.wave, NGW = F.G * NWAVES;
    f32x4 xn[4]; unsigned yn[4][4];
#define P8_LOAD(r_) do { const int rl_ = (r_); row_load(((float*)(F.ws + WS_X)) + (size_t)rl_ * DM, F.lane, xn); \
        _Pragma("unroll") for (int j_ = 0; j_ < 4; ++j_) _Pragma("unroll") for (int k_ = 0; k_ < 4; ++k_) yn[j_][k_] = ((const unsigned*)(F.ws + WS_YK + ((size_t)rl_ * 4 + k_) * DM))[F.lane + 64 * j_]; } while (0)
    if (gw < nrows) P8_LOAD(gw);
    for (int row = gw; row < nrows; row += NGW) {
        f32x4 v[4]; unsigned yc[4][4];
#pragma unroll
        for (int j = 0; j < 4; ++j) { v[j] = xn[j];
#pragma unroll
            for (int k = 0; k < 4; ++k) yc[j][k] = yn[j][k]; }
        if (row + NGW < nrows) P8_LOAD(row + NGW);
        const float* md = ((float*)(F.ws + WS_MOD)) + ((size_t)layer * 17 + row_mi(row)) * 6144;
#pragma unroll
        for (int j = 0; j < 4; ++j) { f32x4 y = (f32x4){0.f, 0.f, 0.f, 0.f};
#pragma unroll
            for (int k = 0; k < 4; ++k) { const int w = (int)yc[j][k]; const f32x2 lo = __builtin_amdgcn_cvt_pk_f32_fp8(w, false), hi2 = __builtin_amdgcn_cvt_pk_f32_fp8(w, true); y[0] += lo[0]; y[1] += lo[1]; y[2] += hi2[0]; y[3] += hi2[1]; }
            const f32x4 g2 = ((const f32x4*)(md + 5120))[F.lane + 64 * j]; if (ABL & 1) y = y * 0.f; v[j] = v[j] * ALPHA + g2 * y; }
        row_ln(v); row_affine(v, F.in[27] + layer * DM, F.in[28] + layer * DM, F.lane, false);
        if (layer == DEPTH - 1) { row_store_f32((float*)(F.out + (size_t)row * DM), F.lane, v); }
        else { row_store_f32(((float*)(F.ws + WS_X)) + (size_t)row * DM, F.lane, v); row_ln(v); const float* mn = ((float*)(F.ws + WS_MOD)) + ((size_t)(layer + 1) * 17 + row_mi(row)) * 6144; row_affine(v, mn + 1024, mn, F.lane, true); row_store_f8((unsigned char*)(F.ws + WS_H8) + (size_t)row * DM, F.lane, v); }
    }
#undef P8_LOAD
}

constexpr int TS_STRIDE = 1028;
constexpr int P5_TS = 0, P5_PART = 16 * TS_STRIDE * 4, P5_LOG = P5_PART + 8 * 16 * 32 * 4, P5_REC = P5_LOG + 16 * 32 * 4;
__device__ __forceinline__ void p5_ln1_router(Frame& F, int layer, int nrows) {
    LAS float* TS = (LAS float*)(F.lds + P5_TS); LAS float* PART = (LAS float*)(F.lds + P5_PART); LAS float* LOG = (LAS float*)(F.lds + P5_LOG); LAS u32x4* REC = (LAS u32x4*)(F.lds + P5_REC);
    if (F.tid < 32) F.MISC[MI_LCNT + F.tid] = 0u;
    if (F.tid == 0) F.MISC[MI_NREC] = 0u;
    __syncthreads();
    const float* wr_ = F.in[21] + (size_t)layer * DM * NE; const float* br_ = F.in[22] + layer * NE;
    const int ngroups = nrows / 16;
    float wb0[32], wb1[32];
    { const float* bp = wr_ + (size_t)(F.wave * 128 + (F.lane >> 4)) * NE + (F.lane & 15);
#pragma unroll
      for (int s = 0; s < 32; ++s) { wb0[s] = bp[(size_t)(4 * s) * NE]; wb1[s] = bp[(size_t)(4 * s) * NE + 16]; } }
    const float brv = br_[F.tid & 31];
    f32x4 vpre[2][4]; u32x2 ypre[2][4];
#define P5_BAR() asm volatile("s_waitcnt lgkmcnt(0)\n\ts_barrier" ::: "memory")
#define P5_LOAD(g_) do { _Pragma("unroll") for (int rr = 0; rr < 2; ++rr) { const int row_ = (g_) * 16 + F.wave * 2 + rr; \
            row_load(layer == 0 ? (row_ < T_LAT ? F.in[0] + (size_t)row_ * DM : F.in[2] + (size_t)(row_ - T_LAT) * DM) : ((float*)(F.ws + WS_X)) + (size_t)row_ * DM, F.lane, vpre[rr]); \
            _Pragma("unroll") for (int j = 0; j < 4; ++j) ypre[rr][j] = ((const u32x2*)(((bf16*)(F.ws + WS_MV)) + (size_t)row_ * DM))[F.lane + 64 * j]; } } while (0)
    if (F.bid < ngroups) P5_LOAD(F.bid);
    for (int g = F.bid; g < ngroups; g += F.G) {
        f32x4 vcur[2][4];
#pragma unroll
        for (int rr = 0; rr < 2; ++rr)
#pragma unroll
            for (int j = 0; j < 4; ++j) { const u32x2 yw = ypre[rr][j]; vcur[rr][j] = vpre[rr][j] * ALPHA + (f32x4){bflo(yw.x), bfhi(yw.x), bflo(yw.y), bfhi(yw.y)}; }
        if (g + F.G < ngroups) P5_LOAD(g + F.G);
#pragma unroll
        for (int rr = 0; rr < 2; ++rr) { const int rl = F.wave * 2 + rr; const int row = g * 16 + rl;
            f32x4 v[4];
#pragma unroll
            for (int j = 0; j < 4; ++j) v[j] = vcur[rr][j];
            row_ln(v); row_affine(v, F.in[19] + layer * DM, F.in[20] + layer * DM, F.lane, false);
            row_store_f32(((float*)(F.ws + WS_X)) + (size_t)row * DM, F.lane, v);
            row_ln(v); const float* md = ((float*)(F.ws + WS_MOD)) + ((size_t)layer * 17 + row_mi(row)) * 6144; row_affine(v, md + 4096, md + 3072, F.lane, true);
#pragma unroll
            for (int j = 0; j < 4; ++j) { int a = 0; a = __builtin_amdgcn_cvt_pk_fp8_f32(v[j][0], v[j][1], a, false); a = __builtin_amdgcn_cvt_pk_fp8_f32(v[j][2], v[j][3], a, true); ((unsigned*)(F.ws + WS_H8 + (size_t)row * DM))[F.lane + 64 * j] = (unsigned)a; }
#pragma unroll
            for (int j = 0; j < 4; ++j) *(LAS f32x4*)(TS + rl * TS_STRIDE + 4 * (F.lane + 64 * j)) = v[j];
        }
        P5_BAR();
        { f32x4 a0 = (f32x4){0.f, 0.f, 0.f, 0.f}, a1 = a0; const int r16 = F.lane & 15, kq = F.lane >> 4;
            const LAS float* ap = TS + r16 * TS_STRIDE + F.wave * 128 + kq;
#pragma unroll
            for (int s = 0; s < 32; ++s) { const float a = ap[4 * s];
                a0 = __builtin_amdgcn_mfma_f32_16x16x4f32(a, wb0[s], a0, 0, 0, 0); a1 = __builtin_amdgcn_mfma_f32_16x16x4f32(a, wb1[s], a1, 0, 0, 0); }
#pragma unroll
            for (int i = 0; i < 4; ++i) { PART[(F.wave * 16 + 4 * kq + i) * 32 + r16] = a0[i]; PART[(F.wave * 16 + 4 * kq + i) * 32 + 16 + r16] = a1[i]; } }
        P5_BAR();
        { const int rl = F.tid >> 5, e = F.tid & 31; float t = brv;
#pragma unroll
            for (int w = 0; w < 8; ++w) t += PART[(w * 16 + rl) * 32 + e];
            float lv[4]; int li[4];
#pragma unroll
            for (int k = 0; k < 4; ++k) { float bv = t; int bi = e;
#define P5_STEP(C) { const float ov = dppx<C>(bv); const int oi = dppxi<C>(bi); const bool take = (ov > bv) || (ov == bv && oi < bi); bv = take ? ov : bv; bi = take ? oi : bi; }
                P5_STEP(0xB1) P5_STEP(0x4E) P5_STEP(0x141) P5_STEP(0x140)
#undef P5_STEP
                { const unsigned vb_ = __builtin_bit_cast(unsigned, bv); const auto rv = __builtin_amdgcn_permlane16_swap(vb_, vb_, false, false); const auto ri_ = __builtin_amdgcn_permlane16_swap((unsigned)bi, (unsigned)bi, false, false);
                  const float va = __builtin_bit_cast(float, (unsigned)rv[0]), vb2 = __builtin_bit_cast(float, (unsigned)rv[1]); const int ia = (int)ri_[0], ib = (int)ri_[1];
                  const bool take = (vb2 > va) || (vb2 == va && ib < ia); bv = take ? vb2 : va; bi = take ? ib : ia; }
                lv[k] = bv; li[k] = bi; if (e == bi) t = -INFINITY; }
            if (e < 4) { const int row = g * 16 + rl;
                const float e1 = __expf(lv[1] - lv[0]), e2 = __expf(lv[2] - lv[0]), e3 = __expf(lv[3] - lv[0]); const float inv = 1.0f / (1.0f + e1 + e2 + e3);
                const float wk = (e == 0 ? 1.0f : (e == 1 ? e1 : (e == 2 ? e2 : e3))) * inv; const int ek = e == 0 ? li[0] : (e == 1 ? li[1] : (e == 2 ? li[2] : li[3]));
                const unsigned p = __hip_atomic_fetch_add((LAS unsigned*)&F.MISC[MI_LCNT + ek], 1u, __ATOMIC_RELAXED, __HIP_MEMORY_SCOPE_WORKGROUP);
                const unsigned ri = __hip_atomic_fetch_add((LAS unsigned*)&F.MISC[MI_NREC], 1u, __ATOMIC_RELAXED, __HIP_MEMORY_SCOPE_WORKGROUP);
                REC[ri] = (u32x4){(unsigned)ek, p, (unsigned)(row * 4 + e), __builtin_bit_cast(unsigned, wk)}; } }
        P5_BAR();
    }
#undef P5_LOAD
#undef P5_BAR
    if (F.tid < 32) { const unsigned n = F.MISC[MI_LCNT + F.tid]; unsigned base = 0u; if (n) base = __hip_atomic_fetch_add(F.ctl + CW_ECNT + (layer * 32 + F.tid) * 64, n, RLX_AGENT); F.MISC[MI_LBASE + F.tid] = base; }
    __syncthreads();
    { const int nrec = (int)F.MISC[MI_NREC];
      for (int i = F.tid; i < nrec; i += NTHR) { const u32x4 r = REC[i]; ((u32x2*)(F.ws + WS_LIST))[(size_t)r.x * LIST_CAP + F.MISC[MI_LBASE + r.x] + r.y] = (u32x2){r.z, r.w}; } }
    __syncthreads();
}

constexpr int CV_T = 32, CV_ROWS = CV_T + 30, CV_GIN = 65536;
__device__ __forceinline__ void conv_units(Frame& F, int layer, int ntot) {
    LAS unsigned short* gin = (LAS unsigned short*)(F.lds + CV_GIN);
    LAS float* cout = (LAS float*)F.lds;
    const int c = F.tid;
    float w[CONVK];
#pragma unroll
    for (int j = 0; j < CONVK; ++j) w[j] = F.in[7][(size_t)layer * CONVK * DB + j * DB + c];
    const float bias = F.in[8][layer * DB + c];
    const f32x4 g0 = ((const f32x4*)(F.in[9] + layer * DB))[F.lane], g1 = ((const f32x4*)(F.in[9] + layer * DB))[F.lane + 64];
    const f32x4 b0 = ((const f32x4*)(F.in[10] + layer * DB))[F.lane], b1 = ((const f32x4*)(F.in[10] + layer * DB))[F.lane + 64];
    u32x4 v[8];
#define CV_DECODE(u_, base_, len_, t0_) const int s_ = (u_) < 1024 ? ((u_) >> 6) : 16 + (((u_) - 1024) >> 3), tt_ = (u_) < 1024 ? ((u_) & 63) : (((u_) - 1024) & 7); \
        const int base_ = s_ < 16 ? s_ * SEQ : T_LAT + (s_ - 16) * NCTX, len_ = s_ < 16 ? SEQ : NCTX, t0_ = tt_ * CV_T
#define CV_LOAD(u_) do { CV_DECODE(u_, bs_, ln_, tz_); _Pragma("unroll") for (int i = 0; i < 8; ++i) { const int p = F.tid + NTHR * i; const int r = p >> 6, ch = p & 63; const int t = tz_ - 15 + r; \
          v[i] = (u32x4){0u, 0u, 0u, 0u}; if (p < CV_ROWS * 64 && t >= 0 && t < ln_) v[i] = *(const u32x4*)(((bf16*)(F.ws + WS_U)) + (size_t)(bs_ + t) * INC + ch * 8); } } while (0)
#define CV_BAR() asm volatile("s_waitcnt lgkmcnt(0)\n\ts_barrier" ::: "memory")
    if (F.bid < ntot) CV_LOAD(F.bid);
    __syncthreads();
    for (int u = F.bid; u < ntot; u += F.G) {
        CV_DECODE(u, base, len, t0); (void)len;
#pragma unroll
        for (int i = 0; i < 8; ++i) { const int p = F.tid + NTHR * i; if (p < CV_ROWS * 64) *(LAS u32x4*)(gin + (p >> 6) * 512 + (p & 63) * 8) = v[i]; }
        if (u + F.G < ntot) CV_LOAD(u + F.G);
        CV_BAR();
#pragma unroll 1
        for (int g = 0; g < CV_T / 16; ++g) {
            float a[16];
#pragma unroll
            for (int i = 0; i < 16; ++i) a[i] = bias;
#pragma unroll
            for (int r = 0; r < 46; ++r) { const float x = bf2f(gin[(16 * g + r) * 512 + c]);
#pragma unroll
                for (int i = 0; i < 16; ++i) { const int j = r - i; if (j >= 0 && j < CONVK) a[i] += w[j] * x; } }
#pragma unroll
            for (int i = 0; i < 16; ++i) cout[(16 * g + i) * 512 + c] = a[i];
        }
        CV_BAR();
#pragma unroll 2
        for (int k = 0; k < CV_T / 8; ++k) { const int tk = F.wave * (CV_T / 8) + k;
            f32x4 v0 = *(const LAS f32x4*)(cout + tk * 512 + 4 * F.lane), v1 = *(const LAS f32x4*)(cout + tk * 512 + 256 + 4 * F.lane);
            float sm = (v0[0] + v0[1]) + (v0[2] + v0[3]) + (v1[0] + v1[1]) + (v1[2] + v1[3]);
            const float mean = wave_sum(sm) * (1.f / DB); v0 = v0 - mean; v1 = v1 - mean;
            float q = (v0[0] * v0[0] + v0[1] * v0[1]) + (v0[2] * v0[2] + v0[3] * v0[3]) + (v1[0] * v1[0] + v1[1] * v1[1]) + (v1[2] * v1[2] + v1[3] * v1[3]);
            const float rstd = 1.0f / sqrtf(wave_sum(q) * (1.f / DB) + LN_EPS);
            v0 = v0 * rstd * g0 + b0; v1 = v1 * rstd * g1 + b1;
            u32x2 o0, o1; o0.x = f2bf(fsilu(v0[0])) | (f2bf(fsilu(v0[1])) << 16); o0.y = f2bf(fsilu(v0[2])) | (f2bf(fsilu(v0[3])) << 16);
            o1.x = f2bf(fsilu(v1[0])) | (f2bf(fsilu(v1[1])) << 16); o1.y = f2bf(fsilu(v1[2])) | (f2bf(fsilu(v1[3])) << 16);
            bf16* dst = ((bf16*)(F.ws + WS_YA)) + (size_t)(base + t0 + tk) * DB; ((u32x2*)dst)[F.lane] = o0; ((u32x2*)dst)[F.lane + 64] = o1; }
    }
#undef CV_DECODE
#undef CV_LOAD
#undef CV_BAR
}

constexpr int ATT_KROW = 144, ATT_VROW = 144;
constexpr int ATT_KB = 64 * ATT_KROW, ATT_VB = 128 * ATT_VROW, ATT_BUF = ATT_KB + ATT_VB;
constexpr int ATT_RPB = 2 * ATT_BUF;
__device__ __forceinline__ int crow(int r, int hi) { return (r & 3) + 8 * (r >> 2) + 4 * hi; }

template <int DV, bool NAT>
__device__ __forceinline__ void attn_pass(Frame& F, const bf16* VT  , int kcol, int nA, int rowA0, int keyA0, int nB, int rowB0, int keyB0,
                                          const bf16x8 (&qf)[4], f32x16 (&o)[DV / 32], float& m_run, float& l_run,
                                          int my_r, int kr0, int qc, int wrow0 = 0, int w0 = 0) {
    const int tid = F.tid, lane = F.lane, q32 = lane & 31, hi = lane >> 5;
    const int nT = nA + nB;
    const int krow = tid >> 3, kch = tid & 7;
    u32x4 kreg, vreg[DV / 64], kreg1, vreg1[DV / 64];
#define ATT_LOAD2(t, KR, VR) do { const int t_ = (t); const int r0_ = t_ < nA ? rowA0 + 64 * t_ : rowB0 + 64 * (t_ - nA); const int k0_ = t_ < nA ? keyA0 + 64 * t_ : keyB0 + 64 * (t_ - nA); \
        KR = *(const u32x4*)(((bf16*)(F.ws + WS_U)) + (size_t)(r0_ + krow) * INC + kcol + kch * 8); \
        _Pragma("unroll") for (int i_ = 0; i_ < DV / 64; ++i_) { const int p_ = tid + NTHR * i_; VR[i_] = *(const u32x4*)(VT + (size_t)(p_ >> 3) * KEYS + k0_ + (p_ & 7) * 8); } } while (0)
#define ATT_STORE2(b, KR, VR) do { LAS unsigned char* kb_ = F.lds + (b) * ATT_BUF; *(LAS u32x4*)(kb_ + krow * ATT_KROW + kch * 16) = KR; \
        _Pragma("unroll") for (int i_ = 0; i_ < DV / 64; ++i_) { const int p_ = tid + NTHR * i_; LAS unsigned char* d_ = kb_ + ATT_KB + (p_ >> 3) * ATT_VROW + (p_ & 7) * 16; \
            *(LAS u32x4*)d_ = VR[i_]; } } while (0)
#define ATT_LOAD(t) ATT_LOAD2(t, kreg, vreg)
#define ATT_STORE(b) ATT_STORE2(b, kreg, vreg)
#define ATT_LBAR() asm volatile("s_waitcnt lgkmcnt(0)\n\ts_barrier" ::: "memory")
    ATT_LBAR();
    ATT_LOAD(0); if (NAT && nT > 1) ATT_LOAD2(1, kreg1, vreg1); ATT_STORE(0);
    ATT_LBAR();
    const int rs_my = NAT ? (my_r < 4 ? 0 : (my_r > 28 ? 24 : my_r - 4)) : 0;
    const int cs_my = NAT ? (qc < 8 ? 0 : (qc > 56 ? 48 : qc - 8)) : 0;
    const int rs_wlo = NAT ? (wrow0 < 4 ? 0 : (wrow0 > 28 ? 24 : wrow0 - 4)) : 0, rs_whi = NAT ? (wrow0 + 1 < 4 ? 0 : (wrow0 + 1 > 28 ? 24 : wrow0 + 1 - 4)) : 0;
    const int sig32 = (q32 & ~12) | ((q32 & 4) << 1) | ((q32 & 8) >> 1);
    auto tile = [&](const int t) __attribute__((always_inline)) {
        if (NAT && t < nA) {
          const int kr = kr0 + t;
          if (kr >= rs_wlo && kr < rs_whi + 8) {
            const LAS unsigned char* kb = F.lds + (t & 1) * ATT_BUF; const LAS unsigned char* vb = kb + ATT_KB;
            f32x16 p0;
#pragma unroll
            for (int i = 0; i < 16; ++i) p0[i] = 0.f;
            {   const unsigned ka = (unsigned)(unsigned long)kb + (unsigned)((w0 + sig32) * ATT_KROW + hi * 16);
                bf16x8 kf[4];
#define ATT_DSR(dst, addr, off) asm volatile("ds_read_b128 %0, %1 offset:%2" : "=v"(dst) : "v"(addr), "i"(off))
                ATT_DSR(kf[0], ka, 0); ATT_DSR(kf[1], ka, 32); ATT_DSR(kf[2], ka, 64); ATT_DSR(kf[3], ka, 96);
                asm volatile("s_waitcnt lgkmcnt(0)" : "+v"(kf[0]), "+v"(kf[1]), "+v"(kf[2]), "+v"(kf[3]));
#pragma unroll
                for (int d0 = 0; d0 < 4; ++d0) p0 = __builtin_amdgcn_mfma_f32_32x32x16_bf16(kf[d0], qf[d0], p0, 0, 0, 0);
#undef ATT_DSR
            }
            {   const bool rowok = (kr >= rs_my) && (kr < rs_my + 8);
                const LAS float* rpb = (const LAS float*)(F.lds + ATT_RPB) + (rowok ? kr - my_r + 7 : 7) * 31 + 15 - qc;
#pragma unroll
                for (int r = 0; r < 16; ++r) { const int kc = w0 + (r & 7) + 8 * hi + 16 * (r >> 3);
                    const bool v0 = rowok && ((unsigned)(kc - cs_my) < 16u);
                    const float bb0 = rpb[v0 ? kc : qc];
                    p0[r] = v0 ? p0[r] + bb0 : -INFINITY; }
            }
            float tm = p0[0];
#pragma unroll
            for (int r = 1; r < 16; ++r) tm = fmaxf(tm, p0[r]);
            if (__builtin_expect(__any(tm - m_run > 8.0f), 0)) { tm = fmaxf(tm, sx(tm, 32)) - m_run; const float dl = fmaxf(tm, 0.f);     m_run += dl; const float alpha = __builtin_amdgcn_exp2f(-dl); l_run *= alpha;
#pragma unroll
                for (int d = 0; d < DV / 32; ++d)
#pragma unroll
                    for (int r = 0; r < 16; ++r) o[d][r] *= alpha; }
            {   constexpr int ND = DV / 32;
                const unsigned va = (unsigned)(unsigned long)vb + (unsigned)(q32 * ATT_VROW + 16 * hi + 2 * w0);
                bf16x8 vA[2 * ND];
#define ATT_DSR(dst, addr, off) asm volatile("ds_read_b128 %0, %1 offset:%2" : "=v"(dst) : "v"(addr), "i"(off))
#pragma unroll
                for (int d = 0; d < ND; ++d) { ATT_DSR(vA[d], va, d * 32 * ATT_VROW); ATT_DSR(vA[ND + d], va, d * 32 * ATT_VROW + 32); }
#undef ATT_DSR
                float ls = 0.f;
#pragma unroll
                for (int r = 0; r < 16; ++r) { p0[r] = __builtin_amdgcn_exp2f(p0[r] - m_run); ls += p0[r]; }
                l_run += ls;
                u32x4 pw[2];
#pragma unroll
                for (int q = 0; q < 2; ++q) { const int s8 = 8 * q; pw[q].x = pk2(p0[s8 + 0], p0[s8 + 1]); pw[q].y = pk2(p0[s8 + 2], p0[s8 + 3]); pw[q].z = pk2(p0[s8 + 4], p0[s8 + 5]); pw[q].w = pk2(p0[s8 + 6], p0[s8 + 7]); }
                if constexpr (ND == 2) asm volatile("s_waitcnt lgkmcnt(0)" : "+v"(vA[0]), "+v"(vA[1]), "+v"(vA[2]), "+v"(vA[3]));
#pragma unroll
                for (int q = 0; q < 2; ++q)
#pragma unroll
                    for (int d = 0; d < ND; ++d) o[d] = __builtin_amdgcn_mfma_f32_32x32x16_bf16(vA[q * ND + d], __builtin_bit_cast(bf16x8, pw[q]), o[d], 0, 0, 0);
            }
          }
        } else {
            const LAS unsigned char* kb = F.lds + (t & 1) * ATT_BUF; const LAS unsigned char* vb = kb + ATT_KB;
            f32x16 p0, p1;
#pragma unroll
            for (int i = 0; i < 16; ++i) { p0[i] = 0.f; p1[i] = 0.f; }
            {
                const unsigned ka = (unsigned)(unsigned long)kb + (unsigned)(sig32 * ATT_KROW + hi * 16);
                bf16x8 kf[8];
#define ATT_DSR(dst, addr, off) asm volatile("ds_read_b128 %0, %1 offset:%2" : "=v"(dst) : "v"(addr), "i"(off))
                ATT_DSR(kf[0], ka, 0); ATT_DSR(kf[1], ka, 32 * ATT_KROW); ATT_DSR(kf[2], ka, 32); ATT_DSR(kf[3], ka, 32 * ATT_KROW + 32);
                ATT_DSR(kf[4], ka, 64); ATT_DSR(kf[5], ka, 32 * ATT_KROW + 64); ATT_DSR(kf[6], ka, 96); ATT_DSR(kf[7], ka, 32 * ATT_KROW + 96);
                asm volatile("s_waitcnt lgkmcnt(0)" : "+v"(kf[0]), "+v"(kf[1]), "+v"(kf[2]), "+v"(kf[3]), "+v"(kf[4]), "+v"(kf[5]), "+v"(kf[6]), "+v"(kf[7]));
#pragma unroll
                for (int d0 = 0; d0 < 4; ++d0) {
                    p0 = __builtin_amdgcn_mfma_f32_32x32x16_bf16(kf[2 * d0], qf[d0], p0, 0, 0, 0);
                    p1 = __builtin_amdgcn_mfma_f32_32x32x16_bf16(kf[2 * d0 + 1], qf[d0], p1, 0, 0, 0);
                }
            }
            float tm = fmaxf(p0[0], p1[0]);
#pragma unroll
            for (int r = 1; r < 16; ++r) tm = fmaxf(tm, fmaxf(p0[r], p1[r]));
            if (__builtin_expect(__any(tm - m_run > 8.0f), 0)) { tm = fmaxf(tm, sx(tm, 32)) - m_run; const float dl = fmaxf(tm, 0.f); m_run += dl; const float alpha = __builtin_amdgcn_exp2f(-dl); l_run *= alpha;
#pragma unroll
                for (int d = 0; d < DV / 32; ++d)
#pragma unroll
                    for (int r = 0; r < 16; ++r) o[d][r] *= alpha; }
            const bool shifted = __any(m_run != 0.f);
            float ls = 0.f;
            if (shifted) {
#pragma unroll
                for (int r = 0; r < 16; ++r) { p0[r] = __builtin_amdgcn_exp2f(p0[r] - m_run); ls += p0[r]; }
            } else {
#pragma unroll
                for (int r = 0; r < 16; ++r) { p0[r] = __builtin_amdgcn_exp2f(p0[r]); ls += p0[r]; }
            }
            {   constexpr int ND = DV / 32;
                const unsigned va = (unsigned)(unsigned long)vb + (unsigned)(q32 * ATT_VROW + 16 * hi);
                bf16x8 vA[2 * ND], vB[2 * ND];
#define ATT_PIN_WAIT(v) do { if constexpr (ND == 4) asm volatile("s_waitcnt lgkmcnt(0)" : "+v"(v[0]), "+v"(v[1]), "+v"(v[2]), "+v"(v[3]), "+v"(v[4]), "+v"(v[5]), "+v"(v[6]), "+v"(v[7])); \
                                  else asm volatile("s_waitcnt lgkmcnt(0)" : "+v"(v[0]), "+v"(v[1]), "+v"(v[2]), "+v"(v[3])); } while (0)
#pragma unroll
                for (int d = 0; d < ND; ++d) { ATT_DSR(vA[d], va, d * 32 * ATT_VROW); ATT_DSR(vA[ND + d], va, d * 32 * ATT_VROW + 32); }
                u32x4 pw[4];
#pragma unroll
                for (int q = 0; q < 2; ++q) { const int s8 = 8 * q; pw[q].x = pk2(p0[s8 + 0], p0[s8 + 1]); pw[q].y = pk2(p0[s8 + 2], p0[s8 + 3]); pw[q].z = pk2(p0[s8 + 4], p0[s8 + 5]); pw[q].w = pk2(p0[s8 + 6], p0[s8 + 7]); }
                ATT_PIN_WAIT(vA);
#pragma unroll
                for (int d = 0; d < ND; ++d) { ATT_DSR(vB[d], va, d * 32 * ATT_VROW + 64); ATT_DSR(vB[ND + d], va, d * 32 * ATT_VROW + 96); }
#pragma unroll
                for (int q = 0; q < 2; ++q)
#pragma unroll
                    for (int d = 0; d < ND; ++d) o[d] = __builtin_amdgcn_mfma_f32_32x32x16_bf16(vA[q * ND + d], __builtin_bit_cast(bf16x8, pw[q]), o[d], 0, 0, 0);
                if (shifted) {
#pragma unroll
                    for (int r = 0; r < 16; ++r) { p1[r] = __builtin_amdgcn_exp2f(p1[r] - m_run); ls += p1[r]; }
                } else {
#pragma unroll
                    for (int r = 0; r < 16; ++r) { p1[r] = __builtin_amdgcn_exp2f(p1[r]); ls += p1[r]; }
                }
#pragma unroll
                for (int q = 0; q < 2; ++q) { const int s8 = 8 * q; pw[2 + q].x = pk2(p1[s8 + 0], p1[s8 + 1]); pw[2 + q].y = pk2(p1[s8 + 2], p1[s8 + 3]); pw[2 + q].z = pk2(p1[s8 + 4], p1[s8 + 5]); pw[2 + q].w = pk2(p1[s8 + 6], p1[s8 + 7]); }
#pragma unroll
                for (int i = 0; i < 2 * ND; ++i) { __builtin_amdgcn_sched_group_barrier(0x008, 1, 0); __builtin_amdgcn_sched_group_barrier(0x002, 40 / (2 * ND) + 1, 0); }
                l_run += ls;
                ATT_PIN_WAIT(vB);
#pragma unroll
                for (int q = 0; q < 2; ++q)
#pragma unroll
                    for (int d = 0; d < ND; ++d) o[d] = __builtin_amdgcn_mfma_f32_32x32x16_bf16(vB[q * ND + d], __builtin_bit_cast(bf16x8, pw[2 + q]), o[d], 0, 0, 0);
#undef ATT_PIN_WAIT
            }
        }
    };
    if constexpr (NAT) {
        for (int t = 0; t < nT; t += 2) {
            if (t + 2 < nT) ATT_LOAD2(t + 2, kreg, vreg);
            tile(t);
            if (t + 1 < nT) ATT_STORE2(1, kreg1, vreg1);
            ATT_LBAR();
            if (t + 1 >= nT) break;
            if (t + 3 < nT) ATT_LOAD2(t + 3, kreg1, vreg1);
            tile(t + 1);
            if (t + 2 < nT) ATT_STORE2(0, kreg, vreg);
            ATT_LBAR();
        }
    } else {
    for (int t = 0; t < nT; ++t) {
        const bool more = t + 1 < nT;
        if (more) ATT_LOAD(t + 1);
        tile(t);
        if (more) ATT_STORE((t + 1) & 1);
        ATT_LBAR();
    }
    }
#undef ATT_LOAD
#undef ATT_STORE
#undef ATT_LOAD2
#undef ATT_LBAR
#undef ATT_STORE2
}
__device__ __forceinline__ void load_qf(const bf16* qrow  , int hi, bf16x8 (&qf)[4]) {
#pragma unroll
    for (int d0 = 0; d0 < 4; ++d0) qf[d0] = *(const bf16x8*)(qrow + d0 * 16 + hi * 8);
}
__device__ __forceinline__ void diff_unit(Frame& F, int layer, int b, int h, int qrow0, bool lat, const float lam, const float lam_init) {
    const int lane = F.lane, q32 = lane & 31, hi = lane >> 5; const int row = qrow0 + F.wave * 32 + q32;
    const bf16* VT = ((bf16*)(F.ws + WS_VTD)) + (size_t)((b * 4 + h) * 128) * KEYS;
    const int nB = lat ? 32 : 0;
    LAS unsigned* o1s = (LAS unsigned*)(F.lds + 65536) + F.wave * 2048 + lane;
    {   f32x16 o1[4]; bf16x8 qf[4]; load_qf(((bf16*)(F.ws + WS_U)) + (size_t)row * INC + C_DQ + 128 * h, hi, qf);
        float m = 0.f, l = 0.f;
#pragma unroll
        for (int d = 0; d < 4; ++d)
#pragma unroll
            for (int r = 0; r < 16; ++r) o1[d][r] = 0.f;
        attn_pass<128, false>(F, VT, C_DK + 128 * h, 4, T_LAT + b * NCTX, 0, nB, b * SEQ, NCTX, qf, o1, m, l, 0, 0, 0);
        l += sx(l, 32); const float il = 1.0f / l;
#pragma unroll
        for (int d = 0; d < 4; ++d)
#pragma unroll
            for (int r = 0; r < 8; ++r) o1s[(d * 8 + r) * 64] = pk2(o1[d][2 * r] * il, o1[d][2 * r + 1] * il); }
    {   f32x16 o2[4]; bf16x8 qf[4]; load_qf(((bf16*)(F.ws + WS_U)) + (size_t)row * INC + C_DQ + 128 * h + 64, hi, qf);
        float m = 0.f, l = 0.f;
#pragma unroll
        for (int d = 0; d < 4; ++d)
#pragma unroll
            for (int r = 0; r < 16; ++r) o2[d][r] = 0.f;
        attn_pass<128, false>(F, VT, C_DK + 128 * h + 64, 4, T_LAT + b * NCTX, 0, nB, b * SEQ, NCTX, qf, o2, m, l, 0, 0, 0);
        l += sx(l, 32); const float il = lam / l;
        float ss = 0.f;
#pragma unroll
        for (int d = 0; d < 4; ++d)
#pragma unroll
            for (int r = 0; r < 8; ++r) { const unsigned ow = o1s[(d * 8 + r) * 64]; const float a0 = bflo(ow) - il * o2[d][2 * r], a1 = bfhi(ow) - il * o2[d][2 * r + 1]; o2[d][2 * r] = a0; o2[d][2 * r + 1] = a1; ss += a0 * a0 + a1 * a1; }
        ss += sx(ss, 32);
        const float rn = (1.0f / sqrtf(ss * (1.0f / 128.0f) + LN_EPS)) * (1.0f - lam_init);
        const float* sg = F.in[15] + layer * 128;
        bf16* dst = ((bf16*)(F.ws + WS_YB)) + (size_t)row * DB + 128 * h;
#pragma unroll
        for (int d = 0; d < 4; ++d)
#pragma unroll
            for (int rp = 0; rp < 2; ++rp) { unsigned wx[2], wy[2];
#pragma unroll
                for (int k = 0; k < 2; ++k) { const int r4 = 2 * rp + k; const int dv = 32 * d + 8 * r4 + 4 * hi; const f32x4 g = *(const f32x4*)(sg + dv);
                    wx[k] = pk2(o2[d][4 * r4] * rn * g[0], o2[d][4 * r4 + 1] * rn * g[1]); wy[k] = pk2(o2[d][4 * r4 + 2] * rn * g[2], o2[d][4 * r4 + 3] * rn * g[3]); }
                swap32(wx[0], wx[1]); swap32(wy[0], wy[1]);
                *(u32x4*)(dst + 32 * d + 16 * rp + 8 * hi) = (u32x4){wx[0], wy[0], wx[1], wy[1]}; } }
}
__device__ __forceinline__ void nat_unit(Frame& F, int layer, int b, int h, int rq) {
    const int lane = F.lane, q32 = lane & 31, hi = lane >> 5;
    const int wrow0 = 4 * rq + 2 * (F.wave >> 2), c0 = 16 * (F.wave & 3);
    const int w0 = c0 < 8 ? 0 : (c0 - 8 > 32 ? 32 : c0 - 8);
    const int my_r = wrow0 + (q32 >> 4), qc = c0 + (q32 & 15); const int row = b * SEQ + 64 * my_r + qc;
    if ((F.G & 63) != 0) { __syncthreads(); LAS float* rp = (LAS float*)(F.lds + ATT_RPB); const float* src = F.in[16] + ((size_t)layer * 8 + h) * 465; for (int i = F.tid; i < 465; i += NTHR) rp[i] = src[i] * LOG2E; }
    const int r_lo = 4 * rq, r_hi = 4 * rq + 3;
    const int kr0 = r_lo < 4 ? 0 : (r_lo > 28 ? 24 : r_lo - 4); const int krl = (r_hi < 4 ? 0 : (r_hi > 28 ? 24 : r_hi - 4)) + 7;
    const int nloc = krl - kr0 + 1;
    bf16x8 qf[4]; load_qf(((bf16*)(F.ws + WS_U)) + (size_t)row * INC + C_NQ + 64 * h, hi, qf);
    f32x16 o[2]; float m = 0.f, l = 0.f;
#pragma unroll
    for (int d = 0; d < 2; ++d)
#pragma unroll
        for (int r = 0; r < 16; ++r) o[d][r] = 0.f;
    attn_pass<64, true>(F, ((bf16*)(F.ws + WS_VTN)) + (size_t)((b * 8 + h) * 64) * KEYS, C_NK + 64 * h, nloc, b * SEQ + 64 * kr0, NCTX + 64 * kr0, 4, T_LAT + b * NCTX, 0, qf, o, m, l, my_r, kr0, qc, __builtin_amdgcn_readfirstlane(wrow0), __builtin_amdgcn_readfirstlane(w0));
    l += sx(l, 32); const float il = 1.0f / l;
    bf16* dst = ((bf16*)(F.ws + WS_YC)) + (size_t)row * DB + 64 * h;
#pragma unroll
    for (int d = 0; d < 2; ++d)
#pragma unroll
        for (int rp = 0; rp < 2; ++rp) { unsigned wx[2], wy[2];
#pragma unroll
            for (int k = 0; k < 2; ++k) { const int r4 = 2 * rp + k; wx[k] = pk2(o[d][4 * r4] * il, o[d][4 * r4 + 1] * il); wy[k] = pk2(o[d][4 * r4 + 2] * il, o[d][4 * r4 + 3] * il); }
            swap32(wx[0], wx[1]); swap32(wy[0], wy[1]);
            *(u32x4*)(dst + 32 * d + 16 * rp + 8 * hi) = (u32x4){wx[0], wy[0], wx[1], wy[1]}; }
}
__device__ __forceinline__ void natctx_unit(Frame& F, int b, int h) {
    const int lane = F.lane, q32 = lane & 31, hi = lane >> 5; const int row = T_LAT + b * NCTX + F.wave * 32 + q32;
    bf16x8 qf[4]; load_qf(((bf16*)(F.ws + WS_U)) + (size_t)row * INC + C_NQ + 64 * h, hi, qf);
    f32x16 o[2]; float m = 0.f, l = 0.f;
#pragma unroll
    for (int d = 0; d < 2; ++d)
#pragma unroll
        for (int r = 0; r < 16; ++r) o[d][r] = 0.f;
    attn_pass<64, false>(F, ((bf16*)(F.ws + WS_VTN)) + (size_t)((b * 8 + h) * 64) * KEYS, C_NK + 64 * h, 4, T_LAT + b * NCTX, 0, 0, 0, 0, qf, o, m, l, 0, 0, 0);
    l += sx(l, 32); const float il = 1.0f / l;
    bf16* dst = ((bf16*)(F.ws + WS_YC)) + (size_t)row * DB + 64 * h;
#pragma unroll
    for (int d = 0; d < 2; ++d)
#pragma unroll
        for (int rp = 0; rp < 2; ++rp) { unsigned wx[2], wy[2];
#pragma unroll
            for (int k = 0; k < 2; ++k) { const int r4 = 2 * rp + k; wx[k] = pk2(o[d][4 * r4] * il, o[d][4 * r4 + 1] * il); wy[k] = pk2(o[d][4 * r4 + 2] * il, o[d][4 * r4 + 3] * il); }
            swap32(wx[0], wx[1]); swap32(wy[0], wy[1]);
            *(u32x4*)(dst + 32 * d + 16 * rp + 8 * hi) = (u32x4){wx[0], wy[0], wx[1], wy[1]}; }
}

constexpr int N_PHASES = 2 + 8 * DEPTH;
struct Args { const float* in[29]; float* out; unsigned char* ws; int ph_lo, ph_hi; };
__global__ void diag_nan_scan(const float* out, unsigned* res) {
    const int row = blockIdx.x; bool bad = false;
    for (int c = threadIdx.x; c < DM; c += blockDim.x) { const float v = out[(size_t)row * DM + c]; if (!(fabsf(v) < 3.0e38f)) bad = true; }
    if (__syncthreads_or(bad) && threadIdx.x == 0) { atomicAdd(&res[0], 1u); atomicMin(&res[1], (unsigned)row); atomicMax(&res[2], (unsigned)row); }
}
__global__ void diag_fill(float* out, const unsigned* res, int which) {
    float c = 0.f; if (which == 0) c = (float)res[0] / 16.f; if (which == 1) c = (float)(res[1] >> 8) + 1.f; if (which == 2) c = (float)(res[2] >> 8) + 1.f; if (which == 3) c = (float)(res[1] & 255) + 1.f;
    for (size_t i = (size_t)blockIdx.x * blockDim.x + threadIdx.x; i < (size_t)T_LAT * DM; i += (size_t)gridDim.x * blockDim.x) out[i] = c;
}
#ifndef DIAG_MODE
#define DIAG_MODE 34
#endif
__global__ void diag_copy_kernel(const unsigned char* ws, float* out) {
    for (size_t i = (size_t)blockIdx.x * blockDim.x + threadIdx.x; i < (size_t)T_LAT * DM; i += (size_t)gridDim.x * blockDim.x) {
        const int r = (int)(i >> 10), c = (int)(i & 1023); float v = 0.f;
        if (DIAG_MODE == 0) v = ((const float*)(ws + WS_X))[i];
        if (DIAG_MODE == 1) { const bf16* U = (const bf16*)(ws + WS_U); for (int k = 0; k < 7; ++k) v += bf2f(U[(size_t)r * INC + c + 1024 * k]) + bf2f(U[(size_t)(T_LAT + (r & 4095)) * INC + c + 1024 * k]);
            if (i < (size_t)16 * 4 * 128 * KEYS) v += bf2f(((const bf16*)(ws + WS_VTD))[i]) + bf2f(((const bf16*)(ws + WS_VTN))[i]); }
        if (DIAG_MODE == 2) { v = c < 512 ? bf2f(((const bf16*)(ws + WS_YA))[(size_t)r * DB + c]) + 2.f * bf2f(((const bf16*)(ws + WS_YB))[(size_t)r * DB + c]) : bf2f(((const bf16*)(ws + WS_YC))[(size_t)r * DB + c - 512]);
            v += c < 512 ? bf2f(((const bf16*)(ws + WS_YA))[(size_t)(T_LAT + (r & 4095)) * DB + c]) + 2.f * bf2f(((const bf16*)(ws + WS_YB))[(size_t)(T_LAT + (r & 4095)) * DB + c]) : bf2f(((const bf16*)(ws + WS_YC))[(size_t)(T_LAT + (r & 4095)) * DB + c - 512]); }
        if (DIAG_MODE == 6) { const bf16* U = (const bf16*)(ws + WS_U); for (int k = 4; k < 7; ++k) v += bf2f(U[(size_t)r * INC + c + 1024 * k]) + bf2f(U[(size_t)(T_LAT + (r & 4095)) * INC + c + 1024 * k]); }
        if (DIAG_MODE == 7) { const bf16* U = (const bf16*)(ws + WS_U); const int cc = c & 511; v = bf2f(U[(size_t)r * INC + cc]) + bf2f(U[(size_t)r * INC + 1024 + c]) + bf2f(U[(size_t)r * INC + 2560 + c]) + bf2f(U[(size_t)(T_LAT + (r & 4095)) * INC + cc]) + bf2f(U[(size_t)(T_LAT + (r & 4095)) * INC + 1024 + c]) + bf2f(U[(size_t)(T_LAT + (r & 4095)) * INC + 2560 + c]); }
        if (DIAG_MODE == 8) { const bf16* W = (const bf16*)(ws + WS_WIN); v = bf2f(W[(size_t)(r % 7168) * DM + c]) + bf2f(W[(size_t)(7168 + (r % 7168)) * DM + c]); }
        if (DIAG_MODE == 20) { const unsigned* ctl = (const unsigned*)(ws + WS_CTL); unsigned t = 0; for (int e = 0; e < 32; ++e) t += ctl[CW_ECNT + e * 64]; v = 10.f * (float)t / 147456.f; }
        if (DIAG_MODE == 21) { const bf16* Y = (const bf16*)(ws + WS_YK); float a = 0.f; for (int k = 0; k < 256; ++k) a += fabsf(bf2f(Y[(size_t)k * 500009 + (i & 65535)])); v = 100.f * a / 256.f; }
        if (DIAG_MODE == 22) { const bf16* Y = (const bf16*)(ws + WS_U); float a = 0.f; for (int k = 0; k < 256; ++k) a += fabsf(bf2f(Y[(size_t)k * 500009 + (i & 65535)])); v = 100.f * a / 256.f; }
        if (DIAG_MODE == 23) { const u32x2* L = (const u32x2*)(ws + WS_LIST); float a = 0.f; for (int e = 0; e < 32; ++e) for (int k = 0; k < 8; ++k) a += __builtin_bit_cast(float, L[(size_t)e * LIST_CAP + k * 100].y); v = 100.f * a / 256.f; }
        if (DIAG_MODE == 24) { const u32x2* L = (const u32x2*)(ws + WS_LIST); float a = 0.f; for (int e = 0; e < 32; ++e) for (int k = 0; k < 8; ++k) a += (L[(size_t)e * LIST_CAP + k * 100].x < 131072u) ? 1.f : 0.f; v = 10.f * a / 256.f; }
        if (DIAG_MODE == 25) { const unsigned short* Y = (const unsigned short*)(ws + WS_YK); float a = 0.f; for (int k = 0; k < 256; ++k) a += (Y[(size_t)k * 500009 + (i & 65535)] != 0xAAAAu) ? 1.f : 0.f; v = 10.f * a / 256.f; }
        if (DIAG_MODE == 27) { const u32x2* L = (const u32x2*)(ws + WS_LIST); float a = 0.f; for (int e = 0; e < 32; ++e) for (int k = 0; k < 8; ++k) a += (float)(L[(size_t)e * LIST_CAP + k * 100].y >> 20); v = a / 256.f; }
        if (DIAG_MODE == 28) { const u32x2* L = (const u32x2*)(ws + WS_LIST); float a = 0.f; for (int e = 0; e < 32; ++e) for (int k = 0; k < 8; ++k) { const float w = __builtin_bit_cast(float, L[(size_t)e * LIST_CAP + k * 100].y); a += (w > 0.01f && w < 1.0f) ? 1.f : 0.f; } v = a / 25.6f; }
        if (DIAG_MODE == 29) { const u32x2* L = (const u32x2*)(ws + WS_LIST); float a = 0.f; for (int e = 0; e < 32; ++e) for (int k = 0; k < 8; ++k) a += ((L[(size_t)e * LIST_CAP + k * 100].y >> 20) > 2000u) ? 1.f : 0.f; v = a / 25.6f; }
        if (DIAG_MODE == 31) { const u32x2* L = (const u32x2*)(ws + WS_LIST); v = 100.f * __builtin_bit_cast(float, L[5].y); }
        if (DIAG_MODE == 32) { const u32x2* L = (const u32x2*)(ws + WS_LIST); v = (float)(L[5].y >> 20); }
        if (DIAG_MODE == 33) { v = 25.f; }
        if (DIAG_MODE == 34) { const u32x2* L = (const u32x2*)(ws + WS_LIST); const unsigned y = L[5].y; v = (y > 0x3C000000u && y < 0x3F800001u) ? 25.f : ((y >> 20) < 944u ? 50.f : 75.f); }
        if (DIAG_MODE == 3) { const bf16* Z = (const bf16*)(ws + WS_MB); v = bf2f(Z[(size_t)r * DM + c]);
#if !defined(DIAG_ONEJ)
 v += bf2f(Z[(size_t)r * 3072 + 1024 + c]) + bf2f(Z[(size_t)r * 3072 + 2048 + c]);
#endif
 }
        if (DIAG_MODE == 4) v = ((const float*)(ws + WS_MV))[i];
        if (DIAG_MODE == 5) v = bf2f(((const bf16*)(ws + WS_H))[i]);
        out[i] = v; }
}
#ifndef PHASE_MASK
#define PHASE_MASK 0xffffffffu
#endif
#define PMASK(k) ((PHASE_MASK >> (((k) < 2) ? (k) : 2 + (((k) - 2) & 7))) & 1u)
#define IN(k) (PMASK(k) && lo <= (k) && (k) < hi)
#define LAUNDER() do { int wv_ = F.wave0; asm volatile("" : "+s"(wv_)); const int t_ = (wv_ << 6) | lane_now(); F.tid = t_; F.lane = t_ & 63; F.wave = wv_; unsigned char* w_ = args.ws; asm volatile("" : "+s"(w_)); F.ws = (GAS unsigned char*)w_; F.ctl = (gu32*)(w_ + WS_CTL); unsigned long long z_ = 0; asm volatile("" : "+s"(z_)); F.in = args.in + z_; int b_ = blockIdx.x, g_ = gridDim.x; asm volatile("" : "+s"(b_), "+s"(g_)); F.bid = b_; F.G = g_; } while (0)
#define SEAM(k) do { if (IN(k) && IN((k) + 1)) xcd_barrier(bar); } while (0)
template <int layer>
__device__ __forceinline__ void layer_phases(Frame& F, const Args& args, const XcdBarrier& bar, const int lo, const int hi, const int vcu) {
        const int pb = 2 + 8 * layer;
        const bool with_ctx = layer < DEPTH - 1;
        const int nrows = with_ctx ? T_ALL : T_LAT;
        if (IN(pb + 0)) { LAUNDER();
            pg8::StaticOrder S; S.init_bytes((unsigned char*)(F.ws + WS_H8), DM, (unsigned char*)(F.ws + WS_WIN) + (size_t)layer * INC * DM, DM, T_ALL, INC, F.G, F.bid);
            EpiWin E{F.ws, W8_INV};
            pg8::gemm_phase<EpiWin, pg8::StaticOrder, true>(F.lds, F.wave, DM, DM, S, E);
        } SEAM(pb + 0);
        if (IN(pb + 1)) { LAUNDER();
#ifndef UNIT_MASK
#define UNIT_MASK 15
#endif
            const int nsq = with_ctx ? 576 : 512;
            const float lam_init = 0.8f - 0.6f * expf(-0.3f * (float)layer);
            const float lam = expf(wave_sum(F.in[11][layer * 64 + F.lane] * F.in[12][layer * 64 + F.lane])) - expf(wave_sum(F.in[13][layer * 64 + F.lane] * F.in[14][layer * 64 + F.lane])) + lam_init;
            if (UNIT_MASK & 1) for (int u = vcu; u < nsq; u += F.G) { const bool lat = u < 512; const int b = lat ? (u >> 5) : ((u - 512) >> 2), h = lat ? ((u >> 3) & 3) : ((u - 512) & 3);
                diff_unit(F, layer, b, h, lat ? b * SEQ + (u & 7) * 256 : T_LAT + b * NCTX, lat, lam, lam_init); }
            { __syncthreads(); LAS float* rp = (LAS float*)(F.lds + ATT_RPB); const float* src = F.in[16] + ((size_t)layer * 8 + ((vcu >> 3) & 7)) * 465; for (int i = F.tid; i < 465; i += NTHR) rp[i] = src[i] * LOG2E; }
            if (UNIT_MASK & 2) for (int u = vcu; u < 1024; u += F.G) nat_unit(F, layer, u >> 6, (u >> 3) & 7, u & 7);
            if (UNIT_MASK & 4) conv_units(F, layer, 2 * nsq);
            if ((UNIT_MASK & 8) && with_ctx) for (int u = F.bid; u < 128; u += F.G) natctx_unit(F, u >> 3, u & 7);
            __syncthreads();
        } SEAM(pb + 1);
        if (IN(pb + 2)) { LAUNDER();
            MergeOrder S; S.Y = (const char*)(F.ws + WS_YA); S.W = (const char*)(((bf16*)(F.ws + WS_WBR)) + (size_t)layer * 3 * DM * DB); S.T.init(nullptr, DB, nullptr, DB, nrows, DM, F.G, F.bid);
            EpiMB E{((bf16*)(F.ws + WS_U)), ((bf16*)(F.ws + WS_MB))};
            pg8::gemm_phase<EpiMB, MergeOrder>(F.lds, F.wave, DB * 2, DB * 2, S, E);
            if (layer == 0 && F.G == 256 && F.bid >= 64) convert_items(F, CV_LAYER + CV_P0_L1, CV_LAYER + CV_P0_L1 + CV_SLOT_A, (F.bid - 64) * NWAVES + F.wave, 192 * NWAVES);
        } SEAM(pb + 2);
        if (IN(pb + 3)) { LAUNDER();
            pg8::StaticOrder S; S.init(((bf16*)(F.ws + WS_MB)), DM, ((bf16*)(F.ws + WS_WOUT)) + (size_t)layer * DM * DM, DM, nrows, DM, F.G, F.bid);
            EpiWout E{((float*)(F.ws + WS_MOD)) + (size_t)layer * 17 * 6144 + 2048, ((bf16*)(F.ws + WS_MV))};
            pg8::gemm_phase<EpiWout, pg8::StaticOrder>(F.lds, F.wave, DM * 2, DM * 2, S, E);
            if (layer == 0 && F.G == 256 && F.bid >= 64) convert_items(F, CV_LAYER + CV_P0_L1 + CV_SLOT_A, 2 * CV_LAYER, (F.bid - 64) * NWAVES + F.wave, 192 * NWAVES);
        } SEAM(pb + 3);
        if (IN(pb + 4)) { LAUNDER(); p5_ln1_router(F, layer, nrows); } SEAM(pb + 4);
        if (IN(pb + 5)) { LAUNDER();
            moe_build_tiles(F, layer, 8, true);
            MoeSched1 S{(const char*)(F.ws + WS_H8), (const char*)(F.ws + WS_W1 + (size_t)layer * NE * 2048 * DM), (LAS const int*)(F.lds + TILE_OFF), (LAS const unsigned short*)(F.lds + IDX_OFF), (int)F.MISC[MI_NUNITS]};
            EpiMoe1 E{(unsigned char*)(F.ws + WS_U), F.in[24] + (size_t)layer * NE * 2048};
            pg8::gemm_phase<EpiMoe1, MoeSched1, true>(F.lds, F.wave, DM, DM, S, E);
        } SEAM(pb + 5);
        if (IN(pb + 6)) { LAUNDER();
            moe_build_tiles(F, layer, 4, false);
            MoeSched2 S{(const char*)(F.ws + WS_U), (const char*)(F.ws + WS_W2 + (size_t)layer * NE * DM * DFF), (LAS const int*)(F.lds + TILE_OFF), (int)F.MISC[MI_NUNITS]};
            EpiMoe2 E{(unsigned char*)(F.ws + WS_YK), F.in[26] + (size_t)layer * NE * DM, ((u32x2*)(F.ws + WS_LIST))};
            pg8::gemm_phase<EpiMoe2, MoeSched2, true>(F.lds, F.wave, DFF, DFF, S, E);
        } SEAM(pb + 6);
        if (IN(pb + 7)) { LAUNDER(); p8_final(F, layer, nrows); } SEAM(pb + 7);
    }
__global__ void __launch_bounds__(NTHR, 2) fwd_kernel(Args args) {
    extern __shared__ __attribute__((aligned(16))) unsigned char lds_raw[];
    Frame F;
    F.lds = (LAS unsigned char*)lds_raw;
    F.MISC = (volatile LAS unsigned*)(F.lds + MISC_OFF);
    F.tid = threadIdx.x; F.lane = F.tid & 63; F.wave = __builtin_amdgcn_readfirstlane(F.tid >> 6); F.wave0 = F.wave; F.G = gridDim.x; F.bid = blockIdx.x;
    unsigned char* ws = args.ws;
    F.ctl = (gu32*)(ws + WS_CTL);
    F.in = args.in; F.out = (GAS float*)args.out; F.ws = (GAS unsigned char*)ws;
    for (int u = F.tid; u < (LDS_BYTES - MISC_OFF) / 4; u += NTHR) ((LAS unsigned*)(F.lds + MISC_OFF))[u] = 0u;
    __syncthreads();
    const int lo = args.ph_lo, hi = args.ph_hi;
    XcdBarrier bar; bar.bar = (unsigned*)(F.ctl + CW_BAR); bar.x = 0; bar.st = nullptr; bar.w0 = F.wave0;
    if (hi - lo > 1) { bar = xcd_barrier_post((unsigned*)(F.ctl + CW_BAR), F.MISC + MI_BAR); bar.w0 = F.wave0; }
    const int vcu = (F.G % 8 == 0) ? (F.bid % 8) * (F.G / 8) + F.bid / 8 : F.bid;

    if (IN(0)) { LAUNDER(); p0_prologue(F); } SEAM(0);
    if (IN(1)) { LAUNDER(); p1_modulate0(F); } SEAM(1);

    layer_phases<0>(F, args, bar, lo, hi, vcu);
    layer_phases<1>(F, args, bar, lo, hi, vcu);
#undef IN
#undef SEAM
}

extern "C" void kernel_launch(void* const* d_in, const int* in_sizes, int n_in, void* d_out, int out_size, void* d_ws, size_t ws_size, hipStream_t stream) {
    static int grid = 0;
    if (grid == 0) {
        if (n_in != 29 || out_size != T_LAT * DM || ws_size < WS_END) { fprintf(stderr, "kernel_launch: unexpected shapes (n_in %d out %d ws %zu need %zu)\n", n_in, out_size, ws_size, (size_t)WS_END); grid = -1; return; }
        int dev = 0, cus = 0, per_cu = 0;
        if (hipGetDevice(&dev) != hipSuccess || hipDeviceGetAttribute(&cus, hipDeviceAttributeMultiprocessorCount, dev) != hipSuccess) { grid = -1; return; }
        if (hipFuncSetAttribute((const void*)fwd_kernel, hipFuncAttributeMaxDynamicSharedMemorySize, LDS_BYTES) != hipSuccess) { fprintf(stderr, "kernel_launch: hipFuncSetAttribute failed\n"); grid = -1; return; }
        if (hipOccupancyMaxActiveBlocksPerMultiprocessor(&per_cu, (const void*)fwd_kernel, NTHR, LDS_BYTES) != hipSuccess || per_cu < 1) fprintf(stderr, "kernel_launch: occupancy query reports %d\n", per_cu);
        (void)hipGetLastError();
        grid = cus < 256 ? cus : 256;
        if (grid != 256) fprintf(stderr, "kernel_launch: %d CUs; this kernel is sized for 256\n", cus);
    }
    if (grid < 0) return;
    if (hipMemsetAsync((char*)d_ws + WS_CTL, 0, CTL_ZERO_BYTES, stream) != hipSuccess) return;
    Args a{};
    for (int i = 0; i < 29; ++i) a.in[i] = (const float*)d_in[i];
    a.out = (float*)d_out; a.ws = (unsigned char*)d_ws;
#if MK_ONE_LAUNCH
    a.ph_lo = 0; a.ph_hi = N_PHASES;
    hipLaunchKernelGGL(fwd_kernel, dim3(grid), dim3(NTHR), LDS_BYTES, stream, a);
#else
    const int np = DIAG_STOP ? DIAG_STOP : N_PHASES;
    for (int p = 0; p < np; ++p) { a.ph_lo = p; a.ph_hi = p + 1; hipLaunchKernelGGL(fwd_kernel, dim3(grid), dim3(NTHR), LDS_BYTES, stream, a); }
#ifdef DIAG_NAN
    { unsigned* res = (unsigned*)((char*)d_ws + 512 * 1024); hipMemsetAsync(res, 0, 4, stream); hipMemsetAsync(res + 1, 0xFF, 4, stream); hipMemsetAsync(res + 2, 0, 4, stream);
      hipLaunchKernelGGL(diag_nan_scan, dim3(T_LAT), dim3(256), 0, stream, (const float*)d_out, res);
      hipLaunchKernelGGL(diag_fill, dim3(2048), dim3(256), 0, stream, (float*)d_out, (const unsigned*)res, DIAG_NAN); }
#endif
    if (DIAG_STOP) hipLaunchKernelGGL(diag_copy_kernel, dim3(2048), dim3(256), 0, stream, (const unsigned char*)d_ws, (float*)d_out);
#endif
}
```

```cpp
#include <hip/hip_runtime.h>
#include <cstdio>
#include <cstdint>

#define DIAG_GATEPLAIN 0
#ifndef ABL
#define ABL 0
#endif
#ifndef DIAG_STOP
#define DIAG_STOP 0
#endif
#ifndef MK_ONE_LAUNCH
#define MK_ONE_LAUNCH 1
#endif

#define LAS __attribute__((address_space(3)))
#define GAS __attribute__((address_space(1)))
typedef unsigned short bf16;
typedef short bf16x8 __attribute__((ext_vector_type(8)));
typedef float f32x4 __attribute__((ext_vector_type(4)));
typedef float f32x2 __attribute__((ext_vector_type(2)));
typedef float f32x16 __attribute__((ext_vector_type(16)));
typedef unsigned u32x4 __attribute__((ext_vector_type(4)));
typedef unsigned u32x2 __attribute__((ext_vector_type(2)));
typedef GAS unsigned gu32;

constexpr int NB = 16, SEQ = 2048, NCTX = 256, DM = 1024, DB = 512, DEPTH = 2;
constexpr int T_LAT = NB * SEQ, T_CTX = NB * NCTX, T_ALL = T_LAT + T_CTX;
constexpr int INC = 7168, NE = 32, TOPK = 4, DFF = 1024, CONVK = 31;
constexpr int KEYS = NCTX + SEQ;
constexpr int C_DQ = 1024, C_DK = 1536, C_DV = 2048, C_NQ = 2560, C_NK = 3072, C_NV = 3584, C_G = 4096;
constexpr float LN_EPS = 1e-6f, ALPHA = 1.4142135623730951f, LOG2E = 1.4426950408889634f;
constexpr float QSCALE = 0.125f * LOG2E;
constexpr int LIST_CAP = T_ALL;

constexpr size_t MiB = 1u << 20;
constexpr size_t WS_CTL = 0, CTL_ZERO_BYTES = 1 * MiB;
constexpr size_t WS_MOD = 1 * MiB;
constexpr size_t WS_ROPE = 3 * MiB;
constexpr size_t WS_LIST = 4 * MiB;
constexpr size_t WS_WIN = 16 * MiB;
constexpr size_t WS_WBR = WS_WIN + 28 * MiB;
constexpr size_t WS_WOUT = WS_WBR + 6 * MiB;
constexpr size_t WS_W1 = WS_WOUT + 4 * MiB;
constexpr size_t WS_W2 = WS_W1 + 128 * MiB;
constexpr size_t WS_WIN8 = WS_W2 + 64 * MiB;
constexpr size_t WS_H8 = WS_WIN8 + 8 * MiB;
constexpr size_t WS_H = WS_H8 + 36 * MiB;
constexpr size_t WS_X = WS_H + 72 * MiB;
constexpr size_t WS_U = WS_X + 144 * MiB;
constexpr size_t WS_MV = WS_U;
constexpr size_t WS_YA = WS_U + 504 * MiB;
constexpr size_t WS_YB = WS_YA + 36 * MiB;
constexpr size_t WS_YC = WS_YB + 36 * MiB;
constexpr size_t WS_MB = WS_YC + 36 * MiB;
constexpr size_t WS_Z = WS_MB;
constexpr size_t WS_YK = WS_YA;
constexpr size_t WS_VTD = WS_Z + 216 * MiB;
constexpr size_t WS_VTN = WS_VTD + 36 * MiB;
constexpr size_t WS_END = WS_VTN + 36 * MiB;
static_assert(WS_END <= 2048 * MiB, "workspace map");
constexpr int MAX_TILES = 608;

constexpr int CW_TMO = 0, CW_CODE = 1;
constexpr int CW_BAR = 4096;
constexpr int CW_ECNT = 16384;

constexpr int RING_BYTES = 131072;
constexpr int IDX_OFF = RING_BYTES;
constexpr int TILE_OFF = IDX_OFF + 24 * 512;
constexpr int MISC_OFF = TILE_OFF + 24 * 32;
constexpr int LDS_BYTES = 147456;
static_assert(MISC_OFF + 2048 <= LDS_BYTES, "LDS map");
constexpr int NWAVES = 8, NTHR = 512;

__device__ __forceinline__ unsigned f2bf(float f) { unsigned u = __builtin_bit_cast(unsigned, f); return (u + 0x7fffu + ((u >> 16) & 1u)) >> 16; }
typedef __bf16 bf16x2_t __attribute__((ext_vector_type(2)));
__device__ __forceinline__ unsigned pk2(float lo, float hi) { const f32x2 v = {lo, hi}; const bf16x2_t b = __builtin_convertvector(v, bf16x2_t); return __builtin_bit_cast(unsigned, b); }
__device__ __forceinline__ float bf2f(unsigned short b) { return __builtin_bit_cast(float, (unsigned)b << 16); }
__device__ __forceinline__ float bflo(unsigned w) { return __builtin_bit_cast(float, w << 16); }
__device__ __forceinline__ float bfhi(unsigned w) { return __builtin_bit_cast(float, w & 0xffff0000u); }
__device__ __forceinline__ float fsigmoid(float x) { return __builtin_amdgcn_rcpf(1.0f + __builtin_amdgcn_exp2f(-x * LOG2E)); }
__device__ __forceinline__ int lane_now() { int l; asm volatile("v_mbcnt_lo_u32_b32 %0, -1, 0\n\tv_mbcnt_hi_u32_b32 %0, -1, %0" : "=v"(l)); return l; }
__device__ __forceinline__ float sx(float v, int m) { return __builtin_bit_cast(float, __builtin_amdgcn_ds_bpermute((lane_now() ^ m) << 2, __builtin_bit_cast(int, v))); }
__device__ __forceinline__ void swap32(unsigned& x, unsigned& y) { const auto r = __builtin_amdgcn_permlane32_swap(x, y, false, false); x = r[0]; y = r[1]; }
template <int CTRL> __device__ __forceinline__ float dppx(float v) { return __builtin_bit_cast(float, __builtin_amdgcn_update_dpp(0, __builtin_bit_cast(int, v), CTRL, 0xF, 0xF, false)); }
template <int CTRL> __device__ __forceinline__ int dppxi(int v) { return __builtin_amdgcn_update_dpp(0, v, CTRL, 0xF, 0xF, false); }
__device__ __forceinline__ float wave_sum(float v) {
    v += dppx<0xB1>(v); v += dppx<0x4E>(v); v += dppx<0x141>(v); v += dppx<0x140>(v);
    { const unsigned b = __builtin_bit_cast(unsigned, v); const auto r = __builtin_amdgcn_permlane16_swap(b, b, false, false); v = __builtin_bit_cast(float, (unsigned)r[0]) + __builtin_bit_cast(float, (unsigned)r[1]); }
    { const unsigned b = __builtin_bit_cast(unsigned, v); const auto r = __builtin_amdgcn_permlane32_swap(b, b, false, false); v = __builtin_bit_cast(float, (unsigned)r[0]) + __builtin_bit_cast(float, (unsigned)r[1]); }
    return v;
}
#define LDS_WAIT() asm volatile("s_waitcnt lgkmcnt(0)" ::: "memory")
#define VM_WAIT() asm volatile("s_waitcnt vmcnt(0)" ::: "memory")
#define RLX_AGENT __ATOMIC_RELAXED, __HIP_MEMORY_SCOPE_AGENT

#define XB_TMO      128
#define XB_XCNT(j)  (256  + 64 * (j))
#define XB_XSUB(j)  (1280 + 64 * (j))
#define XB_XGEN(j)  (2304 + 64 * (j))
#define XB_TOP      3328
#define XB_TOPGEN   3392
#define XCD_BAR_WORDS 3456
#define XB_SPIN_CAP (1u << 22)
__device__ __forceinline__ unsigned xb_ld(unsigned* p)              { return __hip_atomic_load(p, __ATOMIC_RELAXED, __HIP_MEMORY_SCOPE_AGENT); }
__device__ __forceinline__ unsigned xb_add(unsigned* p, unsigned v) { return __hip_atomic_fetch_add(p, v, __ATOMIC_RELAXED, __HIP_MEMORY_SCOPE_AGENT); }
__device__ __forceinline__ unsigned xb_xcc_id() { return (unsigned)__builtin_amdgcn_s_getreg((3 << 11) | 20) & 0xFu; }
#define XB_SPIN(cond, bar) do { unsigned _sp = 0; while (cond) { __builtin_amdgcn_s_sleep(1); \
    if ((++_sp & 255u) == 0u) { if (xb_ld(&(bar)[XB_TMO])) break; if (_sp > XB_SPIN_CAP) { atomicAdd(&(bar)[XB_TMO], 1u); break; } } } } while (0)
struct XcdBarrier { unsigned* bar; unsigned x; volatile LAS unsigned* st; int w0; };
__device__ __forceinline__ XcdBarrier xcd_barrier_post(unsigned* bar, volatile LAS unsigned* st) {
    XcdBarrier b; b.bar = bar; b.x = xb_xcc_id(); b.st = st;
    if (threadIdx.x == 0) (void)xb_add(&bar[XB_XCNT(b.x)], 1u);
    return b;
}
__device__ __forceinline__ void xcd_barrier_complete(unsigned* bar, unsigned x, unsigned& nloc, unsigned& nx) {
    const unsigned G = gridDim.x * gridDim.y * gridDim.z;
    unsigned sum, cnt, mine, sp = 0u;
    for (;;) {
        sum = 0u; cnt = 0u; mine = 0u;
#pragma unroll
        for (unsigned j = 0; j < 16; ++j) { const unsigned c = xb_ld(&bar[XB_XCNT(j)]); sum += c; cnt += (c > 0u) ? 1u : 0u; mine = (j == x) ? c : mine; }
        if (sum == G) break;
        __builtin_amdgcn_s_sleep(1);
        if ((++sp & 255u) == 0u) { if (xb_ld(&bar[XB_TMO])) break; if (sp > XB_SPIN_CAP) { atomicAdd(&bar[XB_TMO], 1u); break; } }
    }
    nloc = mine > 0u ? mine : 1u; nx = cnt > 0u ? cnt : 1u;
}
__device__ __forceinline__ void xcd_barrier(const XcdBarrier& b) {
    asm volatile("s_waitcnt vmcnt(0)" ::: "memory");
    __syncthreads();
    if (b.w0 == 0 && lane_now() == 0) {
        unsigned* bar = b.bar;
        __builtin_amdgcn_s_waitcnt(0);
        unsigned nloc = b.st[0], nx = b.st[1];
        if (nloc == 0u) { xcd_barrier_complete(bar, b.x, nloc, nx); b.st[0] = nloc; b.st[1] = nx; }
        const unsigned old = xb_add(&bar[XB_XSUB(b.x)], 1u);
        const unsigned gen = old / nloc;
        if (old + 1u == (gen + 1u) * nloc) {
            __builtin_amdgcn_fence(__ATOMIC_RELEASE, "agent");
            asm volatile("s_waitcnt vmcnt(0)" ::: "memory");
            const unsigned og = xb_add(&bar[XB_TOP], 1u);
            const unsigned tg = og / nx;
            if (og + 1u == (tg + 1u) * nx) xb_add(&bar[XB_TOPGEN], 1u);
            else XB_SPIN(xb_ld(&bar[XB_TOPGEN]) == tg, bar);
            __builtin_amdgcn_fence(__ATOMIC_ACQUIRE, "agent");
            xb_add(&bar[XB_XGEN(b.x)], 1u);
            asm volatile("s_waitcnt vmcnt(0)" ::: "memory");
        } else {
            XB_SPIN(xb_ld(&bar[XB_XGEN(b.x)]) == gen, bar);
            __builtin_amdgcn_fence(__ATOMIC_ACQUIRE, "agent");
            asm volatile("s_waitcnt vmcnt(0)" ::: "memory");
        }
    }
    __syncthreads();
}

namespace pg8 {
typedef int v8i_t __attribute__((ext_vector_type(8)));
typedef int v4i_t __attribute__((ext_vector_type(4)));
constexpr int BM = 256, BK = 64, HALF = 128, HTB = HALF * BK * 2, STAGE_BYTES = 8 * HTB, NXCD = 8, WGM = 8;
__host__ __device__ __forceinline__ int lds_byte(int r, int c) { const int st = (r >> 4) * 2 + (c >> 5), rr = r & 15, cc = c & 31, ob = rr * 64 + cc * 2; return st * 1024 + (ob ^ (((ob >> 9) & 1) << 5)); }
__host__ __device__ __forceinline__ void stage_rc(int b, int& R, int& C) { const int st = b / 1024, sb = b % 1024, swz = sb ^ (((sb >> 9) & 1) << 5); R = (st >> 1) * 16 + swz / 64; C = (st & 1) * 32 + (swz % 64) / 2; }
__host__ __device__ __forceinline__ int perm32(int rho) { const int n = rho >> 4, i = rho & 15; return 8 * (i >> 2) + 4 * n + (i & 3); }

struct Unit { const char* pa; const char* pb; int pm, pn, e, nrows, ti, slot; };

struct StaticOrder {
    static constexpr bool GATHER = false;
    const char* A; const char* Bt; int lda, K; int nM, nN, nwg, G, c;
    __device__ __forceinline__ void init(const bf16* A_, int lda_, const bf16* Bt_, int K_, int M, int N, int G_, int c_) { A = (const char*)A_; Bt = (const char*)Bt_; lda = lda_ * 2; K = K_ * 2; nM = M / BM; nN = N / BM; nwg = nM * nN; G = G_; c = c_; }
    __device__ __forceinline__ void init_bytes(const void* A_, int ldab, const void* Bt_, int Kb, int M, int N, int G_, int c_) { A = (const char*)A_; Bt = (const char*)Bt_; lda = ldab; K = Kb; nM = M / BM; nN = N / BM; nwg = nM * nN; G = G_; c = c_; }
    __device__ __forceinline__ bool next(int i, Unit& u) const {
        const long L = (long)i * G + c; if (L >= nwg) return false;
        int wgid = (int)L; { const int q = nwg / NXCD, r = nwg % NXCD, xcd = wgid % NXCD, off = wgid / NXCD; wgid = (xcd < r ? xcd * (q + 1) : r * (q + 1) + (xcd - r) * q) + off; }
        const int nig = WGM * nN, gid = wgid / nig, fm = gid * WGM, gsz = (nM - fm) < WGM ? (nM - fm) : WGM;
        u.pm = fm + ((wgid % nig) % gsz); u.pn = (wgid % nig) / gsz; u.e = 0; u.nrows = 256; u.ti = u.pm; u.slot = 0;
        u.pa = A + (size_t)u.pm * BM * lda; u.pb = Bt + (size_t)u.pn * BM * K; return true;
    }
    __device__ __forceinline__ unsigned arow(const Unit&, int R) const { return (unsigned)R; }
};

template <class Epi, class Sched, bool FP8 = false>
__device__ __forceinline__ void gemm_phase(LAS unsigned char* lds, const int wid, const int Kb, const int ldab, const Sched& S, const Epi& E) {
    const int lane = lane_now(), tid = (wid << 6) | lane, wr = wid >> 2, wc = wid & 3, fr = lane & 15, fq = lane >> 4;
    int sc7f = 0x7f7f7f7f; if (FP8) asm volatile("" : "+v"(sc7f));
    int nt = Kb / 128; asm volatile("" : "+s"(nt));
    unsigned voffB[1]; const size_t row64B = (size_t)64 * Kb;
    { int R0, C0; stage_rc(tid * 16, R0, C0); const int Rb = Epi::PERM ? ((R0 & ~31) + perm32(R0 & 31)) : R0; voffB[0] = (unsigned)(Rb * Kb + C0 * 2); }
    const size_t kstep = (size_t)(BK * 2);
    const size_t hstepB = (size_t)HALF * Kb;
    const unsigned ldsw = (unsigned)wid * 1024u;
    const int aoff = lds_byte(wr * 64 + fr, fq * 8), boff = lds_byte(wc * 32 + fr, fq * 8);
#define PG8_SA(b, h) (((b) * 2 + (h)) * HTB)
#define PG8_SB(b, h) ((4 + (b) * 2 + (h)) * HTB)
#define PG8_STAGE(bufoff, gbase, v0, v1) do { const char* gb_ = (const char*)(gbase); const unsigned l0_ = (unsigned)(unsigned long)lds + (unsigned)(bufoff) + ldsw, l1_ = l0_ + 8192u; unsigned keep_; \
        asm volatile("s_mov_b32 %0, m0\n\ts_mov_b32 m0, %4\n\ts_nop 0\n\tglobal_load_lds_dwordx4 %1, %3\n\ts_mov_b32 m0, %5\n\ts_nop 0\n\tglobal_load_lds_dwordx4 %2, %3\n\ts_mov_b32 m0, %0" \
                     : "=&s"(keep_) : "v"(v0), "v"(v1), "s"(gb_), "s"(l0_), "s"(l1_) : "memory"); } while (0)
#define PG8_STB(bufoff, gbase) do { const char* gb_ = (const char*)(gbase); const char* gc_ = gb_ + row64B; const unsigned l0_ = (unsigned)(unsigned long)lds + (unsigned)(bufoff) + ldsw, l1_ = l0_ + 8192u; unsigned keep_; \
        asm volatile("s_mov_b32 %0, m0\n\ts_mov_b32 m0, %4\n\ts_nop 0\n\tglobal_load_lds_dwordx4 %1, %2\n\ts_mov_b32 m0, %5\n\ts_nop 0\n\tglobal_load_lds_dwordx4 %1, %3\n\ts_mov_b32 m0, %0" \
                     : "=&s"(keep_) : "v"(voffB[0]), "s"(gb_), "s"(gc_), "s"(l0_), "s"(l1_) : "memory"); } while (0)
#define PG8_LDA(dst, b, h) do { if constexpr (FP8) { _Pragma("unroll") for (int m = 0; m < 4; ++m) { const v4i_t lo_ = *(const LAS v4i_t*)(lds + PG8_SA(b, h) + aoff + m * 2048), hi_ = *(const LAS v4i_t*)(lds + PG8_SA(b, h) + aoff + m * 2048 + 1024); dst##8[m] = __builtin_shufflevector(lo_, hi_, 0, 1, 2, 3, 4, 5, 6, 7); } } \
        else { _Pragma("unroll") for (int m = 0; m < 4; ++m) _Pragma("unroll") for (int k = 0; k < 2; ++k) dst[m][k] = *(const LAS bf16x8*)(lds + PG8_SA(b, h) + aoff + m * 2048 + k * 1024); } } while (0)
#define PG8_LDB(dst, b, h) do { if constexpr (FP8) { _Pragma("unroll") for (int n = 0; n < 2; ++n) { const v4i_t lo_ = *(const LAS v4i_t*)(lds + PG8_SB(b, h) + boff + n * 2048), hi_ = *(const LAS v4i_t*)(lds + PG8_SB(b, h) + boff + n * 2048 + 1024); dst##8[n] = __builtin_shufflevector(lo_, hi_, 0, 1, 2, 3, 4, 5, 6, 7); } } \
        else { _Pragma("unroll") for (int n = 0; n < 2; ++n) _Pragma("unroll") for (int k = 0; k < 2; ++k) dst[n][k] = *(const LAS bf16x8*)(lds + PG8_SB(b, h) + boff + n * 2048 + k * 1024); } } while (0)
#define PG8_MMA(ai, bj, At, Bt) do { __builtin_amdgcn_s_setprio(1); if constexpr (FP8) { _Pragma("unroll") for (int m = 0; m < 4; ++m) _Pragma("unroll") for (int n = 0; n < 2; ++n) \
        acc[ai][bj][m][n] = __builtin_amdgcn_mfma_scale_f32_16x16x128_f8f6f4(Bt##8[n], At##8[m], acc[ai][bj][m][n], 0, 0, 0, sc7f, 0, sc7f); } else { \
        _Pragma("unroll") for (int m = 0; m < 4; ++m) _Pragma("unroll") for (int n = 0; n < 2; ++n) _Pragma("unroll") for (int k = 0; k < 2; ++k) \
        acc[ai][bj][m][n] = __builtin_amdgcn_mfma_f32_16x16x32_bf16(Bt[n][k], At[m][k], acc[ai][bj][m][n], 0, 0, 0); } __builtin_amdgcn_s_setprio(0); } while (0)
#define PG8_WAIT_V(n) asm volatile("s_waitcnt vmcnt(" #n ")" ::: "memory")
#define PG8_WAIT_L(n) asm volatile("s_waitcnt lgkmcnt(" #n ")" ::: "memory")
#define PG8_BAR __builtin_amdgcn_s_barrier()
#define PG8_SCHED __builtin_amdgcn_sched_barrier(0)
#define PG8_VOFF(dst, u) do { const int t2_ = Sched::GATHER ? ((wid << 6) | lane_now()) : tid; _Pragma("unroll") for (int i = 0; i < 2; ++i) { int R_, C_; stage_rc(t2_ * 16 + i * 8192, R_, C_); \
        _Pragma("unroll") for (int h = 0; h < 2; ++h) dst[h][i] = (unsigned)(S.arow(u, h * HALF + R_) * (unsigned)ldab + (unsigned)C_ * 2u); } } while (0)
    Unit cur, nxt; int ui = 0;
    if (!S.next(0, cur)) return;
    f32x4 acc[2][2][4][2];
#pragma unroll
    for (int a = 0; a < 2; ++a)
#pragma unroll
        for (int b = 0; b < 2; ++b)
#pragma unroll
            for (int m = 0; m < 4; ++m)
#pragma unroll
                for (int n = 0; n < 2; ++n) acc[a][b][m][n] = (f32x4){0.f, 0.f, 0.f, 0.f};
    bf16x8 At[4][2], B0[2][2], B1[2][2]; v8i_t At8[4], B08[2], B18[2];
    unsigned vc[2][2];
    PG8_VOFF(vc, cur);
    const char* cA = cur.pa; const char* cB = cur.pb;
    PG8_STB(PG8_SB(0, 0), cB); PG8_STB(PG8_SB(0, 1), cB + hstepB); PG8_STAGE(PG8_SA(0, 0), cA, vc[0][0], vc[0][1]); PG8_STAGE(PG8_SA(0, 1), cA, vc[1][0], vc[1][1]);
    if (wr == 1) PG8_BAR;
    PG8_WAIT_V(2); PG8_BAR;
    PG8_STB(PG8_SB(1, 0), cB + kstep); PG8_STAGE(PG8_SA(1, 0), cA + kstep, vc[0][0], vc[0][1]); PG8_STB(PG8_SB(1, 1), cB + hstepB + kstep);
    PG8_WAIT_V(6); PG8_BAR;
    for (;;) {
        const bool has_next = S.next(ui + 1, nxt);
        const char* nA = has_next ? nxt.pa : cA; const char* nB = has_next ? nxt.pb : cB;
#pragma nounroll
        for (int t = 0; t < nt; t += 2) {
            const bool last = (t == nt - 2);
            const char* a1 = cA + (size_t)(t + 1) * kstep;
            const char* a2 = last ? nA : cA + (size_t)(t + 2) * kstep; const char* b2 = last ? nB : cB + (size_t)(t + 2) * kstep;
            const char* a3 = a2 + kstep; const char* b3 = b2 + kstep;
            unsigned v2_00 = vc[0][0], v2_01 = vc[0][1], v2_10 = vc[1][0], v2_11 = vc[1][1];
            if (Sched::GATHER && last && has_next) { unsigned vn[2][2]; PG8_VOFF(vn, nxt); v2_00 = vn[0][0]; v2_01 = vn[0][1]; v2_10 = vn[1][0]; v2_11 = vn[1][1]; }
            PG8_LDB(B0, 0, 0); PG8_LDB(B1, 0, 1); PG8_SCHED; PG8_LDA(At, 0, 0); PG8_STAGE(PG8_SA(1, 1), a1, vc[1][0], vc[1][1]);
            PG8_WAIT_V(8); PG8_WAIT_L(0); PG8_BAR; PG8_MMA(0, 0, At, B0); PG8_MMA(0, 1, At, B1); PG8_BAR; PG8_SCHED;
            PG8_LDA(At, 0, 1); PG8_STB(PG8_SB(0, 0), b2); PG8_STB(PG8_SB(0, 1), b2 + hstepB); PG8_STAGE(PG8_SA(0, 0), a2, v2_00, v2_01);
            PG8_WAIT_V(8); PG8_WAIT_L(0); PG8_BAR; PG8_MMA(1, 0, At, B0); PG8_MMA(1, 1, At, B1); PG8_BAR; PG8_SCHED;
            PG8_LDB(B0, 1, 0); PG8_LDB(B1, 1, 1); PG8_SCHED; PG8_LDA(At, 1, 0); PG8_STAGE(PG8_SA(0, 1), a2, v2_10, v2_11);
            PG8_WAIT_V(8); PG8_WAIT_L(0); PG8_BAR; PG8_MMA(0, 0, At, B0); PG8_MMA(0, 1, At, B1); PG8_BAR; PG8_SCHED;
            PG8_LDA(At, 1, 1); PG8_STB(PG8_SB(1, 0), b3); PG8_STB(PG8_SB(1, 1), b3 + hstepB); PG8_STAGE(PG8_SA(1, 0), a3, v2_00, v2_01);
            PG8_WAIT_V(8); PG8_WAIT_L(0); PG8_BAR; PG8_MMA(1, 0, At, B0); PG8_MMA(1, 1, At, B1); PG8_BAR; PG8_SCHED;
        }
        if (wr == 0) PG8_BAR;
        { const int l_ = lane_now(); E(acc, cur, wr, wc, l_ & 15, l_ >> 4); }
        if (!has_next) break;
        if (!E.carry(cur)) {
#pragma unroll
        for (int a = 0; a < 2; ++a)
#pragma unroll
            for (int b = 0; b < 2; ++b)
#pragma unroll
                for (int m = 0; m < 4; ++m)
#pragma unroll
                    for (int n = 0; n < 2; ++n) acc[a][b][m][n] = (f32x4){0.f, 0.f, 0.f, 0.f};
        }
        cur = nxt; cA = nA; cB = nB; ++ui;
        if (Sched::GATHER) { PG8_VOFF(vc, cur); }
        if (wr == 1) PG8_BAR;
    }
    PG8_WAIT_V(0);
    PG8_BAR;
#undef PG8_SA
#undef PG8_SB
#undef PG8_STAGE
#undef PG8_STB
#undef PG8_LDA
#undef PG8_LDB
#undef PG8_MMA
#undef PG8_WAIT_V
#undef PG8_WAIT_L
#undef PG8_BAR
#undef PG8_SCHED
#undef PG8_VOFF
}
}

struct Frame {
    LAS unsigned char* lds;
    volatile LAS unsigned* MISC;
    gu32* ctl;
    int tid, lane, wave, G, bid, wave0;
    const float* const* in;
    GAS float* out; GAS unsigned char* ws;
};

constexpr int MI_BAR = 8;
constexpr int MI_NUNITS = 16;
constexpr int MI_NREC = 17;
constexpr int MI_LCNT = 32;
constexpr int MI_LBASE = 64;

constexpr float W8_SCALE = 64.0f, W8_INV = 1.0f / 64.0f;
__device__ __forceinline__ u32x2 pack8_f8(const float (&x)[8]) { u32x2 w; int a = 0, b = 0; a = __builtin_amdgcn_cvt_pk_fp8_f32(x[0], x[1], a, false); a = __builtin_amdgcn_cvt_pk_fp8_f32(x[2], x[3], a, true); b = __builtin_amdgcn_cvt_pk_fp8_f32(x[4], x[5], b, false); b = __builtin_amdgcn_cvt_pk_fp8_f32(x[6], x[7], b, true); w.x = (unsigned)a; w.y = (unsigned)b; return w; }
__device__ __forceinline__ u32x4 pack8(const float (&x)[8]) { u32x4 w; w.x = pk2(x[0], x[1]); w.y = pk2(x[2], x[3]); w.z = pk2(x[4], x[5]); w.w = pk2(x[6], x[7]); return w; }
#define ACC8(x, A, ai, bj, m) do { const f32x4 _a = A[ai][bj][m][0], _b = A[ai][bj][m][1]; x[0] = _a[0]; x[1] = _a[1]; x[2] = _a[2]; x[3] = _a[3]; x[4] = _b[0]; x[5] = _b[1]; x[6] = _b[2]; x[7] = _b[3]; } while (0)

struct EpiWin {
    static constexpr bool PERM = true;
    __device__ __forceinline__ bool carry(const pg8::Unit&) const { return false; }
    GAS unsigned char* ws; float asc;
    __device__ __forceinline__ void operator()(const f32x4 (&acc)[2][2][4][2], const pg8::Unit& u, int wr, int wc, int fr, int fq) const {
        bf16* const U = (bf16*)(ws + WS_U); bf16* const VTD = (bf16*)(ws + WS_VTD); bf16* const VTN = (bf16*)(ws + WS_VTN); const f32x2* const rope = (const f32x2*)(ws + WS_ROPE);
        const int pn = u.pn; const int row0 = u.pm * 256 + wr * 64 + fr; const int cw = wc * 32 + 8 * fq;
        if (pn < 4) {
#pragma unroll
            for (int ai = 0; ai < 2; ++ai)
#pragma unroll
                for (int m = 0; m < 4; ++m) { const int row = row0 + ai * 128 + m * 16; float v[8], g[8]; ACC8(v, acc, ai, 0, m); ACC8(g, acc, ai, 1, m);
#pragma unroll
                    for (int j = 0; j < 8; ++j) v[j] = (v[j] * asc) * fsigmoid(g[j] * asc);
                    *(u32x4*)(U + (size_t)row * INC + 128 * pn + cw) = pack8(v); }
        } else if (pn < 8) {
            const bool latent = u.pm < 128; const float sc = ((pn < 6) ? QSCALE : 1.f) * asc;
#pragma unroll
            for (int ai = 0; ai < 2; ++ai)
#pragma unroll
                for (int m = 0; m < 4; ++m) { const int row = row0 + ai * 128 + m * 16; const int l = row & 2047; const int pos = (wc & 1) ? (l & 63) : (l >> 6);
#pragma unroll
                    for (int bj = 0; bj < 2; ++bj) { float x[8]; ACC8(x, acc, ai, bj, m);
                        if (latent) {
                            const f32x4* rp = (const f32x4*)(rope + pos * 16 + 8 * (fq & 1));
                            const f32x4 r0 = rp[0], r1 = rp[1], r2 = rp[2], r3 = rp[3];
                            const float cs[8] = {r0[0], r0[2], r1[0], r1[2], r2[0], r2[2], r3[0], r3[2]}, sn[8] = {r0[1], r0[3], r1[1], r1[3], r2[1], r2[3], r3[1], r3[3]};
#pragma unroll
                            for (int j = 0; j < 8; ++j) { const unsigned xb = __builtin_bit_cast(unsigned, x[j]); const auto sw = __builtin_amdgcn_permlane32_swap(xb, xb, false, false);
                                const float p = (fq < 2) ? -__builtin_bit_cast(float, (unsigned)sw[1]) : __builtin_bit_cast(float, (unsigned)sw[0]); x[j] = x[j] * cs[j] + p * sn[j]; }
                        }
#pragma unroll
                        for (int j = 0; j < 8; ++j) x[j] *= sc;
                        *(u32x4*)(U + (size_t)row * INC + 256 * pn + 128 * bj + cw) = pack8(x); } }
        } else if (pn == 8 || pn == 9 || pn == 14 || pn == 15) {
            const bool isd = pn < 10;
#pragma unroll
            for (int ai = 0; ai < 2; ++ai)
#pragma unroll
                for (int m = 0; m < 4; ++m) { const int row = row0 + ai * 128 + m * 16; int b, key;
                    if (row < T_LAT) { b = row >> 11; key = NCTX + (row & 2047); } else { const int rc = row - T_LAT; b = rc >> 8; key = rc & 255; }
#pragma unroll
                    for (int bj = 0; bj < 2; ++bj) { float x[8]; ACC8(x, acc, ai, bj, m);
                        bf16* dst;
                        if (isd) { const int head = (pn - 8) * 2 + bj; dst = VTD + ((size_t)((b * 4 + head) * 128 + cw)) * KEYS + key; }
                        else { const int head = (pn - 14) * 4 + bj * 2 + (wc >> 1); dst = VTN + ((size_t)((b * 8 + head) * 64 + (cw & 63))) * KEYS + key; }
#pragma unroll
                        for (int j = 0; j < 8; ++j) dst[(size_t)j * KEYS] = (bf16)f2bf(x[j] * asc); } }
        } else if (pn < 14 || DIAG_GATEPLAIN) {
            const float sc = ((pn < 12) ? QSCALE : 1.f) * asc;
#pragma unroll
            for (int ai = 0; ai < 2; ++ai)
#pragma unroll
                for (int m = 0; m < 4; ++m) { const int row = row0 + ai * 128 + m * 16;
#pragma unroll
                    for (int bj = 0; bj < 2; ++bj) { float x[8]; ACC8(x, acc, ai, bj, m);
#pragma unroll
                        for (int j = 0; j < 8; ++j) x[j] *= sc;
                        *(u32x4*)(U + (size_t)row * INC + 256 * pn + 128 * bj + cw) = pack8(x); } }
        } else {
#pragma unroll
            for (int ai = 0; ai < 2; ++ai)
#pragma unroll
                for (int m = 0; m < 4; ++m) { const int row = row0 + ai * 128 + m * 16;
#pragma unroll
                    for (int bj = 0; bj < 2; ++bj) { float x[8]; ACC8(x, acc, ai, bj, m);
#pragma unroll
                        for (int j = 0; j < 8; ++j) x[j] = fsigmoid(x[j] * asc);
                        *(u32x4*)(U + (size_t)row * INC + 256 * pn + 128 * bj + cw) = pack8(x); } }
        }
    }
};

struct EpiMB {
    static constexpr bool PERM = true;
    const bf16* U; bf16* MB;
    __device__ __forceinline__ bool carry(const pg8::Unit& u) const { return u.e < 2; }
    __device__ __forceinline__ void operator()(f32x4 (&acc)[2][2][4][2], const pg8::Unit& u, int wr, int wc, int fr, int fq) const {
        const int row0 = u.pm * 256 + wr * 64 + fr; const int cw = wc * 32 + 8 * fq; const int j = u.e;
#pragma unroll
        for (int ai = 0; ai < 2; ++ai) {
            u32x4 gw[4][2], gn[4][2];
#pragma unroll
            for (int m = 0; m < 4; ++m)
#pragma unroll
                for (int bj = 0; bj < 2; ++bj) { const int row = row0 + ai * 128 + m * 16, col = 256 * u.pn + 128 * bj + cw; const bf16* gp = U + (size_t)row * INC + C_G + 1024 * j + col;
                    gw[m][bj] = *(const u32x4*)gp; gn[m][bj] = (j < 2) ? *(const u32x4*)(gp + 1024) : (u32x4){0u, 0u, 0u, 0u}; }
#pragma unroll
            for (int m = 0; m < 4; ++m)
#pragma unroll
                for (int bj = 0; bj < 2; ++bj) { const int row = row0 + ai * 128 + m * 16, col = 256 * u.pn + 128 * bj + cw;
                    const u32x4 g4 = gw[m][bj], n4 = gn[m][bj];
                    float g[8] = {bflo(g4.x), bfhi(g4.x), bflo(g4.y), bfhi(g4.y), bflo(g4.z), bfhi(g4.z), bflo(g4.w), bfhi(g4.w)};
                    const float gx[8] = {bflo(n4.x), bfhi(n4.x), bflo(n4.y), bfhi(n4.y), bflo(n4.z), bfhi(n4.z), bflo(n4.w), bfhi(n4.w)};
                    if (j > 0) {
#pragma unroll
                        for (int q = 0; q < 8; ++q) g[q] = fmaxf(g[q], 1.0e-12f); }
                    float x[8]; ACC8(x, acc, ai, bj, m);
                    if (j < 2) {
#pragma unroll
                        for (int q = 0; q < 8; ++q) x[q] = (x[q] * g[q]) * __builtin_amdgcn_rcpf(fmaxf(gx[q], 1.0e-12f));
                        acc[ai][bj][m][0] = (f32x4){x[0], x[1], x[2], x[3]}; acc[ai][bj][m][1] = (f32x4){x[4], x[5], x[6], x[7]};
                    } else {
#pragma unroll
                        for (int q = 0; q < 8; ++q) x[q] *= g[q];
                        *(u32x4*)(MB + (size_t)row * DM + col) = pack8(x); } }
        }
    }
};
struct MergeOrder {
    static constexpr bool GATHER = false;
    const char* Y; const char* W; pg8::StaticOrder T;
    __device__ __forceinline__ bool next(int i, pg8::Unit& u) const {
        const int t = i / 3, j = i - 3 * t; if (!T.next(t, u)) return false;
        u.e = j; u.pa = Y + (size_t)j * (36 * MiB) + (size_t)u.pm * 256 * (DB * 2); u.pb = W + ((size_t)j * DM + (size_t)u.pn * 256) * (DB * 2); return true; }
    __device__ __forceinline__ unsigned arow(const pg8::Unit&, int R) const { return (unsigned)R; }
};

struct EpiWout {
    static constexpr bool PERM = true;
    __device__ __forceinline__ bool carry(const pg8::Unit&) const { return false; }
    const float* g1base; bf16* YG;
    __device__ __forceinline__ void operator()(const f32x4 (&acc)[2][2][4][2], const pg8::Unit& u, int wr, int wc, int fr, int fq) const {
        const int row0 = u.pm * 256 + wr * 64 + fr; const int cw = wc * 32 + 8 * fq;
        const bool latent = u.pm < 128; const int mi = latent ? (u.pm >> 3) : 16;
        const float* g1 = g1base + (size_t)mi * 6144;
        f32x4 gv[2][2];
#pragma unroll
        for (int bj = 0; bj < 2; ++bj) { const int col = 256 * u.pn + 128 * bj + cw; gv[bj][0] = *(const f32x4*)(g1 + col); gv[bj][1] = *(const f32x4*)(g1 + col + 4); }
#pragma unroll
        for (int ai = 0; ai < 2; ++ai)
#pragma unroll
            for (int m = 0; m < 4; ++m) { const int row = row0 + ai * 128 + m * 16;
#pragma unroll
                for (int bj = 0; bj < 2; ++bj) { const int col = 256 * u.pn + 128 * bj + cw; float x[8]; ACC8(x, acc, ai, bj, m);
#pragma unroll
                    for (int q = 0; q < 4; ++q) { x[q] *= gv[bj][0][q]; x[4 + q] *= gv[bj][1][q]; }
                    *(u32x4*)(YG + (size_t)row * DM + col) = pack8(x); } }
    }
};

struct EpiMoe1 {
    static constexpr bool PERM = true;
    __device__ __forceinline__ bool carry(const pg8::Unit&) const { return false; }
    unsigned char* ACT; const float* b1;
    __device__ __forceinline__ void operator()(const f32x4 (&acc)[2][2][4][2], const pg8::Unit& u, int wr, int wc, int fr, int fq) const {
        const int cw = wc * 32 + 8 * fq; const int col = 128 * u.pn + cw;
        const float* bg = b1 + (size_t)u.e * 2048 + col; const float* bl = bg + 1024;
        const f32x4 bga = *(const f32x4*)bg, bgb = *(const f32x4*)(bg + 4), bla = *(const f32x4*)bl, blb = *(const f32x4*)(bl + 4);
        const float bgv[8] = {bga[0], bga[1], bga[2], bga[3], bgb[0], bgb[1], bgb[2], bgb[3]}, blv[8] = {bla[0], bla[1], bla[2], bla[3], blb[0], blb[1], blb[2], blb[3]};
#pragma unroll
        for (int ai = 0; ai < 2; ++ai)
#pragma unroll
            for (int m = 0; m < 4; ++m) { const int R = ai * 128 + wr * 64 + m * 16 + fr; float g[8], l[8]; ACC8(g, acc, ai, 0, m); ACC8(l, acc, ai, 1, m);
#pragma unroll
                for (int j = 0; j < 8; ++j) { const float gl = fminf(g[j] * W8_INV + bgv[j], 7.0f); const float li = fminf(fmaxf(l[j] * W8_INV + blv[j], -7.0f), 7.0f); g[j] = gl * fsigmoid(1.702f * gl) * (li + 1.0f); }
                *(u32x2*)(ACT + ((size_t)u.ti * 256 + R) * DFF + col) = pack8_f8(g); }
    }
};

struct EpiMoe2 {
    static constexpr bool PERM = true;
    __device__ __forceinline__ bool carry(const pg8::Unit&) const { return false; }
    unsigned char* YK; const float* b2; const u32x2* LIST;
    __device__ __forceinline__ void operator()(const f32x4 (&acc)[2][2][4][2], const pg8::Unit& u, int wr, int wc, int fr, int fq) const {
        const int cw = wc * 32 + 8 * fq;
        const u32x2* lst = LIST + (size_t)u.e * LIST_CAP + u.pm * 256;
        u32x2 ent[2][4];
#pragma unroll
        for (int ai = 0; ai < 2; ++ai)
#pragma unroll
            for (int m = 0; m < 4; ++m) { const int R = ai * 128 + wr * 64 + m * 16 + fr; ent[ai][m] = lst[R < u.nrows ? R : u.nrows - 1]; }
        f32x4 bv[2][2];
#pragma unroll
        for (int bj = 0; bj < 2; ++bj) { const float* bb = b2 + (size_t)u.e * DM + 256 * u.pn + 128 * bj + cw; bv[bj][0] = *(const f32x4*)bb; bv[bj][1] = *(const f32x4*)(bb + 4); }
#pragma unroll
        for (int ai = 0; ai < 2; ++ai)
#pragma unroll
            for (int m = 0; m < 4; ++m) { const int R = ai * 128 + wr * 64 + m * 16 + fr;
                if (R < u.nrows) { const unsigned tokslot = ent[ai][m].x, wbits = ent[ai][m].y; const float w = __uint_as_float(wbits);
#pragma unroll
                    for (int bj = 0; bj < 2; ++bj) { const int col = 256 * u.pn + 128 * bj + cw; float x[8]; ACC8(x, acc, ai, bj, m);
#pragma unroll
                        for (int j = 0; j < 4; ++j) { x[j] = w * (x[j] * W8_INV + bv[bj][0][j]); x[4 + j] = w * (x[4 + j] * W8_INV + bv[bj][1][j]); }
                        *(u32x2*)(YK + (size_t)tokslot * DM + col) = pack8_f8(x); } } }
    }
};

__device__ __forceinline__ void moe_build_tiles(Frame& F, int layer, int NPN, bool gather) {
    LAS int* tile = (LAS int*)(F.lds + TILE_OFF); LAS unsigned short* idx = (LAS unsigned short*)(F.lds + IDX_OFF);
    if (F.tid == 0) F.MISC[MI_NUNITS] = 0u;
    if (F.tid < NE) F.MISC[MI_LCNT + F.tid] = __hip_atomic_load(F.ctl + CW_ECNT + (layer * 32 + F.tid) * 64, RLX_AGENT);
    __syncthreads();
    if (F.tid < 24) {
        const int gx = F.G >> 3, v = (F.bid >> 3) + gx * F.tid; const int ti = (F.bid & 7) + 8 * (v / NPN), pn = v % NPN;
        int accum = 0, fe = -1, fpm = 0, fn = 0;
        for (int e = 0; e < NE; ++e) { const int cnt = (int)F.MISC[MI_LCNT + e]; const int te = (cnt + 255) >> 8;
            if (fe < 0 && ti < accum + te) { fe = e; fpm = ti - accum; fn = cnt - 256 * fpm; if (fn > 256) fn = 256; } accum += te; }
        LAS int* t = tile + F.tid * 8; t[0] = fe < 0 ? 0 : fe; t[1] = fpm; t[2] = fn; t[3] = pn; t[4] = ti; t[5] = fe >= 0 ? 1 : 0;
        if (fe >= 0) __hip_atomic_fetch_add((LAS unsigned*)&F.MISC[MI_NUNITS], 1u, __ATOMIC_RELAXED, __HIP_MEMORY_SCOPE_WORKGROUP);
    }
    __syncthreads();
    if (gather) {
        const int nu = (int)F.MISC[MI_NUNITS];
        for (int k0 = 0; k0 < nu * 256; k0 += 12 * NTHR) {
            unsigned tk[12];
#pragma unroll
            for (int q = 0; q < 12; ++q) { const int k = k0 + q * NTHR + F.tid; tk[q] = 0u;
                if (k < nu * 256) { const int i = k >> 8, R = k & 255; const LAS int* t = tile + i * 8; const int n = t[2]; const int Rc = R < n ? R : n - 1; tk[q] = ((u32x2*)(F.ws + WS_LIST))[(size_t)t[0] * LIST_CAP + t[1] * 256 + Rc].x; } }
#pragma unroll
            for (int q = 0; q < 12; ++q) { const int k = k0 + q * NTHR + F.tid; if (k < nu * 256) idx[k] = (unsigned short)(tk[q] >> 2); }
        }
        __syncthreads();
    }
}
struct MoeSched1 {
    static constexpr bool GATHER = true;
    const char* A; const char* W; LAS const int* tile; LAS const unsigned short* idx; int nunits;
    __device__ __forceinline__ bool next(int i, pg8::Unit& u) const {
        if (i >= nunits) return false; const LAS int* t = tile + i * 8;
        u.e = __builtin_amdgcn_readfirstlane(t[0]); u.pm = __builtin_amdgcn_readfirstlane(t[1]); u.nrows = __builtin_amdgcn_readfirstlane(t[2]); u.pn = __builtin_amdgcn_readfirstlane(t[3]); u.ti = __builtin_amdgcn_readfirstlane(t[4]); u.slot = i;
        u.pa = A; u.pb = W + ((size_t)u.e * 2048 + (size_t)u.pn * 256) * DM; return true; }
    __device__ __forceinline__ unsigned arow(const pg8::Unit& u, int R) const { return (unsigned)idx[u.slot * 256 + R]; }
};
struct MoeSched2 {
    static constexpr bool GATHER = false;
    const char* A; const char* W; LAS const int* tile; int nunits;
    __device__ __forceinline__ bool next(int i, pg8::Unit& u) const {
        if (i >= nunits) return false; const LAS int* t = tile + i * 8;
        u.e = __builtin_amdgcn_readfirstlane(t[0]); u.pm = __builtin_amdgcn_readfirstlane(t[1]); u.nrows = __builtin_amdgcn_readfirstlane(t[2]); u.pn = __builtin_amdgcn_readfirstlane(t[3]); u.ti = __builtin_amdgcn_readfirstlane(t[4]); u.slot = i;
        u.pa = A + (size_t)u.ti * 256 * DFF; u.pb = W + ((size_t)u.e * 1024 + (size_t)u.pn * 256) * DFF; return true; }
    __device__ __forceinline__ unsigned arow(const pg8::Unit&, int R) const { return (unsigned)R; }
};

__device__ __forceinline__ void p0_transpose_item(const float* W, int K, int N, bf16* WT, int glu_half, LAS float* scr, int item, int lane, int ldt, int nrep) {
    const int nblk = N / 32, kb = item / nblk, nb = item % nblk, k0 = 64 * kb, n0 = 32 * nb;
    int d0 = n0;
    if (glu_half && n0 < 2 * glu_half) { const int part = n0 / glu_half, ix = n0 % glu_half; d0 = (ix >> 7) * 256 + part * 128 + (ix & 127); }
    { float wv_[32];
#pragma unroll
      for (int i = 0; i < 32; ++i) wv_[i] = W[(size_t)(k0 + 2 * i + (lane >> 5)) * N + n0 + (lane & 31)];
#pragma unroll
      for (int i = 0; i < 32; ++i) scr[(2 * i + (lane >> 5)) * 33 + (lane & 31)] = wv_[i]; }
    LDS_WAIT(); asm volatile("" ::: "memory");
    const int c = lane & 7;
#pragma unroll
    for (int j = 0; j < 4; ++j) { const int n = (lane >> 3) + 8 * j; const LAS float* s = scr + (8 * c) * 33 + n;
        u32x4 o; o.x = f2bf(s[0 * 33]) | (f2bf(s[1 * 33]) << 16); o.y = f2bf(s[2 * 33]) | (f2bf(s[3 * 33]) << 16); o.z = f2bf(s[4 * 33]) | (f2bf(s[5 * 33]) << 16); o.w = f2bf(s[6 * 33]) | (f2bf(s[7 * 33]) << 16);
        for (int rp = 0; rp < nrep; ++rp) *(u32x4*)(WT + (size_t)(d0 + n) * ldt + rp * K + k0 + 8 * c) = o; }
    LDS_WAIT(); asm volatile("" ::: "memory");
}
__device__ __forceinline__ void p0_transpose_item_f8(const float* W, int K, int N, unsigned char* WT, int glu_half, LAS float* scr, int item, int lane, int drow = 0) {
    const int nblk = N / 32, kb = item / nblk, nb = item % nblk, k0 = 64 * kb, n0 = 32 * nb;
    int d0 = n0;
    if (glu_half && n0 < 2 * glu_half) { const int part = n0 / glu_half, ix = n0 % glu_half; d0 = (ix >> 7) * 256 + part * 128 + (ix & 127); }
    { float wv_[32];
#pragma unroll
      for (int i = 0; i < 32; ++i) wv_[i] = W[(size_t)(k0 + 2 * i + (lane >> 5)) * N + n0 + (lane & 31)];
#pragma unroll
      for (int i = 0; i < 32; ++i) scr[(2 * i + (lane >> 5)) * 33 + (lane & 31)] = wv_[i]; }
    LDS_WAIT(); asm volatile("" ::: "memory");
    const int n = lane >> 1, kh = (lane & 1) * 32; const LAS float* sp = scr + kh * 33 + n;
    unsigned w[8];
#pragma unroll
    for (int q = 0; q < 8; ++q) { int a = 0; a = __builtin_amdgcn_cvt_pk_fp8_f32(sp[(4 * q) * 33] * W8_SCALE, sp[(4 * q + 1) * 33] * W8_SCALE, a, false); a = __builtin_amdgcn_cvt_pk_fp8_f32(sp[(4 * q + 2) * 33] * W8_SCALE, sp[(4 * q + 3) * 33] * W8_SCALE, a, true); w[q] = (unsigned)a; }
    unsigned char* dst = WT + (size_t)(d0 + drow + n) * K + k0 + kh;
    *(u32x4*)dst = (u32x4){w[0], w[1], w[2], w[3]}; *(u32x4*)(dst + 16) = (u32x4){w[4], w[5], w[6], w[7]};
    LDS_WAIT(); asm volatile("" ::: "memory");
}
constexpr int CV_WIN = 16 * 224, CV_WBR = 3 * 8 * 32, CV_WOUT = 16 * 32, CV_W1 = 32 * 16 * 64, CV_W2 = 32 * 16 * 32, CV_LAYER = CV_WIN + CV_WBR + CV_WOUT + CV_W1 + CV_W2;
constexpr int CV_SLOT_A = 34000, CV_SLOT_B = 14000, CV_P0_L1 = CV_LAYER - CV_SLOT_A - CV_SLOT_B;
__device__ __forceinline__ void convert_items(Frame& F, int it0, int it1, int first, int stride) {
    LAS float* scr = (LAS float*)(F.lds + F.wave * 16384);
    for (int it = it0 + first; it < it1; it += stride) {
        const int l = it / CV_LAYER; int r = it - l * CV_LAYER;
        if (r < CV_WIN) { p0_transpose_item_f8(F.in[6] + (size_t)l * DM * INC, DM, INC, (unsigned char*)(F.ws + WS_WIN) + (size_t)l * INC * DM, 512, scr, r, F.lane); continue; } r -= CV_WIN;
        if (r < CV_WBR) { const int m = l * 3 + r / 256; p0_transpose_item(F.in[17] + (size_t)m * DB * DM, DB, DM, ((bf16*)(F.ws + WS_WBR)) + (size_t)m * DM * DB, 0, scr, r % 256, F.lane, DB, 1); continue; } r -= CV_WBR;
        if (r < CV_WOUT) { p0_transpose_item(F.in[18] + (size_t)l * DM * DM, DM, DM, ((bf16*)(F.ws + WS_WOUT)) + (size_t)l * DM * DM, 0, scr, r, F.lane, DM, 1); continue; } r -= CV_WOUT;
        if (r < CV_W1) { const int m = l * 32 + r / 1024; p0_transpose_item_f8(F.in[23] + (size_t)m * DM * 2048, DM, 2048, (unsigned char*)(F.ws + WS_W1) + (size_t)m * 2048 * DM, 1024, scr, r % 1024, F.lane); continue; } r -= CV_W1;
        { const int m = l * 32 + r / 512; p0_transpose_item_f8(F.in[25] + (size_t)m * DFF * DM, DFF, DM, (unsigned char*)(F.ws + WS_W2) + (size_t)m * DM * DFF, 0, scr, r % 512, F.lane); }
    }
}
__device__ __forceinline__ float fsilu(float x) { return x * fsigmoid(x); }
__device__ __forceinline__ void p0_prologue(Frame& F) {
    if (F.bid < 192) {
        LAS float* s = (LAS float*)F.lds;
        LAS float* red = (LAS float*)(F.lds + 17 * 4096);
        for (int i = F.tid; i < 17 * 1024; i += NTHR) { const int mi = i >> 10, k = i & 1023; s[i] = fsilu(mi < 16 ? F.in[1][mi * 1024 + k] : F.in[3][k]); }
        __syncthreads();
        const int layer = F.bid / 96, cg = F.bid % 96;
        const float* W = F.in[4] + (size_t)layer * DM * 6144 + cg * 64 + F.lane;
        float acc[17];
#pragma unroll
        for (int b = 0; b < 17; ++b) acc[b] = 0.f;
#pragma unroll 4
        for (int k = F.wave * 128; k < F.wave * 128 + 128; k += 4) {
            const float w0 = W[(size_t)k * 6144], w1 = W[(size_t)(k + 1) * 6144], w2 = W[(size_t)(k + 2) * 6144], w3 = W[(size_t)(k + 3) * 6144];
#pragma unroll
            for (int b = 0; b < 17; ++b) { const f32x4 sv = *(const LAS f32x4*)(s + b * 1024 + k); acc[b] += sv[0] * w0 + sv[1] * w1 + sv[2] * w2 + sv[3] * w3; }
        }
#pragma unroll
        for (int b = 0; b < 17; ++b) red[(F.wave * 17 + b) * 64 + F.lane] = acc[b];
        __syncthreads();
        for (int i = F.tid; i < 17 * 64; i += NTHR) { const int b = i >> 6, cl = i & 63; float t = 0.f;
#pragma unroll
            for (int w = 0; w < 8; ++w) t += red[(w * 17 + b) * 64 + cl];
            ((float*)(F.ws + WS_MOD))[((size_t)layer * 17 + b) * 6144 + cg * 64 + cl] = t + F.in[5][layer * 6144 + cg * 64 + cl]; }
        __syncthreads();
    } else if (F.bid == 255) {
        for (int i = F.tid; i < 1024; i += NTHR) { const int pos = i >> 4, fi = i & 15;
            double invf = 1.0; for (int q = 0; q < fi; ++q) invf *= 0.5623413251903491;
            const float ang = (float)pos * (float)invf;
            double a = (double)ang; const double tw = 6.283185307179586476925; a -= tw * __builtin_rint(a / tw);
            const double a2 = a * a; double sn = a, cs = 1.0, ts = a, tc = 1.0;
            for (int q = 1; q < 14; ++q) { tc *= -a2 / (double)((2 * q - 1) * (2 * q)); ts *= -a2 / (double)((2 * q) * (2 * q + 1)); cs += tc; sn += ts; }
            ((f32x2*)(F.ws + WS_ROPE))[i] = (f32x2){(float)cs, (float)sn}; }
    }
    __syncthreads();
    convert_items(F, 0, F.G == 256 ? CV_LAYER + CV_P0_L1 : 2 * CV_LAYER, F.bid * NWAVES + F.wave, F.G * NWAVES);
}
__device__ __forceinline__ void row_load(const float* p, int lane, f32x4 (&v)[4]) {
#pragma unroll
    for (int j = 0; j < 4; ++j) v[j] = ((const f32x4*)p)[lane + 64 * j];
}
__device__ __forceinline__ void row_ln(f32x4 (&v)[4]) {
    float s = 0.f;
#pragma unroll
    for (int j = 0; j < 4; ++j) s += (v[j][0] + v[j][1]) + (v[j][2] + v[j][3]);
    const float mean = wave_sum(s) * (1.f / DM); float q = 0.f;
#pragma unroll
    for (int j = 0; j < 4; ++j) { v[j] = v[j] - mean; q += (v[j][0] * v[j][0] + v[j][1] * v[j][1]) + (v[j][2] * v[j][2] + v[j][3] * v[j][3]); }
    const float rstd = 1.0f / sqrtf(wave_sum(q) * (1.f / DM) + LN_EPS);
#pragma unroll
    for (int j = 0; j < 4; ++j) v[j] = v[j] * rstd;
}
__device__ __forceinline__ void row_affine(f32x4 (&v)[4], const float* g, const float* b, int lane, bool plus1) {
#pragma unroll
    for (int j = 0; j < 4; ++j) { f32x4 gv = ((const f32x4*)g)[lane + 64 * j]; const f32x4 bv = ((const f32x4*)b)[lane + 64 * j]; if (plus1) gv = gv + 1.0f; v[j] = v[j] * gv + bv; }
}
__device__ __forceinline__ void row_store_bf16(bf16* p, int lane, const f32x4 (&v)[4]) {
#pragma unroll
    for (int j = 0; j < 4; ++j) { u32x2 w; w.x = f2bf(v[j][0]) | (f2bf(v[j][1]) << 16); w.y = f2bf(v[j][2]) | (f2bf(v[j][3]) << 16); ((u32x2*)p)[lane + 64 * j] = w; }
}
__device__ __forceinline__ void row_store_f8(unsigned char* p, int lane, const f32x4 (&v)[4]) {
#pragma unroll
    for (int j = 0; j < 4; ++j) { int a = 0; a = __builtin_amdgcn_cvt_pk_fp8_f32(v[j][0], v[j][1], a, false); a = __builtin_amdgcn_cvt_pk_fp8_f32(v[j][2], v[j][3], a, true); ((unsigned*)p)[lane + 64 * j] = (unsigned)a; }
}
__device__ __forceinline__ void row_store_f32(float* p, int lane, const f32x4 (&v)[4]) {
#pragma unroll
    for (int j = 0; j < 4; ++j) ((f32x4*)p)[lane + 64 * j] = v[j];
}
__device__ __forceinline__ int row_mi(int row) { return row < T_LAT ? (row >> 11) : 16; }

__device__ __forceinline__ void p1_modulate0(Frame& F) {
    const int gw = F.bid * NWAVES + F.wave, NGW = F.G * NWAVES;
    for (int row = gw; row < T_ALL; row += NGW) {
        f32x4 v[4]; row_load(row < T_LAT ? F.in[0] + (size_t)row * DM : F.in[2] + (size_t)(row - T_LAT) * DM, F.lane, v);
        row_ln(v); const float* md = ((float*)(F.ws + WS_MOD)) + (size_t)row_mi(row) * 6144; row_affine(v, md + 1024, md, F.lane, true);
        row_store_f8((unsigned char*)(F.ws + WS_H8) + (size_t)row * DM, F.lane, v);
    }
}
__device__ __forceinline__ f32x4 bf4(u32x2 w) { return (f32x4){bflo(w.x), bfhi(w.x), bflo(w.y), bfhi(w.y)}; }
__device__ __forceinline__ void p8_final(Frame& F, int layer, int nrows) {
    const int gw = F.bid * NWAVES + F.wave, NGW = F.G * NWAVES;
    u32x2 xn[4]; unsigned yn[4][4];
#define P8_LOAD(r_) do { const int rl_ = (r_); _Pragma("unroll") for (int j_ = 0; j_ < 4; ++j_) xn[j_] = ((const u32x2*)(((bf16*)(F.ws + WS_X)) + (size_t)rl_ * DM))[F.lane + 64 * j_]; \
        _Pragma("unroll") for (int j_ = 0; j_ < 4; ++j_) _Pragma("unroll") for (int k_ = 0; k_ < 4; ++k_) yn[j_][k_] = ((const unsigned*)(F.ws + WS_YK + ((size_t)rl_ * 4 + k_) * DM))[F.lane + 64 * j_]; } while (0)
    if (gw < nrows) P8_LOAD(gw);
    for (int row = gw; row < nrows; row += NGW) {
        f32x4 v[4]; unsigned yc[4][4];
#pragma unroll
        for (int j = 0; j < 4; ++j) { v[j] = bf4(xn[j]);
#pragma unroll
            for (int k = 0; k < 4; ++k) yc[j][k] = yn[j][k]; }
        if (row + NGW < nrows) P8_LOAD(row + NGW);
        const float* md = ((float*)(F.ws + WS_MOD)) + ((size_t)layer * 17 + row_mi(row)) * 6144;
#pragma unroll
        for (int j = 0; j < 4; ++j) { f32x4 y = (f32x4){0.f, 0.f, 0.f, 0.f};
#pragma unroll
            for (int k = 0; k < 4; ++k) { const int w = (int)yc[j][k]; const f32x2 lo = __builtin_amdgcn_cvt_pk_f32_fp8(w, false), hi2 = __builtin_amdgcn_cvt_pk_f32_fp8(w, true); y[0] += lo[0]; y[1] += lo[1]; y[2] += hi2[0]; y[3] += hi2[1]; }
            const f32x4 g2 = ((const f32x4*)(md + 5120))[F.lane + 64 * j]; if (ABL & 1) y = y * 0.f; v[j] = v[j] * ALPHA + g2 * y; }
        row_ln(v); row_affine(v, F.in[27] + layer * DM, F.in[28] + layer * DM, F.lane, false);
        if (layer == DEPTH - 1) { row_store_f32((float*)(F.out + (size_t)row * DM), F.lane, v); }
        else { row_store_bf16(((bf16*)(F.ws + WS_X)) + (size_t)row * DM, F.lane, v); row_ln(v); const float* mn = ((float*)(F.ws + WS_MOD)) + ((size_t)(layer + 1) * 17 + row_mi(row)) * 6144; row_affine(v, mn + 1024, mn, F.lane, true); row_store_f8((unsigned char*)(F.ws + WS_H8) + (size_t)row * DM, F.lane, v); }
    }
#undef P8_LOAD
}

constexpr int TS_STRIDE = 1028;
constexpr int P5_TS = 0, P5_PART = 16 * TS_STRIDE * 4, P5_LOG = P5_PART + 8 * 16 * 32 * 4, P5_REC = P5_LOG + 16 * 32 * 4;
__device__ __forceinline__ void p5_ln1_router(Frame& F, int layer, int nrows) {
    LAS float* TS = (LAS float*)(F.lds + P5_TS); LAS float* PART = (LAS float*)(F.lds + P5_PART); LAS float* LOG = (LAS float*)(F.lds + P5_LOG); LAS u32x4* REC = (LAS u32x4*)(F.lds + P5_REC);
    if (F.tid < 32) F.MISC[MI_LCNT + F.tid] = 0u;
    if (F.tid == 0) F.MISC[MI_NREC] = 0u;
    __syncthreads();
    const float* wr_ = F.in[21] + (size_t)layer * DM * NE; const float* br_ = F.in[22] + layer * NE;
    const int ngroups = nrows / 16;
    float wb0[32], wb1[32];
    { const float* bp = wr_ + (size_t)(F.wave * 128 + (F.lane >> 4)) * NE + (F.lane & 15);
#pragma unroll
      for (int s = 0; s < 32; ++s) { wb0[s] = bp[(size_t)(4 * s) * NE]; wb1[s] = bp[(size_t)(4 * s) * NE + 16]; } }
    const float brv = br_[F.tid & 31];
    f32x4 vpre[2][4]; u32x2 ypre[2][4], xraw[2][4];
#define P5_BAR() asm volatile("s_waitcnt lgkmcnt(0)\n\ts_barrier" ::: "memory")
#define P5_LOAD(g_) do { _Pragma("unroll") for (int rr = 0; rr < 2; ++rr) { const int row_ = (g_) * 16 + F.wave * 2 + rr; \
            if (layer == 0) row_load(row_ < T_LAT ? F.in[0] + (size_t)row_ * DM : F.in[2] + (size_t)(row_ - T_LAT) * DM, F.lane, vpre[rr]); \
            else { _Pragma("unroll") for (int j = 0; j < 4; ++j) xraw[rr][j] = ((const u32x2*)(((bf16*)(F.ws + WS_X)) + (size_t)row_ * DM))[F.lane + 64 * j]; } \
            _Pragma("unroll") for (int j = 0; j < 4; ++j) ypre[rr][j] = ((const u32x2*)(((bf16*)(F.ws + WS_MV)) + (size_t)row_ * DM))[F.lane + 64 * j]; } } while (0)
    if (F.bid < ngroups) P5_LOAD(F.bid);
    for (int g = F.bid; g < ngroups; g += F.G) {
        f32x4 vcur[2][4];
#pragma unroll
        for (int rr = 0; rr < 2; ++rr)
#pragma unroll
            for (int j = 0; j < 4; ++j) { const f32x4 xin = layer == 0 ? vpre[rr][j] : bf4(xraw[rr][j]); vcur[rr][j] = xin * ALPHA + bf4(ypre[rr][j]); }
        if (g + F.G < ngroups) P5_LOAD(g + F.G);
#pragma unroll
        for (int rr = 0; rr < 2; ++rr) { const int rl = F.wave * 2 + rr; const int row = g * 16 + rl;
            f32x4 v[4];
#pragma unroll
            for (int j = 0; j < 4; ++j) v[j] = vcur[rr][j];
            row_ln(v); row_affine(v, F.in[19] + layer * DM, F.in[20] + layer * DM, F.lane, false);
            row_store_bf16(((bf16*)(F.ws + WS_X)) + (size_t)row * DM, F.lane, v);
            row_ln(v); const float* md = ((float*)(F.ws + WS_MOD)) + ((size_t)layer * 17 + row_mi(row)) * 6144; row_affine(v, md + 4096, md + 3072, F.lane, true);
#pragma unroll
            for (int j = 0; j < 4; ++j) { int a = 0; a = __builtin_amdgcn_cvt_pk_fp8_f32(v[j][0], v[j][1], a, false); a = __builtin_amdgcn_cvt_pk_fp8_f32(v[j][2], v[j][3], a, true); ((unsigned*)(F.ws + WS_H8 + (size_t)row * DM))[F.lane + 64 * j] = (unsigned)a; }
#pragma unroll
            for (int j = 0; j < 4; ++j) *(LAS f32x4*)(TS + rl * TS_STRIDE + 4 * (F.lane + 64 * j)) = v[j];
        }
        P5_BAR();
        { f32x4 a0 = (f32x4){0.f, 0.f, 0.f, 0.f}, a1 = a0; const int r16 = F.lane & 15, kq = F.lane >> 4;
            const LAS float* ap = TS + r16 * TS_STRIDE + F.wave * 128 + kq;
#pragma unroll
            for (int s = 0; s < 32; ++s) { const float a = ap[4 * s];
                a0 = __builtin_amdgcn_mfma_f32_16x16x4f32(a, wb0[s], a0, 0, 0, 0); a1 = __builtin_amdgcn_mfma_f32_16x16x4f32(a, wb1[s], a1, 0, 0, 0); }
#pragma unroll
            for (int i = 0; i < 4; ++i) { PART[(F.wave * 16 + 4 * kq + i) * 32 + r16] = a0[i]; PART[(F.wave * 16 + 4 * kq + i) * 32 + 16 + r16] = a1[i]; } }
        P5_BAR();
        { const int rl = F.tid >> 5, e = F.tid & 31; float t = brv;
#pragma unroll
            for (int w = 0; w < 8; ++w) t += PART[(w * 16 + rl) * 32 + e];
            float lv[4]; int li[4];
#pragma unroll
            for (int k = 0; k < 4; ++k) { float bv = t; int bi = e;
#define P5_STEP(C) { const float ov = dppx<C>(bv); const int oi = dppxi<C>(bi); const bool take = (ov > bv) || (ov == bv && oi < bi); bv = take ? ov : bv; bi = take ? oi : bi; }
                P5_STEP(0xB1) P5_STEP(0x4E) P5_STEP(0x141) P5_STEP(0x140)
#undef P5_STEP
                { const unsigned vb_ = __builtin_bit_cast(unsigned, bv); const auto rv = __builtin_amdgcn_permlane16_swap(vb_, vb_, false, false); const auto ri_ = __builtin_amdgcn_permlane16_swap((unsigned)bi, (unsigned)bi, false, false);
                  const float va = __builtin_bit_cast(float, (unsigned)rv[0]), vb2 = __builtin_bit_cast(float, (unsigned)rv[1]); const int ia = (int)ri_[0], ib = (int)ri_[1];
                  const bool take = (vb2 > va) || (vb2 == va && ib < ia); bv = take ? vb2 : va; bi = take ? ib : ia; }
                lv[k] = bv; li[k] = bi; if (e == bi) t = -INFINITY; }
            if (e < 4) { const int row = g * 16 + rl;
                const float e1 = __expf(lv[1] - lv[0]), e2 = __expf(lv[2] - lv[0]), e3 = __expf(lv[3] - lv[0]); const float inv = 1.0f / (1.0f + e1 + e2 + e3);
                const float wk = (e == 0 ? 1.0f : (e == 1 ? e1 : (e == 2 ? e2 : e3))) * inv; const int ek = e == 0 ? li[0] : (e == 1 ? li[1] : (e == 2 ? li[2] : li[3]));
                const unsigned p = __hip_atomic_fetch_add((LAS unsigned*)&F.MISC[MI_LCNT + ek], 1u, __ATOMIC_RELAXED, __HIP_MEMORY_SCOPE_WORKGROUP);
                const unsigned ri = __hip_atomic_fetch_add((LAS unsigned*)&F.MISC[MI_NREC], 1u, __ATOMIC_RELAXED, __HIP_MEMORY_SCOPE_WORKGROUP);
                REC[ri] = (u32x4){(unsigned)ek, p, (unsigned)(row * 4 + e), __builtin_bit_cast(unsigned, wk)}; } }
        P5_BAR();
    }
#undef P5_LOAD
#undef P5_BAR
    if (F.tid < 32) { const unsigned n = F.MISC[MI_LCNT + F.tid]; unsigned base = 0u; if (n) base = __hip_atomic_fetch_add(F.ctl + CW_ECNT + (layer * 32 + F.tid) * 64, n, RLX_AGENT); F.MISC[MI_LBASE + F.tid] = base; }
    __syncthreads();
    { const int nrec = (int)F.MISC[MI_NREC];
      for (int i = F.tid; i < nrec; i += NTHR) { const u32x4 r = REC[i]; ((u32x2*)(F.ws + WS_LIST))[(size_t)r.x * LIST_CAP + F.MISC[MI_LBASE + r.x] + r.y] = (u32x2){r.z, r.w}; } }
    __syncthreads();
}

constexpr int CV_T = 32, CV_ROWS = CV_T + 30, CV_GIN = 65536;
__device__ __forceinline__ void conv_units(Frame& F, int layer, int ntot) {
    LAS unsigned short* gin = (LAS unsigned short*)(F.lds + CV_GIN);
    LAS float* cout = (LAS float*)F.lds;
    const int c = F.tid;
    float w[CONVK];
#pragma unroll
    for (int j = 0; j < CONVK; ++j) w[j] = F.in[7][(size_t)layer * CONVK * DB + j * DB + c];
    const float bias = F.in[8][layer * DB + c];
    const f32x4 g0 = ((const f32x4*)(F.in[9] + layer * DB))[F.lane], g1 = ((const f32x4*)(F.in[9] + layer * DB))[F.lane + 64];
    const f32x4 b0 = ((const f32x4*)(F.in[10] + layer * DB))[F.lane], b1 = ((const f32x4*)(F.in[10] + layer * DB))[F.lane + 64];
    u32x4 v[8];
#define CV_DECODE(u_, base_, len_, t0_) const int s_ = (u_) < 1024 ? ((u_) >> 6) : 16 + (((u_) - 1024) >> 3), tt_ = (u_) < 1024 ? ((u_) & 63) : (((u_) - 1024) & 7); \
        const int base_ = s_ < 16 ? s_ * SEQ : T_LAT + (s_ - 16) * NCTX, len_ = s_ < 16 ? SEQ : NCTX, t0_ = tt_ * CV_T
#define CV_LOAD(u_) do { CV_DECODE(u_, bs_, ln_, tz_); _Pragma("unroll") for (int i = 0; i < 8; ++i) { const int p = F.tid + NTHR * i; const int r = p >> 6, ch = p & 63; const int t = tz_ - 15 + r; \
          v[i] = (u32x4){0u, 0u, 0u, 0u}; if (p < CV_ROWS * 64 && t >= 0 && t < ln_) v[i] = *(const u32x4*)(((bf16*)(F.ws + WS_U)) + (size_t)(bs_ + t) * INC + ch * 8); } } while (0)
#define CV_BAR() asm volatile("s_waitcnt lgkmcnt(0)\n\ts_barrier" ::: "memory")
    if (F.bid < ntot) CV_LOAD(F.bid);
    __syncthreads();
    for (int u = F.bid; u < ntot; u += F.G) {
        CV_DECODE(u, base, len, t0); (void)len;
#pragma unroll
        for (int i = 0; i < 8; ++i) { const int p = F.tid + NTHR * i; if (p < CV_ROWS * 64) *(LAS u32x4*)(gin + (p >> 6) * 512 + (p & 63) * 8) = v[i]; }
        if (u + F.G < ntot) CV_LOAD(u + F.G);
        CV_BAR();
#pragma unroll 1
        for (int g = 0; g < CV_T / 16; ++g) {
            float a[16];
#pragma unroll
            for (int i = 0; i < 16; ++i) a[i] = bias;
#pragma unroll
            for (int r = 0; r < 46; ++r) { const float x = bf2f(gin[(16 * g + r) * 512 + c]);
#pragma unroll
                for (int i = 0; i < 16; ++i) { const int j = r - i; if (j >= 0 && j < CONVK) a[i] += w[j] * x; } }
#pragma unroll
            for (int i = 0; i < 16; ++i) cout[(16 * g + i) * 512 + c] = a[i];
        }
        CV_BAR();
#pragma unroll 2
        for (int k = 0; k < CV_T / 8; ++k) { const int tk = F.wave * (CV_T / 8) + k;
            f32x4 v0 = *(const LAS f32x4*)(cout + tk * 512 + 4 * F.lane), v1 = *(const LAS f32x4*)(cout + tk * 512 + 256 + 4 * F.lane);
            float sm = (v0[0] + v0[1]) + (v0[2] + v0[3]) + (v1[0] + v1[1]) + (v1[2] + v1[3]);
            const float mean = wave_sum(sm) * (1.f / DB); v0 = v0 - mean; v1 = v1 - mean;
            float q = (v0[0] * v0[0] + v0[1] * v0[1]) + (v0[2] * v0[2] + v0[3] * v0[3]) + (v1[0] * v1[0] + v1[1] * v1[1]) + (v1[2] * v1[2] + v1[3] * v1[3]);
            const float rstd = 1.0f / sqrtf(wave_sum(q) * (1.f / DB) + LN_EPS);
            v0 = v0 * rstd * g0 + b0; v1 = v1 * rstd * g1 + b1;
            u32x2 o0, o1; o0.x = f2bf(fsilu(v0[0])) | (f2bf(fsilu(v0[1])) << 16); o0.y = f2bf(fsilu(v0[2])) | (f2bf(fsilu(v0[3])) << 16);
            o1.x = f2bf(fsilu(v1[0])) | (f2bf(fsilu(v1[1])) << 16); o1.y = f2bf(fsilu(v1[2])) | (f2bf(fsilu(v1[3])) << 16);
            bf16* dst = ((bf16*)(F.ws + WS_YA)) + (size_t)(base + t0 + tk) * DB; ((u32x2*)dst)[F.lane] = o0; ((u32x2*)dst)[F.lane + 64] = o1; }
    }
#undef CV_DECODE
#undef CV_LOAD
#undef CV_BAR
}

constexpr int ATT_KROW = 144, ATT_VROW = 144;
constexpr int ATT_KB = 64 * ATT_KROW, ATT_VB = 128 * ATT_VROW, ATT_BUF = ATT_KB + ATT_VB;
constexpr int ATT_RPB = 2 * ATT_BUF;
__device__ __forceinline__ int crow(int r, int hi) { return (r & 3) + 8 * (r >> 2) + 4 * hi; }

template <int DV, bool NAT>
__device__ __forceinline__ void attn_pass(Frame& F, const bf16* VT  , int kcol, int nA, int rowA0, int keyA0, int nB, int rowB0, int keyB0,
                                          const bf16x8 (&qf)[4], f32x16 (&o)[DV / 32], float& m_run, float& l_run,
                                          int my_r, int kr0, int qc, int wrow0 = 0, int w0 = 0) {
    const int tid = F.tid, lane = F.lane, q32 = lane & 31, hi = lane >> 5;
    const int nT = nA + nB;
    const int krow = tid >> 3, kch = tid & 7;
    u32x4 kreg, vreg[DV / 64], kreg1, vreg1[DV / 64];
#define ATT_LOAD2(t, KR, VR) do { const int t_ = (t); const int r0_ = t_ < nA ? rowA0 + 64 * t_ : rowB0 + 64 * (t_ - nA); const int k0_ = t_ < nA ? keyA0 + 64 * t_ : keyB0 + 64 * (t_ - nA); \
        KR = *(const u32x4*)(((bf16*)(F.ws + WS_U)) + (size_t)(r0_ + krow) * INC + kcol + kch * 8); \
        _Pragma("unroll") for (int i_ = 0; i_ < DV / 64; ++i_) { const int p_ = tid + NTHR * i_; VR[i_] = *(const u32x4*)(VT + (size_t)(p_ >> 3) * KEYS + k0_ + (p_ & 7) * 8); } } while (0)
#define ATT_STORE2(b, KR, VR) do { LAS unsigned char* kb_ = F.lds + (b) * ATT_BUF; *(LAS u32x4*)(kb_ + krow * ATT_KROW + kch * 16) = KR; \
        _Pragma("unroll") for (int i_ = 0; i_ < DV / 64; ++i_) { const int p_ = tid + NTHR * i_; LAS unsigned char* d_ = kb_ + ATT_KB + (p_ >> 3) * ATT_VROW + (p_ & 7) * 16; \
            *(LAS u32x4*)d_ = VR[i_]; } } while (0)
#define ATT_LOAD(t) ATT_LOAD2(t, kreg, vreg)
#define ATT_STORE(b) ATT_STORE2(b, kreg, vreg)
#define ATT_LBAR() asm volatile("s_waitcnt lgkmcnt(0)\n\ts_barrier" ::: "memory")
    ATT_LBAR();
    ATT_LOAD(0); if (NAT && nT > 1) ATT_LOAD2(1, kreg1, vreg1); ATT_STORE(0);
    ATT_LBAR();
    const int rs_my = NAT ? (my_r < 4 ? 0 : (my_r > 28 ? 24 : my_r - 4)) : 0;
    const int cs_my = NAT ? (qc < 8 ? 0 : (qc > 56 ? 48 : qc - 8)) : 0;
    const int rs_wlo = NAT ? (wrow0 < 4 ? 0 : (wrow0 > 28 ? 24 : wrow0 - 4)) : 0, rs_whi = NAT ? (wrow0 + 1 < 4 ? 0 : (wrow0 + 1 > 28 ? 24 : wrow0 + 1 - 4)) : 0;
    const int sig32 = (q32 & ~12) | ((q32 & 4) << 1) | ((q32 & 8) >> 1);
    auto tile = [&](const int t) __attribute__((always_inline)) {
        if (NAT && t < nA) {
          const int kr = kr0 + t;
          if (kr >= rs_wlo && kr < rs_whi + 8) {
            const LAS unsigned char* kb = F.lds + (t & 1) * ATT_BUF; const LAS unsigned char* vb = kb + ATT_KB;
            f32x16 p0;
#pragma unroll
            for (int i = 0; i < 16; ++i) p0[i] = 0.f;
            {   const unsigned ka = (unsigned)(unsigned long)kb + (unsigned)((w0 + sig32) * ATT_KROW + hi * 16);
                bf16x8 kf[4];
#define ATT_DSR(dst, addr, off) asm volatile("ds_read_b128 %0, %1 offset:%2" : "=v"(dst) : "v"(addr), "i"(off))
                ATT_DSR(kf[0], ka, 0); ATT_DSR(kf[1], ka, 32); ATT_DSR(kf[2], ka, 64); ATT_DSR(kf[3], ka, 96);
                asm volatile("s_waitcnt lgkmcnt(0)" : "+v"(kf[0]), "+v"(kf[1]), "+v"(kf[2]), "+v"(kf[3]));
#pragma unroll
                for (int d0 = 0; d0 < 4; ++d0) p0 = __builtin_amdgcn_mfma_f32_32x32x16_bf16(kf[d0], qf[d0], p0, 0, 0, 0);
#undef ATT_DSR
            }
            {   const bool rowok = (kr >= rs_my) && (kr < rs_my + 8);
                const LAS float* rpb = (const LAS float*)(F.lds + ATT_RPB) + (rowok ? kr - my_r + 7 : 7) * 31 + 15 - qc;
#pragma unroll
                for (int r = 0; r < 16; ++r) { const int kc = w0 + (r & 7) + 8 * hi + 16 * (r >> 3);
                    const bool v0 = rowok && ((unsigned)(kc - cs_my) < 16u);
                    const float bb0 = rpb[v0 ? kc : qc];
                    p0[r] = v0 ? p0[r] + bb0 : -INFINITY; }
            }
            float tm = p0[0];
#pragma unroll
            for (int r = 1; r < 16; ++r) tm = fmaxf(tm, p0[r]);
            if (__builtin_expect(__any(tm - m_run > 8.0f), 0)) { tm = fmaxf(tm, sx(tm, 32)) - m_run; const float dl = fmaxf(tm, 0.f);     m_run += dl; const float alpha = __builtin_amdgcn_exp2f(-dl); l_run *= alpha;
#pragma unroll
                for (int d = 0; d < DV / 32; ++d)
#pragma unroll
                    for (int r = 0; r < 16; ++r) o[d][r] *= alpha; }
            {   constexpr int ND = DV / 32;
                const unsigned va = (unsigned)(unsigned long)vb + (unsigned)(q32 * ATT_VROW + 16 * hi + 2 * w0);
                bf16x8 vA[2 * ND];
#define ATT_DSR(dst, addr, off) asm volatile("ds_read_b128 %0, %1 offset:%2" : "=v"(dst) : "v"(addr), "i"(off))
#pragma unroll
                for (int d = 0; d < ND; ++d) { ATT_DSR(vA[d], va, d * 32 * ATT_VROW); ATT_DSR(vA[ND + d], va, d * 32 * ATT_VROW + 32); }
#undef ATT_DSR
                float ls = 0.f;
#pragma unroll
                for (int r = 0; r < 16; ++r) { p0[r] = __builtin_amdgcn_exp2f(p0[r] - m_run); ls += p0[r]; }
                l_run += ls;
                u32x4 pw[2];
#pragma unroll
                for (int q = 0; q < 2; ++q) { const int s8 = 8 * q; pw[q].x = pk2(p0[s8 + 0], p0[s8 + 1]); pw[q].y = pk2(p0[s8 + 2], p0[s8 + 3]); pw[q].z = pk2(p0[s8 + 4], p0[s8 + 5]); pw[q].w = pk2(p0[s8 + 6], p0[s8 + 7]); }
                if constexpr (ND == 2) asm volatile("s_waitcnt lgkmcnt(0)" : "+v"(vA[0]), "+v"(vA[1]), "+v"(vA[2]), "+v"(vA[3]));
#pragma unroll
                for (int q = 0; q < 2; ++q)
#pragma unroll
                    for (int d = 0; d < ND; ++d) o[d] = __builtin_amdgcn_mfma_f32_32x32x16_bf16(vA[q * ND + d], __builtin_bit_cast(bf16x8, pw[q]), o[d], 0, 0, 0);
            }
          }
        } else {
            const LAS unsigned char* kb = F.lds + (t & 1) * ATT_BUF; const LAS unsigned char* vb = kb + ATT_KB;
            f32x16 p0, p1;
#pragma unroll
            for (int i = 0; i < 16; ++i) { p0[i] = 0.f; p1[i] = 0.f; }
            {
                const unsigned ka = (unsigned)(unsigned long)kb + (unsigned)(sig32 * ATT_KROW + hi * 16);
                bf16x8 kf[8];
#define ATT_DSR(dst, addr, off) asm volatile("ds_read_b128 %0, %1 offset:%2" : "=v"(dst) : "v"(addr), "i"(off))
                ATT_DSR(kf[0], ka, 0); ATT_DSR(kf[1], ka, 32 * ATT_KROW); ATT_DSR(kf[2], ka, 32); ATT_DSR(kf[3], ka, 32 * ATT_KROW + 32);
                ATT_DSR(kf[4], ka, 64); ATT_DSR(kf[5], ka, 32 * ATT_KROW + 64); ATT_DSR(kf[6], ka, 96); ATT_DSR(kf[7], ka, 32 * ATT_KROW + 96);
                asm volatile("s_waitcnt lgkmcnt(0)" : "+v"(kf[0]), "+v"(kf[1]), "+v"(kf[2]), "+v"(kf[3]), "+v"(kf[4]), "+v"(kf[5]), "+v"(kf[6]), "+v"(kf[7]));
#pragma unroll
                for (int d0 = 0; d0 < 4; ++d0) {
                    p0 = __builtin_amdgcn_mfma_f32_32x32x16_bf16(kf[2 * d0], qf[d0], p0, 0, 0, 0);
                    p1 = __builtin_amdgcn_mfma_f32_32x32x16_bf16(kf[2 * d0 + 1], qf[d0], p1, 0, 0, 0);
                }
            }
            float tm = fmaxf(p0[0], p1[0]);
#pragma unroll
            for (int r = 1; r < 16; ++r) tm = fmaxf(tm, fmaxf(p0[r], p1[r]));
            if (__builtin_expect(__any(tm - m_run > 8.0f), 0)) { tm = fmaxf(tm, sx(tm, 32)) - m_run; const float dl = fmaxf(tm, 0.f); m_run += dl; const float alpha = __builtin_amdgcn_exp2f(-dl); l_run *= alpha;
#pragma unroll
                for (int d = 0; d < DV / 32; ++d)
#pragma unroll
                    for (int r = 0; r < 16; ++r) o[d][r] *= alpha; }
            const bool shifted = __any(m_run != 0.f);
            float ls = 0.f;
            if (shifted) {
#pragma unroll
                for (int r = 0; r < 16; ++r) { p0[r] = __builtin_amdgcn_exp2f(p0[r] - m_run); ls += p0[r]; }
            } else {
#pragma unroll
                for (int r = 0; r < 16; ++r) { p0[r] = __builtin_amdgcn_exp2f(p0[r]); ls += p0[r]; }
            }
            {   constexpr int ND = DV / 32;
                const unsigned va = (unsigned)(unsigned long)vb + (unsigned)(q32 * ATT_VROW + 16 * hi);
                bf16x8 vA[2 * ND], vB[2 * ND];
#define ATT_PIN_WAIT(v) do { if constexpr (ND == 4) asm volatile("s_waitcnt lgkmcnt(0)" : "+v"(v[0]), "+v"(v[1]), "+v"(v[2]), "+v"(v[3]), "+v"(v[4]), "+v"(v[5]), "+v"(v[6]), "+v"(v[7])); \
                                  else asm volatile("s_waitcnt lgkmcnt(0)" : "+v"(v[0]), "+v"(v[1]), "+v"(v[2]), "+v"(v[3])); } while (0)
#pragma unroll
                for (int d = 0; d < ND; ++d) { ATT_DSR(vA[d], va, d * 32 * ATT_VROW); ATT_DSR(vA[ND + d], va, d * 32 * ATT_VROW + 32); }
                u32x4 pw[4];
#pragma unroll
                for (int q = 0; q < 2; ++q) { const int s8 = 8 * q; pw[q].x = pk2(p0[s8 + 0], p0[s8 + 1]); pw[q].y = pk2(p0[s8 + 2], p0[s8 + 3]); pw[q].z = pk2(p0[s8 + 4], p0[s8 + 5]); pw[q].w = pk2(p0[s8 + 6], p0[s8 + 7]); }
                ATT_PIN_WAIT(vA);
#pragma unroll
                for (int d = 0; d < ND; ++d) { ATT_DSR(vB[d], va, d * 32 * ATT_VROW + 64); ATT_DSR(vB[ND + d], va, d * 32 * ATT_VROW + 96); }
#pragma unroll
                for (int q = 0; q < 2; ++q)
#pragma unroll
                    for (int d = 0; d < ND; ++d) o[d] = __builtin_amdgcn_mfma_f32_32x32x16_bf16(vA[q * ND + d], __builtin_bit_cast(bf16x8, pw[q]), o[d], 0, 0, 0);
                if (shifted) {
#pragma unroll
                    for (int r = 0; r < 16; ++r) { p1[r] = __builtin_amdgcn_exp2f(p1[r] - m_run); ls += p1[r]; }
                } else {
#pragma unroll
                    for (int r = 0; r < 16; ++r) { p1[r] = __builtin_amdgcn_exp2f(p1[r]); ls += p1[r]; }
                }
#pragma unroll
                for (int q = 0; q < 2; ++q) { const int s8 = 8 * q; pw[2 + q].x = pk2(p1[s8 + 0], p1[s8 + 1]); pw[2 + q].y = pk2(p1[s8 + 2], p1[s8 + 3]); pw[2 + q].z = pk2(p1[s8 + 4], p1[s8 + 5]); pw[2 + q].w = pk2(p1[s8 + 6], p1[s8 + 7]); }
#pragma unroll
                for (int i = 0; i < 2 * ND; ++i) { __builtin_amdgcn_sched_group_barrier(0x008, 1, 0); __builtin_amdgcn_sched_group_barrier(0x002, 40 / (2 * ND) + 1, 0); }
                l_run += ls;
                ATT_PIN_WAIT(vB);
#pragma unroll
                for (int q = 0; q < 2; ++q)
#pragma unroll
                    for (int d = 0; d < ND; ++d) o[d] = __builtin_amdgcn_mfma_f32_32x32x16_bf16(vB[q * ND + d], __builtin_bit_cast(bf16x8, pw[2 + q]), o[d], 0, 0, 0);
#undef ATT_PIN_WAIT
            }
        }
    };
    if constexpr (NAT) {
        for (int t = 0; t < nT; t += 2) {
            if (t + 2 < nT) ATT_LOAD2(t + 2, kreg, vreg);
            tile(t);
            if (t + 1 < nT) ATT_STORE2(1, kreg1, vreg1);
            ATT_LBAR();
            if (t + 1 >= nT) break;
            if (t + 3 < nT) ATT_LOAD2(t + 3, kreg1, vreg1);
            tile(t + 1);
            if (t + 2 < nT) ATT_STORE2(0, kreg, vreg);
            ATT_LBAR();
        }
    } else {
    for (int t = 0; t < nT; ++t) {
        const bool more = t + 1 < nT;
        if (more) ATT_LOAD(t + 1);
        tile(t);
        if (more) ATT_STORE((t + 1) & 1);
        ATT_LBAR();
    }
    }
#undef ATT_LOAD
#undef ATT_STORE
#undef ATT_LOAD2
#undef ATT_LBAR
#undef ATT_STORE2
}
__device__ __forceinline__ void load_qf(const bf16* qrow  , int hi, bf16x8 (&qf)[4]) {
#pragma unroll
    for (int d0 = 0; d0 < 4; ++d0) qf[d0] = *(const bf16x8*)(qrow + d0 * 16 + hi * 8);
}
__device__ __forceinline__ void diff_unit(Frame& F, int layer, int b, int h, int qrow0, bool lat, const float lam, const float lam_init) {
    const int lane = F.lane, q32 = lane & 31, hi = lane >> 5; const int row = qrow0 + F.wave * 32 + q32;
    const bf16* VT = ((bf16*)(F.ws + WS_VTD)) + (size_t)((b * 4 + h) * 128) * KEYS;
    const int nB = lat ? 32 : 0;
    LAS unsigned* o1s = (LAS unsigned*)(F.lds + 65536) + F.wave * 2048 + lane;
    {   f32x16 o1[4]; bf16x8 qf[4]; load_qf(((bf16*)(F.ws + WS_U)) + (size_t)row * INC + C_DQ + 128 * h, hi, qf);
        float m = 0.f, l = 0.f;
#pragma unroll
        for (int d = 0; d < 4; ++d)
#pragma unroll
            for (int r = 0; r < 16; ++r) o1[d][r] = 0.f;
        attn_pass<128, false>(F, VT, C_DK + 128 * h, 4, T_LAT + b * NCTX, 0, nB, b * SEQ, NCTX, qf, o1, m, l, 0, 0, 0);
        l += sx(l, 32); const float il = 1.0f / l;
#pragma unroll
        for (int d = 0; d < 4; ++d)
#pragma unroll
            for (int r = 0; r < 8; ++r) o1s[(d * 8 + r) * 64] = pk2(o1[d][2 * r] * il, o1[d][2 * r + 1] * il); }
    {   f32x16 o2[4]; bf16x8 qf[4]; load_qf(((bf16*)(F.ws + WS_U)) + (size_t)row * INC + C_DQ + 128 * h + 64, hi, qf);
        float m = 0.f, l = 0.f;
#pragma unroll
        for (int d = 0; d < 4; ++d)
#pragma unroll
            for (int r = 0; r < 16; ++r) o2[d][r] = 0.f;
        attn_pass<128, false>(F, VT, C_DK + 128 * h + 64, 4, T_LAT + b * NCTX, 0, nB, b * SEQ, NCTX, qf, o2, m, l, 0, 0, 0);
        l += sx(l, 32); const float il = lam / l;
        float ss = 0.f;
#pragma unroll
        for (int d = 0; d < 4; ++d)
#pragma unroll
            for (int r = 0; r < 8; ++r) { const unsigned ow = o1s[(d * 8 + r) * 64]; const float a0 = bflo(ow) - il * o2[d][2 * r], a1 = bfhi(ow) - il * o2[d][2 * r + 1]; o2[d][2 * r] = a0; o2[d][2 * r + 1] = a1; ss += a0 * a0 + a1 * a1; }
        ss += sx(ss, 32);
        const float rn = (1.0f / sqrtf(ss * (1.0f / 128.0f) + LN_EPS)) * (1.0f - lam_init);
        const float* sg = F.in[15] + layer * 128;
        bf16* dst = ((bf16*)(F.ws + WS_YB)) + (size_t)row * DB + 128 * h;
#pragma unroll
        for (int d = 0; d < 4; ++d)
#pragma unroll
            for (int rp = 0; rp < 2; ++rp) { unsigned wx[2], wy[2];
#pragma unroll
                for (int k = 0; k < 2; ++k) { const int r4 = 2 * rp + k; const int dv = 32 * d + 8 * r4 + 4 * hi; const f32x4 g = *(const f32x4*)(sg + dv);
                    wx[k] = pk2(o2[d][4 * r4] * rn * g[0], o2[d][4 * r4 + 1] * rn * g[1]); wy[k] = pk2(o2[d][4 * r4 + 2] * rn * g[2], o2[d][4 * r4 + 3] * rn * g[3]); }
                swap32(wx[0], wx[1]); swap32(wy[0], wy[1]);
                *(u32x4*)(dst + 32 * d + 16 * rp + 8 * hi) = (u32x4){wx[0], wy[0], wx[1], wy[1]}; } }
}
__device__ __forceinline__ void nat_unit(Frame& F, int layer, int b, int h, int rq) {
    const int lane = F.lane, q32 = lane & 31, hi = lane >> 5;
    const int wrow0 = 4 * rq + 2 * (F.wave >> 2), c0 = 16 * (F.wave & 3);
    const int w0 = c0 < 8 ? 0 : (c0 - 8 > 32 ? 32 : c0 - 8);
    const int my_r = wrow0 + (q32 >> 4), qc = c0 + (q32 & 15); const int row = b * SEQ + 64 * my_r + qc;
    if ((F.G & 63) != 0) { __syncthreads(); LAS float* rp = (LAS float*)(F.lds + ATT_RPB); const float* src = F.in[16] + ((size_t)layer * 8 + h) * 465; for (int i = F.tid; i < 465; i += NTHR) rp[i] = src[i] * LOG2E; }
    const int r_lo = 4 * rq, r_hi = 4 * rq + 3;
    const int kr0 = r_lo < 4 ? 0 : (r_lo > 28 ? 24 : r_lo - 4); const int krl = (r_hi < 4 ? 0 : (r_hi > 28 ? 24 : r_hi - 4)) + 7;
    const int nloc = krl - kr0 + 1;
    bf16x8 qf[4]; load_qf(((bf16*)(F.ws + WS_U)) + (size_t)row * INC + C_NQ + 64 * h, hi, qf);
    f32x16 o[2]; float m = 0.f, l = 0.f;
#pragma unroll
    for (int d = 0; d < 2; ++d)
#pragma unroll
        for (int r = 0; r < 16; ++r) o[d][r] = 0.f;
    attn_pass<64, true>(F, ((bf16*)(F.ws + WS_VTN)) + (size_t)((b * 8 + h) * 64) * KEYS, C_NK + 64 * h, nloc, b * SEQ + 64 * kr0, NCTX + 64 * kr0, 4, T_LAT + b * NCTX, 0, qf, o, m, l, my_r, kr0, qc, __builtin_amdgcn_readfirstlane(wrow0), __builtin_amdgcn_readfirstlane(w0));
    l += sx(l, 32); const float il = 1.0f / l;
    bf16* dst = ((bf16*)(F.ws + WS_YC)) + (size_t)row * DB + 64 * h;
#pragma unroll
    for (int d = 0; d < 2; ++d)
#pragma unroll
        for (int rp = 0; rp < 2; ++rp) { unsigned wx[2], wy[2];
#pragma unroll
            for (int k = 0; k < 2; ++k) { const int r4 = 2 * rp + k; wx[k] = pk2(o[d][4 * r4] * il, o[d][4 * r4 + 1] * il); wy[k] = pk2(o[d][4 * r4 + 2] * il, o[d][4 * r4 + 3] * il); }
            swap32(wx[0], wx[1]); swap32(wy[0], wy[1]);
            *(u32x4*)(dst + 32 * d + 16 * rp + 8 * hi) = (u32x4){wx[0], wy[0], wx[1], wy[1]}; }
}
__device__ __forceinline__ void natctx_unit(Frame& F, int b, int h) {
    const int lane = F.lane, q32 = lane & 31, hi = lane >> 5; const int row = T_LAT + b * NCTX + F.wave * 32 + q32;
    bf16x8 qf[4]; load_qf(((bf16*)(F.ws + WS_U)) + (size_t)row * INC + C_NQ + 64 * h, hi, qf);
    f32x16 o[2]; float m = 0.f, l = 0.f;
#pragma unroll
    for (int d = 0; d < 2; ++d)
#pragma unroll
        for (int r = 0; r < 16; ++r) o[d][r] = 0.f;
    attn_pass<64, false>(F, ((bf16*)(F.ws + WS_VTN)) + (size_t)((b * 8 + h) * 64) * KEYS, C_NK + 64 * h, 4, T_LAT + b * NCTX, 0, 0, 0, 0, qf, o, m, l, 0, 0, 0);
    l += sx(l, 32); const float il = 1.0f / l;
    bf16* dst = ((bf16*)(F.ws + WS_YC)) + (size_t)row * DB + 64 * h;
#pragma unroll
    for (int d = 0; d < 2; ++d)
#pragma unroll
        for (int rp = 0; rp < 2; ++rp) { unsigned wx[2], wy[2];
#pragma unroll
            for (int k = 0; k < 2; ++k) { const int r4 = 2 * rp + k; wx[k] = pk2(o[d][4 * r4] * il, o[d][4 * r4 + 1] * il); wy[k] = pk2(o[d][4 * r4 + 2] * il, o[d][4 * r4 + 3] * il); }
            swap32(wx[0], wx[1]); swap32(wy[0], wy[1]);
            *(u32x4*)(dst + 32 * d + 16 * rp + 8 * hi) = (u32x4){wx[0], wy[0], wx[1], wy[1]}; }
}

constexpr int N_PHASES = 2 + 8 * DEPTH;
struct Args { const float* in[29]; float* out; unsigned char* ws; int ph_lo, ph_hi; };
__global__ void diag_nan_scan(const float* out, unsigned* res) {
    const int row = blockIdx.x; bool bad = false;
    for (int c = threadIdx.x; c < DM; c += blockDim.x) { const float v = out[(size_t)row * DM + c]; if (!(fabsf(v) < 3.0e38f)) bad = true; }
    if (__syncthreads_or(bad) && threadIdx.x == 0) { atomicAdd(&res[0], 1u); atomicMin(&res[1], (unsigned)row); atomicMax(&res[2], (unsigned)row); }
}
__global__ void diag_fill(float* out, const unsigned* res, int which) {
    float c = 0.f; if (which == 0) c = (float)res[0] / 16.f; if (which == 1) c = (float)(res[1] >> 8) + 1.f; if (which == 2) c = (float)(res[2] >> 8) + 1.f; if (which == 3) c = (float)(res[1] & 255) + 1.f;
    for (size_t i = (size_t)blockIdx.x * blockDim.x + threadIdx.x; i < (size_t)T_LAT * DM; i += (size_t)gridDim.x * blockDim.x) out[i] = c;
}
#ifndef DIAG_MODE
#define DIAG_MODE 34
#endif
__global__ void diag_copy_kernel(const unsigned char* ws, float* out) {
    for (size_t i = (size_t)blockIdx.x * blockDim.x + threadIdx.x; i < (size_t)T_LAT * DM; i += (size_t)gridDim.x * blockDim.x) {
        const int r = (int)(i >> 10), c = (int)(i & 1023); float v = 0.f;
        if (DIAG_MODE == 0) v = ((const float*)(ws + WS_X))[i];
        if (DIAG_MODE == 1) { const bf16* U = (const bf16*)(ws + WS_U); for (int k = 0; k < 7; ++k) v += bf2f(U[(size_t)r * INC + c + 1024 * k]) + bf2f(U[(size_t)(T_LAT + (r & 4095)) * INC + c + 1024 * k]);
            if (i < (size_t)16 * 4 * 128 * KEYS) v += bf2f(((const bf16*)(ws + WS_VTD))[i]) + bf2f(((const bf16*)(ws + WS_VTN))[i]); }
        if (DIAG_MODE == 2) { v = c < 512 ? bf2f(((const bf16*)(ws + WS_YA))[(size_t)r * DB + c]) + 2.f * bf2f(((const bf16*)(ws + WS_YB))[(size_t)r * DB + c]) : bf2f(((const bf16*)(ws + WS_YC))[(size_t)r * DB + c - 512]);
            v += c < 512 ? bf2f(((const bf16*)(ws + WS_YA))[(size_t)(T_LAT + (r & 4095)) * DB + c]) + 2.f * bf2f(((const bf16*)(ws + WS_YB))[(size_t)(T_LAT + (r & 4095)) * DB + c]) : bf2f(((const bf16*)(ws + WS_YC))[(size_t)(T_LAT + (r & 4095)) * DB + c - 512]); }
        if (DIAG_MODE == 6) { const bf16* U = (const bf16*)(ws + WS_U); for (int k = 4; k < 7; ++k) v += bf2f(U[(size_t)r * INC + c + 1024 * k]) + bf2f(U[(size_t)(T_LAT + (r & 4095)) * INC + c + 1024 * k]); }
        if (DIAG_MODE == 7) { const bf16* U = (const bf16*)(ws + WS_U); const int cc = c & 511; v = bf2f(U[(size_t)r * INC + cc]) + bf2f(U[(size_t)r * INC + 1024 + c]) + bf2f(U[(size_t)r * INC + 2560 + c]) + bf2f(U[(size_t)(T_LAT + (r & 4095)) * INC + cc]) + bf2f(U[(size_t)(T_LAT + (r & 4095)) * INC + 1024 + c]) + bf2f(U[(size_t)(T_LAT + (r & 4095)) * INC + 2560 + c]); }
        if (DIAG_MODE == 8) { const bf16* W = (const bf16*)(ws + WS_WIN); v = bf2f(W[(size_t)(r % 7168) * DM + c]) + bf2f(W[(size_t)(7168 + (r % 7168)) * DM + c]); }
        if (DIAG_MODE == 20) { const unsigned* ctl = (const unsigned*)(ws + WS_CTL); unsigned t = 0; for (int e = 0; e < 32; ++e) t += ctl[CW_ECNT + e * 64]; v = 10.f * (float)t / 147456.f; }
        if (DIAG_MODE == 21) { const bf16* Y = (const bf16*)(ws + WS_YK); float a = 0.f; for (int k = 0; k < 256; ++k) a += fabsf(bf2f(Y[(size_t)k * 500009 + (i & 65535)])); v = 100.f * a / 256.f; }
        if (DIAG_MODE == 22) { const bf16* Y = (const bf16*)(ws + WS_U); float a = 0.f; for (int k = 0; k < 256; ++k) a += fabsf(bf2f(Y[(size_t)k * 500009 + (i & 65535)])); v = 100.f * a / 256.f; }
        if (DIAG_MODE == 23) { const u32x2* L = (const u32x2*)(ws + WS_LIST); float a = 0.f; for (int e = 0; e < 32; ++e) for (int k = 0; k < 8; ++k) a += __builtin_bit_cast(float, L[(size_t)e * LIST_CAP + k * 100].y); v = 100.f * a / 256.f; }
        if (DIAG_MODE == 24) { const u32x2* L = (const u32x2*)(ws + WS_LIST); float a = 0.f; for (int e = 0; e < 32; ++e) for (int k = 0; k < 8; ++k) a += (L[(size_t)e * LIST_CAP + k * 100].x < 131072u) ? 1.f : 0.f; v = 10.f * a / 256.f; }
        if (DIAG_MODE == 25) { const unsigned short* Y = (const unsigned short*)(ws + WS_YK); float a = 0.f; for (int k = 0; k < 256; ++k) a += (Y[(size_t)k * 500009 + (i & 65535)] != 0xAAAAu) ? 1.f : 0.f; v = 10.f * a / 256.f; }
        if (DIAG_MODE == 27) { const u32x2* L = (const u32x2*)(ws + WS_LIST); float a = 0.f; for (int e = 0; e < 32; ++e) for (int k = 0; k < 8; ++k) a += (float)(L[(size_t)e * LIST_CAP + k * 100].y >> 20); v = a / 256.f; }
        if (DIAG_MODE == 28) { const u32x2* L = (const u32x2*)(ws + WS_LIST); float a = 0.f; for (int e = 0; e < 32; ++e) for (int k = 0; k < 8; ++k) { const float w = __builtin_bit_cast(float, L[(size_t)e * LIST_CAP + k * 100].y); a += (w > 0.01f && w < 1.0f) ? 1.f : 0.f; } v = a / 25.6f; }
        if (DIAG_MODE == 29) { const u32x2* L = (const u32x2*)(ws + WS_LIST); float a = 0.f; for (int e = 0; e < 32; ++e) for (int k = 0; k < 8; ++k) a += ((L[(size_t)e * LIST_CAP + k * 100].y >> 20) > 2000u) ? 1.f : 0.f; v = a / 25.6f; }
        if (DIAG_MODE == 31) { const u32x2* L = (const u32x2*)(ws + WS_LIST); v = 100.f * __builtin_bit_cast(float, L[5].y); }
        if (DIAG_MODE == 32) { const u32x2* L = (const u32x2*)(ws + WS_LIST); v = (float)(L[5].y >> 20); }
        if (DIAG_MODE == 33) { v = 25.f; }
        if (DIAG_MODE == 34) { const u32x2* L = (const u32x2*)(ws + WS_LIST); const unsigned y = L[5].y; v = (y > 0x3C000000u && y < 0x3F800001u) ? 25.f : ((y >> 20) < 944u ? 50.f : 75.f); }
        if (DIAG_MODE == 3) { const bf16* Z = (const bf16*)(ws + WS_MB); v = bf2f(Z[(size_t)r * DM + c]);
#if !defined(DIAG_ONEJ)
 v += bf2f(Z[(size_t)r * 3072 + 1024 + c]) + bf2f(Z[(size_t)r * 3072 + 2048 + c]);
#endif
 }
        if (DIAG_MODE == 4) v = ((const float*)(ws + WS_MV))[i];
        if (DIAG_MODE == 5) v = bf2f(((const bf16*)(ws + WS_H))[i]);
        out[i] = v; }
}
#ifndef PHASE_MASK
#define PHASE_MASK 0xffffffffu
#endif
#define PMASK(k) ((PHASE_MASK >> (((k) < 2) ? (k) : 2 + (((k) - 2) & 7))) & 1u)
#define IN(k) (PMASK(k) && lo <= (k) && (k) < hi)
#define LAUNDER() do { int wv_ = F.wave0; asm volatile("" : "+s"(wv_)); const int t_ = (wv_ << 6) | lane_now(); F.tid = t_; F.lane = t_ & 63; F.wave = wv_; unsigned char* w_ = args.ws; asm volatile("" : "+s"(w_)); F.ws = (GAS unsigned char*)w_; F.ctl = (gu32*)(w_ + WS_CTL); unsigned long long z_ = 0; asm volatile("" : "+s"(z_)); F.in = args.in + z_; int b_ = blockIdx.x, g_ = gridDim.x; asm volatile("" : "+s"(b_), "+s"(g_)); F.bid = b_; F.G = g_; } while (0)
#define SEAM(k) do { if (IN(k) && IN((k) + 1)) xcd_barrier(bar); } while (0)
template <int layer>
__device__ __forceinline__ void layer_phases(Frame& F, const Args& args, const XcdBarrier& bar, const int lo, const int hi, const int vcu) {
        const int pb = 2 + 8 * layer;
        const bool with_ctx = layer < DEPTH - 1;
        const int nrows = with_ctx ? T_ALL : T_LAT;
        if (IN(pb + 0)) { LAUNDER();
            pg8::StaticOrder S; S.init_bytes((unsigned char*)(F.ws + WS_H8), DM, (unsigned char*)(F.ws + WS_WIN) + (size_t)layer * INC * DM, DM, T_ALL, INC, F.G, F.bid);
            EpiWin E{F.ws, W8_INV};
            pg8::gemm_phase<EpiWin, pg8::StaticOrder, true>(F.lds, F.wave, DM, DM, S, E);
        } SEAM(pb + 0);
        if (IN(pb + 1)) { LAUNDER();
#ifndef UNIT_MASK
#define UNIT_MASK 15
#endif
            const int nsq = with_ctx ? 576 : 512;
            const float lam_init = 0.8f - 0.6f * expf(-0.3f * (float)layer);
            const float lam = expf(wave_sum(F.in[11][layer * 64 + F.lane] * F.in[12][layer * 64 + F.lane])) - expf(wave_sum(F.in[13][layer * 64 + F.lane] * F.in[14][layer * 64 + F.lane])) + lam_init;
            if (UNIT_MASK & 1) for (int u = vcu; u < nsq; u += F.G) { const bool lat = u < 512; const int b = lat ? (u >> 5) : ((u - 512) >> 2), h = lat ? ((u >> 3) & 3) : ((u - 512) & 3);
                diff_unit(F, layer, b, h, lat ? b * SEQ + (u & 7) * 256 : T_LAT + b * NCTX, lat, lam, lam_init); }
            { __syncthreads(); LAS float* rp = (LAS float*)(F.lds + ATT_RPB); const float* src = F.in[16] + ((size_t)layer * 8 + ((vcu >> 3) & 7)) * 465; for (int i = F.tid; i < 465; i += NTHR) rp[i] = src[i] * LOG2E; }
            if (UNIT_MASK & 2) for (int u = vcu; u < 1024; u += F.G) nat_unit(F, layer, u >> 6, (u >> 3) & 7, u & 7);
            if (UNIT_MASK & 4) conv_units(F, layer, 2 * nsq);
            if ((UNIT_MASK & 8) && with_ctx) for (int u = F.bid; u < 128; u += F.G) natctx_unit(F, u >> 3, u & 7);
            __syncthreads();
        } SEAM(pb + 1);
        if (IN(pb + 2)) { LAUNDER();
            MergeOrder S; S.Y = (const char*)(F.ws + WS_YA); S.W = (const char*)(((bf16*)(F.ws + WS_WBR)) + (size_t)layer * 3 * DM * DB); S.T.init(nullptr, DB, nullptr, DB, nrows, DM, F.G, F.bid);
            EpiMB E{((bf16*)(F.ws + WS_U)), ((bf16*)(F.ws + WS_MB))};
            pg8::gemm_phase<EpiMB, MergeOrder>(F.lds, F.wave, DB * 2, DB * 2, S, E);
            if (layer == 0 && F.G == 256 && F.bid >= 64) convert_items(F, CV_LAYER + CV_P0_L1, CV_LAYER + CV_P0_L1 + CV_SLOT_A, (F.bid - 64) * NWAVES + F.wave, 192 * NWAVES);
        } SEAM(pb + 2);
        if (IN(pb + 3)) { LAUNDER();
            pg8::StaticOrder S; S.init(((bf16*)(F.ws + WS_MB)), DM, ((bf16*)(F.ws + WS_WOUT)) + (size_t)layer * DM * DM, DM, nrows, DM, F.G, F.bid);
            EpiWout E{((float*)(F.ws + WS_MOD)) + (size_t)layer * 17 * 6144 + 2048, ((bf16*)(F.ws + WS_MV))};
            pg8::gemm_phase<EpiWout, pg8::StaticOrder>(F.lds, F.wave, DM * 2, DM * 2, S, E);
            if (layer == 0 && F.G == 256 && F.bid >= 64) convert_items(F, CV_LAYER + CV_P0_L1 + CV_SLOT_A, 2 * CV_LAYER, (F.bid - 64) * NWAVES + F.wave, 192 * NWAVES);
        } SEAM(pb + 3);
        if (IN(pb + 4)) { LAUNDER(); p5_ln1_router(F, layer, nrows); } SEAM(pb + 4);
        if (IN(pb + 5)) { LAUNDER();
            moe_build_tiles(F, layer, 8, true);
            MoeSched1 S{(const char*)(F.ws + WS_H8), (const char*)(F.ws + WS_W1 + (size_t)layer * NE * 2048 * DM), (LAS const int*)(F.lds + TILE_OFF), (LAS const unsigned short*)(F.lds + IDX_OFF), (int)F.MISC[MI_NUNITS]};
            EpiMoe1 E{(unsigned char*)(F.ws + WS_U), F.in[24] + (size_t)layer * NE * 2048};
            pg8::gemm_phase<EpiMoe1, MoeSched1, true>(F.lds, F.wave, DM, DM, S, E);
        } SEAM(pb + 5);
        if (IN(pb + 6)) { LAUNDER();
            moe_build_tiles(F, layer, 4, false);
            MoeSched2 S{(const char*)(F.ws + WS_U), (const char*)(F.ws + WS_W2 + (size_t)layer * NE * DM * DFF), (LAS const int*)(F.lds + TILE_OFF), (int)F.MISC[MI_NUNITS]};
            EpiMoe2 E{(unsigned char*)(F.ws + WS_YK), F.in[26] + (size_t)layer * NE * DM, ((u32x2*)(F.ws + WS_LIST))};
            pg8::gemm_phase<EpiMoe2, MoeSched2, true>(F.lds, F.wave, DFF, DFF, S, E);
        } SEAM(pb + 6);
        if (IN(pb + 7)) { LAUNDER(); p8_final(F, layer, nrows); } SEAM(pb + 7);
    }
__global__ void __launch_bounds__(NTHR, 2) fwd_kernel(Args args) {
    extern __shared__ __attribute__((aligned(16))) unsigned char lds_raw[];
    Frame F;
    F.lds = (LAS unsigned char*)lds_raw;
    F.MISC = (volatile LAS unsigned*)(F.lds + MISC_OFF);
    F.tid = threadIdx.x; F.lane = F.tid & 63; F.wave = __builtin_amdgcn_readfirstlane(F.tid >> 6); F.wave0 = F.wave; F.G = gridDim.x; F.bid = blockIdx.x;
    unsigned char* ws = args.ws;
    F.ctl = (gu32*)(ws + WS_CTL);
    F.in = args.in; F.out = (GAS float*)args.out; F.ws = (GAS unsigned char*)ws;
    for (int u = F.tid; u < (LDS_BYTES - MISC_OFF) / 4; u += NTHR) ((LAS unsigned*)(F.lds + MISC_OFF))[u] = 0u;
    __syncthreads();
    const int lo = args.ph_lo, hi = args.ph_hi;
    XcdBarrier bar; bar.bar = (unsigned*)(F.ctl + CW_BAR); bar.x = 0; bar.st = nullptr; bar.w0 = F.wave0;
    if (hi - lo > 1) { bar = xcd_barrier_post((unsigned*)(F.ctl + CW_BAR), F.MISC + MI_BAR); bar.w0 = F.wave0; }
    const int vcu = (F.G % 8 == 0) ? (F.bid % 8) * (F.G / 8) + F.bid / 8 : F.bid;

    if (IN(0)) { LAUNDER(); p0_prologue(F); } SEAM(0);
    if (IN(1)) { LAUNDER(); p1_modulate0(F); } SEAM(1);

    layer_phases<0>(F, args, bar, lo, hi, vcu);
    layer_phases<1>(F, args, bar, lo, hi, vcu);
#undef IN
#undef SEAM
}

extern "C" void kernel_launch(void* const* d_in, const int* in_sizes, int n_in, void* d_out, int out_size, void* d_ws, size_t ws_size, hipStream_t stream) {
    static int grid = 0;
    if (grid == 0) {
        if (n_in != 29 || out_size != T_LAT * DM || ws_size < WS_END) { fprintf(stderr, "kernel_launch: unexpected shapes (n_in %d out %d ws %zu need %zu)\n", n_in, out_size, ws_size, (size_t)WS_END); grid = -1; return; }
        int dev = 0, cus = 0, per_cu = 0;
        if (hipGetDevice(&dev) != hipSuccess || hipDeviceGetAttribute(&cus, hipDeviceAttributeMultiprocessorCount, dev) != hipSuccess) { grid = -1; return; }
        if (hipFuncSetAttribute((const void*)fwd_kernel, hipFuncAttributeMaxDynamicSharedMemorySize, LDS_BYTES) != hipSuccess) { fprintf(stderr, "kernel_launch: hipFuncSetAttribute failed\n"); grid = -1; return; }
        if (hipOccupancyMaxActiveBlocksPerMultiprocessor(&per_cu, (const void*)fwd_kernel, NTHR, LDS_BYTES) != hipSuccess || per_cu < 1) fprintf(stderr, "kernel_launch: occupancy query reports %d\n", per_cu);
        (void)hipGetLastError();
        grid = cus < 256 ? cus : 256;
        if (grid != 256) fprintf(stderr, "kernel_launch: %d CUs; this kernel is sized for 256\n", cus);
    }
    if (grid < 0) return;
    if (hipMemsetAsync((char*)d_ws + WS_CTL, 0, CTL_ZERO_BYTES, stream) != hipSuccess) return;
    Args a{};
    for (int i = 0; i < 29; ++i) a.in[i] = (const float*)d_in[i];
    a.out = (float*)d_out; a.ws = (unsigned char*)d_ws;
#if MK_ONE_LAUNCH
    a.ph_lo = 0; a.ph_hi = N_PHASES;
    hipLaunchKernelGGL(fwd_kernel, dim3(grid), dim3(NTHR), LDS_BYTES, stream, a);
#else
    const int np = DIAG_STOP ? DIAG_STOP : N_PHASES;
    for (int p = 0; p < np; ++p) { a.ph_lo = p; a.ph_hi = p + 1; hipLaunchKernelGGL(fwd_kernel, dim3(grid), dim3(NTHR), LDS_BYTES, stream, a); }
#ifdef DIAG_NAN
    { unsigned* res = (unsigned*)((char*)d_ws + 512 * 1024); hipMemsetAsync(res, 0, 4, stream); hipMemsetAsync(res + 1, 0xFF, 4, stream); hipMemsetAsync(res + 2, 0, 4, stream);
      hipLaunchKernelGGL(diag_nan_scan, dim3(T_LAT), dim3(256), 0, stream, (const float*)d_out, res);
      hipLaunchKernelGGL(diag_fill, dim3(2048), dim3(256), 0, stream, (float*)d_out, (const unsigned*)res, DIAG_NAN); }
#endif
    if (DIAG_STOP) hipLaunchKernelGGL(diag_copy_kernel, dim3(2048), dim3(256), 0, stream, (const unsigned char*)d_ws, (float*)d_out);
#endif
}
```

```cpp
#include <hip/hip_runtime.h>
#include <cstdio>
#include <cstdint>

#define DIAG_GATEPLAIN 0
#ifndef ABL
#define ABL 0
#endif
#ifndef DIAG_STOP
#define DIAG_STOP 0
#endif
#ifndef MK_ONE_LAUNCH
#define MK_ONE_LAUNCH 1
#endif

#define LAS __attribute__((address_space(3)))
#define GAS __attribute__((address_space(1)))
typedef unsigned short bf16;
typedef short bf16x8 __attribute__((ext_vector_type(8)));
typedef float f32x4 __attribute__((ext_vector_type(4)));
typedef float f32x2 __attribute__((ext_vector_type(2)));
typedef float f32x16 __attribute__((ext_vector_type(16)));
typedef unsigned u32x4 __attribute__((ext_vector_type(4)));
typedef unsigned u32x2 __attribute__((ext_vector_type(2)));
typedef GAS unsigned gu32;

constexpr int NB = 16, SEQ = 2048, NCTX = 256, DM = 1024, DB = 512, DEPTH = 2;
constexpr int T_LAT = NB * SEQ, T_CTX = NB * NCTX, T_ALL = T_LAT + T_CTX;
constexpr int INC = 7168, NE = 32, TOPK = 4, DFF = 1024, CONVK = 31;
constexpr int KEYS = NCTX + SEQ;
constexpr int C_DQ = 1024, C_DK = 1536, C_DV = 2048, C_NQ = 2560, C_NK = 3072, C_NV = 3584, C_G = 4096;
constexpr float LN_EPS = 1e-6f, ALPHA = 1.4142135623730951f, LOG2E = 1.4426950408889634f;
constexpr float QSCALE = 0.125f * LOG2E;
constexpr int LIST_CAP = T_ALL;

constexpr size_t MiB = 1u << 20;
constexpr size_t WS_CTL = 0, CTL_ZERO_BYTES = 1 * MiB;
constexpr size_t WS_MOD = 1 * MiB;
constexpr size_t WS_ROPE = 3 * MiB;
constexpr size_t WS_LIST = 4 * MiB;
constexpr size_t WS_WIN = 16 * MiB;
constexpr size_t WS_WBR = WS_WIN + 28 * MiB;
constexpr size_t WS_WOUT = WS_WBR + 6 * MiB;
constexpr size_t WS_W1 = WS_WOUT + 4 * MiB;
constexpr size_t WS_W2 = WS_W1 + 128 * MiB;
constexpr size_t WS_WIN8 = WS_W2 + 64 * MiB;
constexpr size_t WS_H8 = WS_WIN8 + 8 * MiB;
constexpr size_t WS_H = WS_H8 + 36 * MiB;
constexpr size_t WS_X = WS_H + 72 * MiB;
constexpr size_t WS_U = WS_X + 144 * MiB;
constexpr size_t WS_MV = WS_U;
constexpr size_t WS_YA = WS_U + 504 * MiB;
constexpr size_t WS_YB = WS_YA + 36 * MiB;
constexpr size_t WS_YC = WS_YB + 36 * MiB;
constexpr size_t WS_MB = WS_YC + 36 * MiB;
constexpr size_t WS_Z = WS_MB;
constexpr size_t WS_YK = WS_YA;
constexpr size_t WS_VTD = WS_Z + 216 * MiB;
constexpr size_t WS_VTN = WS_VTD + 36 * MiB;
constexpr size_t WS_END = WS_VTN + 36 * MiB;
static_assert(WS_END <= 2048 * MiB, "workspace map");
constexpr int MAX_TILES = 608;

constexpr int CW_TMO = 0, CW_CODE = 1;
constexpr int CW_BAR = 4096;
constexpr int CW_ECNT = 16384;

constexpr int RING_BYTES = 131072;
constexpr int IDX_OFF = RING_BYTES;
constexpr int TILE_OFF = IDX_OFF + 24 * 512;
constexpr int MISC_OFF = TILE_OFF + 24 * 32;
constexpr int LDS_BYTES = 147456;
static_assert(MISC_OFF + 2048 <= LDS_BYTES, "LDS map");
constexpr int NWAVES = 8, NTHR = 512;

__device__ __forceinline__ unsigned f2bf(float f) { unsigned u = __builtin_bit_cast(unsigned, f); return (u + 0x7fffu + ((u >> 16) & 1u)) >> 16; }
typedef __bf16 bf16x2_t __attribute__((ext_vector_type(2)));
__device__ __forceinline__ unsigned pk2(float lo, float hi) { const f32x2 v = {lo, hi}; const bf16x2_t b = __builtin_convertvector(v, bf16x2_t); return __builtin_bit_cast(unsigned, b); }
__device__ __forceinline__ float bf2f(unsigned short b) { return __builtin_bit_cast(float, (unsigned)b << 16); }
__device__ __forceinline__ float bflo(unsigned w) { return __builtin_bit_cast(float, w << 16); }
__device__ __forceinline__ float bfhi(unsigned w) { return __builtin_bit_cast(float, w & 0xffff0000u); }
__device__ __forceinline__ float fsigmoid(float x) { return __builtin_amdgcn_rcpf(1.0f + __builtin_amdgcn_exp2f(-x * LOG2E)); }
__device__ __forceinline__ int lane_now() { int l; asm volatile("v_mbcnt_lo_u32_b32 %0, -1, 0\n\tv_mbcnt_hi_u32_b32 %0, -1, %0" : "=v"(l)); return l; }
__device__ __forceinline__ float sx(float v, int m) { return __builtin_bit_cast(float, __builtin_amdgcn_ds_bpermute((lane_now() ^ m) << 2, __builtin_bit_cast(int, v))); }
__device__ __forceinline__ void swap32(unsigned& x, unsigned& y) { const auto r = __builtin_amdgcn_permlane32_swap(x, y, false, false); x = r[0]; y = r[1]; }
template <int CTRL> __device__ __forceinline__ float dppx(float v) { return __builtin_bit_cast(float, __builtin_amdgcn_update_dpp(0, __builtin_bit_cast(int, v), CTRL, 0xF, 0xF, false)); }
template <int CTRL> __device__ __forceinline__ int dppxi(int v) { return __builtin_amdgcn_update_dpp(0, v, CTRL, 0xF, 0xF, false); }
__device__ __forceinline__ float wave_sum(float v) {
    v += dppx<0xB1>(v); v += dppx<0x4E>(v); v += dppx<0x141>(v); v += dppx<0x140>(v);
    { const unsigned b = __builtin_bit_cast(unsigned, v); const auto r = __builtin_amdgcn_permlane16_swap(b, b, false, false); v = __builtin_bit_cast(float, (unsigned)r[0]) + __builtin_bit_cast(float, (unsigned)r[1]); }
    { const unsigned b = __builtin_bit_cast(unsigned, v); const auto r = __builtin_amdgcn_permlane32_swap(b, b, false, false); v = __builtin_bit_cast(float, (unsigned)r[0]) + __builtin_bit_cast(float, (unsigned)r[1]); }
    return v;
}
#define LDS_WAIT() asm volatile("s_waitcnt lgkmcnt(0)" ::: "memory")
#define VM_WAIT() asm volatile("s_waitcnt vmcnt(0)" ::: "memory")
#define RLX_AGENT __ATOMIC_RELAXED, __HIP_MEMORY_SCOPE_AGENT

#define XB_TMO      128
#define XB_XCNT(j)  (256  + 64 * (j))
#define XB_XSUB(j)  (1280 + 64 * (j))
#define XB_XGEN(j)  (2304 + 64 * (j))
#define XB_TOP      3328
#define XB_TOPGEN   3392
#define XCD_BAR_WORDS 3456
#define XB_SPIN_CAP (1u << 22)
__device__ __forceinline__ unsigned xb_ld(unsigned* p)              { return __hip_atomic_load(p, __ATOMIC_RELAXED, __HIP_MEMORY_SCOPE_AGENT); }
__device__ __forceinline__ unsigned xb_add(unsigned* p, unsigned v) { return __hip_atomic_fetch_add(p, v, __ATOMIC_RELAXED, __HIP_MEMORY_SCOPE_AGENT); }
__device__ __forceinline__ unsigned xb_xcc_id() { return (unsigned)__builtin_amdgcn_s_getreg((3 << 11) | 20) & 0xFu; }
#define XB_SPIN(cond, bar) do { unsigned _sp = 0; while (cond) { __builtin_amdgcn_s_sleep(1); \
    if ((++_sp & 255u) == 0u) { if (xb_ld(&(bar)[XB_TMO])) break; if (_sp > XB_SPIN_CAP) { atomicAdd(&(bar)[XB_TMO], 1u); break; } } } } while (0)
struct XcdBarrier { unsigned* bar; unsigned x; volatile LAS unsigned* st; int w0; };
__device__ __forceinline__ XcdBarrier xcd_barrier_post(unsigned* bar, volatile LAS unsigned* st) {
    XcdBarrier b; b.bar = bar; b.x = xb_xcc_id(); b.st = st;
    if (threadIdx.x == 0) (void)xb_add(&bar[XB_XCNT(b.x)], 1u);
    return b;
}
__device__ __forceinline__ void xcd_barrier_complete(unsigned* bar, unsigned x, unsigned& nloc, unsigned& nx) {
    const unsigned G = gridDim.x * gridDim.y * gridDim.z;
    unsigned sum, cnt, mine, sp = 0u;
    for (;;) {
        sum = 0u; cnt = 0u; mine = 0u;
#pragma unroll
        for (unsigned j = 0; j < 16; ++j) { const unsigned c = xb_ld(&bar[XB_XCNT(j)]); sum += c; cnt += (c > 0u) ? 1u : 0u; mine = (j == x) ? c : mine; }
        if (sum == G) break;
        __builtin_amdgcn_s_sleep(1);
        if ((++sp & 255u) == 0u) { if (xb_ld(&bar[XB_TMO])) break; if (sp > XB_SPIN_CAP) { atomicAdd(&bar[XB_TMO], 1u); break; } }
    }
    nloc = mine > 0u ? mine : 1u; nx = cnt > 0u ? cnt : 1u;
}
__device__ __forceinline__ void xcd_barrier(const XcdBarrier& b) {
    asm volatile("s_waitcnt vmcnt(0)" ::: "memory");
    __syncthreads();
    if (b.w0 == 0 && lane_now() == 0) {
        unsigned* bar = b.bar;
        __builtin_amdgcn_s_waitcnt(0);
        unsigned nloc = b.st[0], nx = b.st[1];
        if (nloc == 0u) { xcd_barrier_complete(bar, b.x, nloc, nx); b.st[0] = nloc; b.st[1] = nx; }
        const unsigned old = xb_add(&bar[XB_XSUB(b.x)], 1u);
        const unsigned gen = old / nloc;
        if (old + 1u == (gen + 1u) * nloc) {
            __builtin_amdgcn_fence(__ATOMIC_RELEASE, "agent");
            asm volatile("s_waitcnt vmcnt(0)" ::: "memory");
            const unsigned og = xb_add(&bar[XB_TOP], 1u);
            const unsigned tg = og / nx;
            if (og + 1u == (tg + 1u) * nx) xb_add(&bar[XB_TOPGEN], 1u);
            else XB_SPIN(xb_ld(&bar[XB_TOPGEN]) == tg, bar);
            __builtin_amdgcn_fence(__ATOMIC_ACQUIRE, "agent");
            xb_add(&bar[XB_XGEN(b.x)], 1u);
            asm volatile("s_waitcnt vmcnt(0)" ::: "memory");
        } else {
            XB_SPIN(xb_ld(&bar[XB_XGEN(b.x)]) == gen, bar);
            __builtin_amdgcn_fence(__ATOMIC_ACQUIRE, "agent");
            asm volatile("s_waitcnt vmcnt(0)" ::: "memory");
        }
    }
    __syncthreads();
}

namespace pg8 {
typedef int v8i_t __attribute__((ext_vector_type(8)));
typedef int v4i_t __attribute__((ext_vector_type(4)));
constexpr int BM = 256, BK = 64, HALF = 128, HTB = HALF * BK * 2, STAGE_BYTES = 8 * HTB, NXCD = 8, WGM = 8;
__host__ __device__ __forceinline__ int lds_byte(int r, int c) { const int st = (r >> 4) * 2 + (c >> 5), rr = r & 15, cc = c & 31, ob = rr * 64 + cc * 2; return st * 1024 + (ob ^ (((ob >> 9) & 1) << 5)); }
__host__ __device__ __forceinline__ void stage_rc(int b, int& R, int& C) { const int st = b / 1024, sb = b % 1024, swz = sb ^ (((sb >> 9) & 1) << 5); R = (st >> 1) * 16 + swz / 64; C = (st & 1) * 32 + (swz % 64) / 2; }
__host__ __device__ __forceinline__ int perm32(int rho) { const int n = rho >> 4, i = rho & 15; return 8 * (i >> 2) + 4 * n + (i & 3); }

struct Unit { const char* pa; const char* pb; int pm, pn, e, nrows, ti, slot; };

struct StaticOrder {
    static constexpr bool GATHER = false;
    const char* A; const char* Bt; int lda, K; int nM, nN, nwg, G, c;
    __device__ __forceinline__ void init(const bf16* A_, int lda_, const bf16* Bt_, int K_, int M, int N, int G_, int c_) { A = (const char*)A_; Bt = (const char*)Bt_; lda = lda_ * 2; K = K_ * 2; nM = M / BM; nN = N / BM; nwg = nM * nN; G = G_; c = c_; }
    __device__ __forceinline__ void init_bytes(const void* A_, int ldab, const void* Bt_, int Kb, int M, int N, int G_, int c_) { A = (const char*)A_; Bt = (const char*)Bt_; lda = ldab; K = Kb; nM = M / BM; nN = N / BM; nwg = nM * nN; G = G_; c = c_; }
    __device__ __forceinline__ bool next(int i, Unit& u) const {
        const long L = (long)i * G + c; if (L >= nwg) return false;
        int wgid = (int)L; { const int q = nwg / NXCD, r = nwg % NXCD, xcd = wgid % NXCD, off = wgid / NXCD; wgid = (xcd < r ? xcd * (q + 1) : r * (q + 1) + (xcd - r) * q) + off; }
        const int nig = WGM * nN, gid = wgid / nig, fm = gid * WGM, gsz = (nM - fm) < WGM ? (nM - fm) : WGM;
        u.pm = fm + ((wgid % nig) % gsz); u.pn = (wgid % nig) / gsz; u.e = 0; u.nrows = 256; u.ti = u.pm; u.slot = 0;
        u.pa = A + (size_t)u.pm * BM * lda; u.pb = Bt + (size_t)u.pn * BM * K; return true;
    }
    __device__ __forceinline__ unsigned arow(const Unit&, int R) const { return (unsigned)R; }
};

template <class Epi, class Sched, bool FP8 = false>
__device__ __forceinline__ void gemm_phase(LAS unsigned char* lds, const int wid, const int Kb, const int ldab, const Sched& S, const Epi& E) {
    const int lane = lane_now(), tid = (wid << 6) | lane, wr = wid >> 2, wc = wid & 3, fr = lane & 15, fq = lane >> 4;
    int sc7f = 0x7f7f7f7f; if (FP8) asm volatile("" : "+v"(sc7f));
    int nt = Kb / 128; asm volatile("" : "+s"(nt));
    unsigned voffB[1]; const size_t row64B = (size_t)64 * Kb;
    { int R0, C0; stage_rc(tid * 16, R0, C0); const int Rb = Epi::PERM ? ((R0 & ~31) + perm32(R0 & 31)) : R0; voffB[0] = (unsigned)(Rb * Kb + C0 * 2); }
    const size_t kstep = (size_t)(BK * 2);
    const size_t hstepB = (size_t)HALF * Kb;
    const unsigned ldsw = (unsigned)wid * 1024u;
    const int aoff = lds_byte(wr * 64 + fr, fq * 8), boff = lds_byte(wc * 32 + fr, fq * 8);
#define PG8_SA(b, h) (((b) * 2 + (h)) * HTB)
#define PG8_SB(b, h) ((4 + (b) * 2 + (h)) * HTB)
#define PG8_STAGE(bufoff, gbase, v0, v1) do { const char* gb_ = (const char*)(gbase); const unsigned l0_ = (unsigned)(unsigned long)lds + (unsigned)(bufoff) + ldsw, l1_ = l0_ + 8192u; unsigned keep_; \
        asm volatile("s_mov_b32 %0, m0\n\ts_mov_b32 m0, %4\n\ts_nop 0\n\tglobal_load_lds_dwordx4 %1, %3\n\ts_mov_b32 m0, %5\n\ts_nop 0\n\tglobal_load_lds_dwordx4 %2, %3\n\ts_mov_b32 m0, %0" \
                     : "=&s"(keep_) : "v"(v0), "v"(v1), "s"(gb_), "s"(l0_), "s"(l1_) : "memory"); } while (0)
#define PG8_STB(bufoff, gbase) do { const char* gb_ = (const char*)(gbase); const char* gc_ = gb_ + row64B; const unsigned l0_ = (unsigned)(unsigned long)lds + (unsigned)(bufoff) + ldsw, l1_ = l0_ + 8192u; unsigned keep_; \
        asm volatile("s_mov_b32 %0, m0\n\ts_mov_b32 m0, %4\n\ts_nop 0\n\tglobal_load_lds_dwordx4 %1, %2\n\ts_mov_b32 m0, %5\n\ts_nop 0\n\tglobal_load_lds_dwordx4 %1, %3\n\ts_mov_b32 m0, %0" \
                     : "=&s"(keep_) : "v"(voffB[0]), "s"(gb_), "s"(gc_), "s"(l0_), "s"(l1_) : "memory"); } while (0)
#define PG8_LDA(dst, b, h) do { if constexpr (FP8) { _Pragma("unroll") for (int m = 0; m < 4; ++m) { const v4i_t lo_ = *(const LAS v4i_t*)(lds + PG8_SA(b, h) + aoff + m * 2048), hi_ = *(const LAS v4i_t*)(lds + PG8_SA(b, h) + aoff + m * 2048 + 1024); dst##8[m] = __builtin_shufflevector(lo_, hi_, 0, 1, 2, 3, 4, 5, 6, 7); } } \
        else { _Pragma("unroll") for (int m = 0; m < 4; ++m) _Pragma("unroll") for (int k = 0; k < 2; ++k) dst[m][k] = *(const LAS bf16x8*)(lds + PG8_SA(b, h) + aoff + m * 2048 + k * 1024); } } while (0)
#define PG8_LDB(dst, b, h) do { if constexpr (FP8) { _Pragma("unroll") for (int n = 0; n < 2; ++n) { const v4i_t lo_ = *(const LAS v4i_t*)(lds + PG8_SB(b, h) + boff + n * 2048), hi_ = *(const LAS v4i_t*)(lds + PG8_SB(b, h) + boff + n * 2048 + 1024); dst##8[n] = __builtin_shufflevector(lo_, hi_, 0, 1, 2, 3, 4, 5, 6, 7); } } \
        else { _Pragma("unroll") for (int n = 0; n < 2; ++n) _Pragma("unroll") for (int k = 0; k < 2; ++k) dst[n][k] = *(const LAS bf16x8*)(lds + PG8_SB(b, h) + boff + n * 2048 + k * 1024); } } while (0)
#define PG8_MMA(ai, bj, At, Bt) do { __builtin_amdgcn_s_setprio(1); if constexpr (FP8) { _Pragma("unroll") for (int m = 0; m < 4; ++m) _Pragma("unroll") for (int n = 0; n < 2; ++n) \
        acc[ai][bj][m][n] = __builtin_amdgcn_mfma_scale_f32_16x16x128_f8f6f4(Bt##8[n], At##8[m], acc[ai][bj][m][n], 0, 0, 0, sc7f, 0, sc7f); } else { \
        _Pragma("unroll") for (int m = 0; m < 4; ++m) _Pragma("unroll") for (int n = 0; n < 2; ++n) _Pragma("unroll") for (int k = 0; k < 2; ++k) \
        acc[ai][bj][m][n] = __builtin_amdgcn_mfma_f32_16x16x32_bf16(Bt[n][k], At[m][k], acc[ai][bj][m][n], 0, 0, 0); } __builtin_amdgcn_s_setprio(0); } while (0)
#define PG8_WAIT_V(n) asm volatile("s_waitcnt vmcnt(" #n ")" ::: "memory")
#define PG8_WAIT_L(n) asm volatile("s_waitcnt lgkmcnt(" #n ")" ::: "memory")
#define PG8_BAR __builtin_amdgcn_s_barrier()
#define PG8_SCHED __builtin_amdgcn_sched_barrier(0)
#define PG8_VOFF(dst, u) do { const int t2_ = Sched::GATHER ? ((wid << 6) | lane_now()) : tid; _Pragma("unroll") for (int i = 0; i < 2; ++i) { int R_, C_; stage_rc(t2_ * 16 + i * 8192, R_, C_); \
        _Pragma("unroll") for (int h = 0; h < 2; ++h) dst[h][i] = (unsigned)(S.arow(u, h * HALF + R_) * (unsigned)ldab + (unsigned)C_ * 2u); } } while (0)
    Unit cur, nxt; int ui = 0;
    if (!S.next(0, cur)) return;
    f32x4 acc[2][2][4][2];
#pragma unroll
    for (int a = 0; a < 2; ++a)
#pragma unroll
        for (int b = 0; b < 2; ++b)
#pragma unroll
            for (int m = 0; m < 4; ++m)
#pragma unroll
                for (int n = 0; n < 2; ++n) acc[a][b][m][n] = (f32x4){0.f, 0.f, 0.f, 0.f};
    bf16x8 At[4][2], B0[2][2], B1[2][2]; v8i_t At8[4], B08[2], B18[2];
    unsigned vc[2][2];
    PG8_VOFF(vc, cur);
    const char* cA = cur.pa; const char* cB = cur.pb;
    PG8_STB(PG8_SB(0, 0), cB); PG8_STB(PG8_SB(0, 1), cB + hstepB); PG8_STAGE(PG8_SA(0, 0), cA, vc[0][0], vc[0][1]); PG8_STAGE(PG8_SA(0, 1), cA, vc[1][0], vc[1][1]);
    if (wr == 1) PG8_BAR;
    PG8_WAIT_V(2); PG8_BAR;
    PG8_STB(PG8_SB(1, 0), cB + kstep); PG8_STAGE(PG8_SA(1, 0), cA + kstep, vc[0][0], vc[0][1]); PG8_STB(PG8_SB(1, 1), cB + hstepB + kstep);
    PG8_WAIT_V(6); PG8_BAR;
    for (;;) {
        const bool has_next = S.next(ui + 1, nxt);
        const char* nA = has_next ? nxt.pa : cA; const char* nB = has_next ? nxt.pb : cB;
#pragma nounroll
        for (int t = 0; t < nt; t += 2) {
            const bool last = (t == nt - 2);
            const char* a1 = cA + (size_t)(t + 1) * kstep;
            const char* a2 = last ? nA : cA + (size_t)(t + 2) * kstep; const char* b2 = last ? nB : cB + (size_t)(t + 2) * kstep;
            const char* a3 = a2 + kstep; const char* b3 = b2 + kstep;
            unsigned v2_00 = vc[0][0], v2_01 = vc[0][1], v2_10 = vc[1][0], v2_11 = vc[1][1];
            if (Sched::GATHER && last && has_next) { unsigned vn[2][2]; PG8_VOFF(vn, nxt); v2_00 = vn[0][0]; v2_01 = vn[0][1]; v2_10 = vn[1][0]; v2_11 = vn[1][1]; }
            PG8_LDB(B0, 0, 0); PG8_LDB(B1, 0, 1); PG8_SCHED; PG8_LDA(At, 0, 0); PG8_STAGE(PG8_SA(1, 1), a1, vc[1][0], vc[1][1]);
            PG8_WAIT_V(8); PG8_WAIT_L(0); PG8_BAR; PG8_MMA(0, 0, At, B0); PG8_MMA(0, 1, At, B1); PG8_BAR; PG8_SCHED;
            PG8_LDA(At, 0, 1); PG8_STB(PG8_SB(0, 0), b2); PG8_STB(PG8_SB(0, 1), b2 + hstepB); PG8_STAGE(PG8_SA(0, 0), a2, v2_00, v2_01);
            PG8_WAIT_V(8); PG8_WAIT_L(0); PG8_BAR; PG8_MMA(1, 0, At, B0); PG8_MMA(1, 1, At, B1); PG8_BAR; PG8_SCHED;
            PG8_LDB(B0, 1, 0); PG8_LDB(B1, 1, 1); PG8_SCHED; PG8_LDA(At, 1, 0); PG8_STAGE(PG8_SA(0, 1), a2, v2_10, v2_11);
            PG8_WAIT_V(8); PG8_WAIT_L(0); PG8_BAR; PG8_MMA(0, 0, At, B0); PG8_MMA(0, 1, At, B1); PG8_BAR; PG8_SCHED;
            PG8_LDA(At, 1, 1); PG8_STB(PG8_SB(1, 0), b3); PG8_STB(PG8_SB(1, 1), b3 + hstepB); PG8_STAGE(PG8_SA(1, 0), a3, v2_00, v2_01);
            PG8_WAIT_V(8); PG8_WAIT_L(0); PG8_BAR; PG8_MMA(1, 0, At, B0); PG8_MMA(1, 1, At, B1); PG8_BAR; PG8_SCHED;
        }
        if (wr == 0) PG8_BAR;
        { const int l_ = lane_now(); E(acc, cur, wr, wc, l_ & 15, l_ >> 4); }
        if (!has_next) break;
        if (!E.carry(cur)) {
#pragma unroll
        for (int a = 0; a < 2; ++a)
#pragma unroll
            for (int b = 0; b < 2; ++b)
#pragma unroll
                for (int m = 0; m < 4; ++m)
#pragma unroll
                    for (int n = 0; n < 2; ++n) acc[a][b][m][n] = (f32x4){0.f, 0.f, 0.f, 0.f};
        }
        cur = nxt; cA = nA; cB = nB; ++ui;
        if (Sched::GATHER) { PG8_VOFF(vc, cur); }
        if (wr == 1) PG8_BAR;
    }
    PG8_WAIT_V(0);
    PG8_BAR;
#undef PG8_SA
#undef PG8_SB
#undef PG8_STAGE
#undef PG8_STB
#undef PG8_LDA
#undef PG8_LDB
#undef PG8_MMA
#undef PG8_WAIT_V
#undef PG8_WAIT_L
#undef PG8_BAR
#undef PG8_SCHED
#undef PG8_VOFF
}
}

struct Frame {
    LAS unsigned char* lds;
    volatile LAS unsigned* MISC;
    gu32* ctl;
    int tid, lane, wave, G, bid, wave0;
    const float* const* in;
    GAS float* out; GAS unsigned char* ws;
};

constexpr int MI_BAR = 8;
constexpr int MI_NUNITS = 16;
constexpr int MI_NREC = 17;
constexpr int MI_LCNT = 32;
constexpr int MI_LBASE = 64;

constexpr float W8_SCALE = 64.0f, W8_INV = 1.0f / 64.0f;
__device__ __forceinline__ u32x2 pack8_f8(const float (&x)[8]) { u32x2 w; int a = 0, b = 0; a = __builtin_amdgcn_cvt_pk_fp8_f32(x[0], x[1], a, false); a = __builtin_amdgcn_cvt_pk_fp8_f32(x[2], x[3], a, true); b = __builtin_amdgcn_cvt_pk_fp8_f32(x[4], x[5], b, false); b = __builtin_amdgcn_cvt_pk_fp8_f32(x[6], x[7], b, true); w.x = (unsigned)a; w.y = (unsigned)b; return w; }
__device__ __forceinline__ u32x4 pack8(const float (&x)[8]) { u32x4 w; w.x = pk2(x[0], x[1]); w.y = pk2(x[2], x[3]); w.z = pk2(x[4], x[5]); w.w = pk2(x[6], x[7]); return w; }
#define ACC8(x, A, ai, bj, m) do { const f32x4 _a = A[ai][bj][m][0], _b = A[ai][bj][m][1]; x[0] = _a[0]; x[1] = _a[1]; x[2] = _a[2]; x[3] = _a[3]; x[4] = _b[0]; x[5] = _b[1]; x[6] = _b[2]; x[7] = _b[3]; } while (0)

struct EpiWin {
    static constexpr bool PERM = true;
    __device__ __forceinline__ bool carry(const pg8::Unit&) const { return false; }
    GAS unsigned char* ws; float asc;
    __device__ __forceinline__ void operator()(const f32x4 (&acc)[2][2][4][2], const pg8::Unit& u, int wr, int wc, int fr, int fq) const {
        bf16* const U = (bf16*)(ws + WS_U); bf16* const VTD = (bf16*)(ws + WS_VTD); bf16* const VTN = (bf16*)(ws + WS_VTN); const f32x2* const rope = (const f32x2*)(ws + WS_ROPE);
        const int pn = u.pn; const int row0 = u.pm * 256 + wr * 64 + fr; const int cw = wc * 32 + 8 * fq;
        if (pn < 4) {
#pragma unroll
            for (int ai = 0; ai < 2; ++ai)
#pragma unroll
                for (int m = 0; m < 4; ++m) { const int row = row0 + ai * 128 + m * 16; float v[8], g[8]; ACC8(v, acc, ai, 0, m); ACC8(g, acc, ai, 1, m);
#pragma unroll
                    for (int j = 0; j < 8; ++j) v[j] = (v[j] * asc) * fsigmoid(g[j] * asc);
                    *(u32x4*)(U + (size_t)row * INC + 128 * pn + cw) = pack8(v); }
        } else if (pn < 8) {
            const bool latent = u.pm < 128; const float sc = ((pn < 6) ? QSCALE : 1.f) * asc;
#pragma unroll
            for (int ai = 0; ai < 2; ++ai)
#pragma unroll
                for (int m = 0; m < 4; ++m) { const int row = row0 + ai * 128 + m * 16; const int l = row & 2047; const int pos = (wc & 1) ? (l & 63) : (l >> 6);
#pragma unroll
                    for (int bj = 0; bj < 2; ++bj) { float x[8]; ACC8(x, acc, ai, bj, m);
                        if (latent) {
                            const f32x4* rp = (const f32x4*)(rope + pos * 16 + 8 * (fq & 1));
                            const f32x4 r0 = rp[0], r1 = rp[1], r2 = rp[2], r3 = rp[3];
                            const float cs[8] = {r0[0], r0[2], r1[0], r1[2], r2[0], r2[2], r3[0], r3[2]}, sn[8] = {r0[1], r0[3], r1[1], r1[3], r2[1], r2[3], r3[1], r3[3]};
#pragma unroll
                            for (int j = 0; j < 8; ++j) { const unsigned xb = __builtin_bit_cast(unsigned, x[j]); const auto sw = __builtin_amdgcn_permlane32_swap(xb, xb, false, false);
                                const float p = (fq < 2) ? -__builtin_bit_cast(float, (unsigned)sw[1]) : __builtin_bit_cast(float, (unsigned)sw[0]); x[j] = x[j] * cs[j] + p * sn[j]; }
                        }
#pragma unroll
                        for (int j = 0; j < 8; ++j) x[j] *= sc;
                        *(u32x4*)(U + (size_t)row * INC + 256 * pn + 128 * bj + cw) = pack8(x); } }
        } else if (pn == 8 || pn == 9 || pn == 14 || pn == 15) {
            const bool isd = pn < 10;
#pragma unroll
            for (int ai = 0; ai < 2; ++ai)
#pragma unroll
                for (int m = 0; m < 4; ++m) { const int row = row0 + ai * 128 + m * 16; int b, key;
                    if (row < T_LAT) { b = row >> 11; key = NCTX + (row & 2047); } else { const int rc = row - T_LAT; b = rc >> 8; key = rc & 255; }
#pragma unroll
                    for (int bj = 0; bj < 2; ++bj) { float x[8]; ACC8(x, acc, ai, bj, m);
                        bf16* dst;
                        if (isd) { const int head = (pn - 8) * 2 + bj; dst = VTD + ((size_t)((b * 4 + head) * 128 + cw)) * KEYS + key; }
                        else { const int head = (pn - 14) * 4 + bj * 2 + (wc >> 1); dst = VTN + ((size_t)((b * 8 + head) * 64 + (cw & 63))) * KEYS + key; }
#pragma unroll
                        for (int j = 0; j < 8; ++j) dst[(size_t)j * KEYS] = (bf16)f2bf(x[j] * asc); } }
        } else if (pn < 14 || DIAG_GATEPLAIN) {
            const float sc = ((pn < 12) ? QSCALE : 1.f) * asc;
#pragma unroll
            for (int ai = 0; ai < 2; ++ai)
#pragma unroll
                for (int m = 0; m < 4; ++m) { const int row = row0 + ai * 128 + m * 16;
#pragma unroll
                    for (int bj = 0; bj < 2; ++bj) { float x[8]; ACC8(x, acc, ai, bj, m);
#pragma unroll
                        for (int j = 0; j < 8; ++j) x[j] *= sc;
                        *(u32x4*)(U + (size_t)row * INC + 256 * pn + 128 * bj + cw) = pack8(x); } }
        } else {
#pragma unroll
            for (int ai = 0; ai < 2; ++ai)
#pragma unroll
                for (int m = 0; m < 4; ++m) { const int row = row0 + ai * 128 + m * 16;
#pragma unroll
                    for (int bj = 0; bj < 2; ++bj) { float x[8]; ACC8(x, acc, ai, bj, m);
#pragma unroll
                        for (int j = 0; j < 8; ++j) x[j] = fsigmoid(x[j] * asc);
                        *(u32x4*)(U + (size_t)row * INC + 256 * pn + 128 * bj + cw) = pack8(x); } }
        }
    }
};

struct EpiMB {
    static constexpr bool PERM = true;
    const bf16* U; bf16* MB;
    __device__ __forceinline__ bool carry(const pg8::Unit& u) const { return u.e < 2; }
    __device__ __forceinline__ void operator()(f32x4 (&acc)[2][2][4][2], const pg8::Unit& u, int wr, int wc, int fr, int fq) const {
        const int row0 = u.pm * 256 + wr * 64 + fr; const int cw = wc * 32 + 8 * fq; const int j = u.e;
#pragma unroll
        for (int ai = 0; ai < 2; ++ai) {
            u32x4 gw[4][2], gn[4][2];
#pragma unroll
            for (int m = 0; m < 4; ++m)
#pragma unroll
                for (int bj = 0; bj < 2; ++bj) { const int row = row0 + ai * 128 + m * 16, col = 256 * u.pn + 128 * bj + cw; const bf16* gp = U + (size_t)row * INC + C_G + 1024 * j + col;
                    gw[m][bj] = *(const u32x4*)gp; gn[m][bj] = (j < 2) ? *(const u32x4*)(gp + 1024) : (u32x4){0u, 0u, 0u, 0u}; }
#pragma unroll
            for (int m = 0; m < 4; ++m)
#pragma unroll
                for (int bj = 0; bj < 2; ++bj) { const int row = row0 + ai * 128 + m * 16, col = 256 * u.pn + 128 * bj + cw;
                    const u32x4 g4 = gw[m][bj], n4 = gn[m][bj];
                    float g[8] = {bflo(g4.x), bfhi(g4.x), bflo(g4.y), bfhi(g4.y), bflo(g4.z), bfhi(g4.z), bflo(g4.w), bfhi(g4.w)};
                    const float gx[8] = {bflo(n4.x), bfhi(n4.x), bflo(n4.y), bfhi(n4.y), bflo(n4.z), bfhi(n4.z), bflo(n4.w), bfhi(n4.w)};
                    if (j > 0) {
#pragma unroll
                        for (int q = 0; q < 8; ++q) g[q] = fmaxf(g[q], 1.0e-12f); }
                    float x[8]; ACC8(x, acc, ai, bj, m);
                    if (j < 2) {
#pragma unroll
                        for (int q = 0; q < 8; ++q) x[q] = (x[q] * g[q]) * __builtin_amdgcn_rcpf(fmaxf(gx[q], 1.0e-12f));
                        acc[ai][bj][m][0] = (f32x4){x[0], x[1], x[2], x[3]}; acc[ai][bj][m][1] = (f32x4){x[4], x[5], x[6], x[7]};
                    } else {
#pragma unroll
                        for (int q = 0; q < 8; ++q) x[q] *= g[q];
                        *(u32x4*)(MB + (size_t)row * DM + col) = pack8(x); } }
        }
    }
};
struct MergeOrder {
    static constexpr bool GATHER = false;
    const char* Y; const char* W; pg8::StaticOrder T;
    __device__ __forceinline__ bool next(int i, pg8::Unit& u) const {
        const int t = i / 3, j = i - 3 * t; if (!T.next(t, u)) return false;
        u.e = j; u.pa = Y + (size_t)j * (36 * MiB) + (size_t)u.pm * 256 * (DB * 2); u.pb = W + ((size_t)j * DM + (size_t)u.pn * 256) * (DB * 2); return true; }
    __device__ __forceinline__ unsigned arow(const pg8::Unit&, int R) const { return (unsigned)R; }
};

struct EpiWout {
    static constexpr bool PERM = true;
    __device__ __forceinline__ bool carry(const pg8::Unit&) const { return false; }
    const float* g1base; bf16* YG;
    __device__ __forceinline__ void operator()(const f32x4 (&acc)[2][2][4][2], const pg8::Unit& u, int wr, int wc, int fr, int fq) const {
        const int row0 = u.pm * 256 + wr * 64 + fr; const int cw = wc * 32 + 8 * fq;
        const bool latent = u.pm < 128; const int mi = latent ? (u.pm >> 3) : 16;
        const float* g1 = g1base + (size_t)mi * 6144;
        f32x4 gv[2][2];
#pragma unroll
        for (int bj = 0; bj < 2; ++bj) { const int col = 256 * u.pn + 128 * bj + cw; gv[bj][0] = *(const f32x4*)(g1 + col); gv[bj][1] = *(const f32x4*)(g1 + col + 4); }
#pragma unroll
        for (int ai = 0; ai < 2; ++ai)
#pragma unroll
            for (int m = 0; m < 4; ++m) { const int row = row0 + ai * 128 + m * 16;
#pragma unroll
                for (int bj = 0; bj < 2; ++bj) { const int col = 256 * u.pn + 128 * bj + cw; float x[8]; ACC8(x, acc, ai, bj, m);
#pragma unroll
                    for (int q = 0; q < 4; ++q) { x[q] *= gv[bj][0][q]; x[4 + q] *= gv[bj][1][q]; }
                    *(u32x4*)(YG + (size_t)row * DM + col) = pack8(x); } }
    }
};

struct EpiMoe1 {
    static constexpr bool PERM = true;
    __device__ __forceinline__ bool carry(const pg8::Unit&) const { return false; }
    unsigned char* ACT; const float* b1;
    __device__ __forceinline__ void operator()(const f32x4 (&acc)[2][2][4][2], const pg8::Unit& u, int wr, int wc, int fr, int fq) const {
        const int cw = wc * 32 + 8 * fq; const int col = 128 * u.pn + cw;
        const float* bg = b1 + (size_t)u.e * 2048 + col; const float* bl = bg + 1024;
        const f32x4 bga = *(const f32x4*)bg, bgb = *(const f32x4*)(bg + 4), bla = *(const f32x4*)bl, blb = *(const f32x4*)(bl + 4);
        const float bgv[8] = {bga[0], bga[1], bga[2], bga[3], bgb[0], bgb[1], bgb[2], bgb[3]}, blv[8] = {bla[0], bla[1], bla[2], bla[3], blb[0], blb[1], blb[2], blb[3]};
#pragma unroll
        for (int ai = 0; ai < 2; ++ai)
#pragma unroll
            for (int m = 0; m < 4; ++m) { const int R = ai * 128 + wr * 64 + m * 16 + fr; float g[8], l[8]; ACC8(g, acc, ai, 0, m); ACC8(l, acc, ai, 1, m);
#pragma unroll
                for (int j = 0; j < 8; ++j) { const float gl = fminf(g[j] * W8_INV + bgv[j], 7.0f); const float li = fminf(fmaxf(l[j] * W8_INV + blv[j], -7.0f), 7.0f); g[j] = gl * fsigmoid(1.702f * gl) * (li + 1.0f); }
                *(u32x2*)(ACT + ((size_t)u.ti * 256 + R) * DFF + col) = pack8_f8(g); }
    }
};

struct EpiMoe2 {
    static constexpr bool PERM = true;
    __device__ __forceinline__ bool carry(const pg8::Unit&) const { return false; }
    unsigned char* YK; const float* b2; const u32x2* LIST;
    __device__ __forceinline__ void operator()(const f32x4 (&acc)[2][2][4][2], const pg8::Unit& u, int wr, int wc, int fr, int fq) const {
        const int cw = wc * 32 + 8 * fq;
        const u32x2* lst = LIST + (size_t)u.e * LIST_CAP + u.pm * 256;
        u32x2 ent[2][4];
#pragma unroll
        for (int ai = 0; ai < 2; ++ai)
#pragma unroll
            for (int m = 0; m < 4; ++m) { const int R = ai * 128 + wr * 64 + m * 16 + fr; ent[ai][m] = lst[R < u.nrows ? R : u.nrows - 1]; }
        f32x4 bv[2][2];
#pragma unroll
        for (int bj = 0; bj < 2; ++bj) { const float* bb = b2 + (size_t)u.e * DM + 256 * u.pn + 128 * bj + cw; bv[bj][0] = *(const f32x4*)bb; bv[bj][1] = *(const f32x4*)(bb + 4); }
#pragma unroll
        for (int ai = 0; ai < 2; ++ai)
#pragma unroll
            for (int m = 0; m < 4; ++m) { const int R = ai * 128 + wr * 64 + m * 16 + fr;
                if (R < u.nrows) { const unsigned tokslot = ent[ai][m].x, wbits = ent[ai][m].y; const float w = __uint_as_float(wbits);
#pragma unroll
                    for (int bj = 0; bj < 2; ++bj) { const int col = 256 * u.pn + 128 * bj + cw; float x[8]; ACC8(x, acc, ai, bj, m);
#pragma unroll
                        for (int j = 0; j < 4; ++j) { x[j] = w * (x[j] * W8_INV + bv[bj][0][j]); x[4 + j] = w * (x[4 + j] * W8_INV + bv[bj][1][j]); }
                        *(u32x2*)(YK + (size_t)tokslot * DM + col) = pack8_f8(x); } } }
    }
};

__device__ __forceinline__ void moe_build_tiles(Frame& F, int layer, int NPN, bool gather) {
    LAS int* tile = (LAS int*)(F.lds + TILE_OFF); LAS unsigned short* idx = (LAS unsigned short*)(F.lds + IDX_OFF);
    if (F.tid == 0) F.MISC[MI_NUNITS] = 0u;
    if (F.tid < NE) F.MISC[MI_LCNT + F.tid] = __hip_atomic_load(F.ctl + CW_ECNT + (layer * 32 + F.tid) * 64, RLX_AGENT);
    __syncthreads();
    if (F.tid < 24) {
        const int gx = F.G >> 3, v = (F.bid >> 3) + gx * F.tid; const int ti = (F.bid & 7) + 8 * (v / NPN), pn = v % NPN;
        int accum = 0, fe = -1, fpm = 0, fn = 0;
        for (int e = 0; e < NE; ++e) { const int cnt = (int)F.MISC[MI_LCNT + e]; const int te = (cnt + 255) >> 8;
            if (fe < 0 && ti < accum + te) { fe = e; fpm = ti - accum; fn = cnt - 256 * fpm; if (fn > 256) fn = 256; } accum += te; }
        LAS int* t = tile + F.tid * 8; t[0] = fe < 0 ? 0 : fe; t[1] = fpm; t[2] = fn; t[3] = pn; t[4] = ti; t[5] = fe >= 0 ? 1 : 0;
        if (fe >= 0) __hip_atomic_fetch_add((LAS unsigned*)&F.MISC[MI_NUNITS], 1u, __ATOMIC_RELAXED, __HIP_MEMORY_SCOPE_WORKGROUP);
    }
    __syncthreads();
    if (gather) {
        const int nu = (int)F.MISC[MI_NUNITS];
        for (int k0 = 0; k0 < nu * 256; k0 += 12 * NTHR) {
            unsigned tk[12];
#pragma unroll
            for (int q = 0; q < 12; ++q) { const int k = k0 + q * NTHR + F.tid; tk[q] = 0u;
                if (k < nu * 256) { const int i = k >> 8, R = k & 255; const LAS int* t = tile + i * 8; const int n = t[2]; const int Rc = R < n ? R : n - 1; tk[q] = ((u32x2*)(F.ws + WS_LIST))[(size_t)t[0] * LIST_CAP + t[1] * 256 + Rc].x; } }
#pragma unroll
            for (int q = 0; q < 12; ++q) { const int k = k0 + q * NTHR + F.tid; if (k < nu * 256) idx[k] = (unsigned short)(tk[q] >> 2); }
        }
        __syncthreads();
    }
}
struct MoeSched1 {
    static constexpr bool GATHER = true;
    const char* A; const char* W; LAS const int* tile; LAS const unsigned short* idx; int nunits;
    __device__ __forceinline__ bool next(int i, pg8::Unit& u) const {
        if (i >= nunits) return false; const LAS int* t = tile + i * 8;
        u.e = __builtin_amdgcn_readfirstlane(t[0]); u.pm = __builtin_amdgcn_readfirstlane(t[1]); u.nrows = __builtin_amdgcn_readfirstlane(t[2]); u.pn = __builtin_amdgcn_readfirstlane(t[3]); u.ti = __builtin_amdgcn_readfirstlane(t[4]); u.slot = i;
        u.pa = A; u.pb = W + ((size_t)u.e * 2048 + (size_t)u.pn * 256) * DM; return true; }
    __device__ __forceinline__ unsigned arow(const pg8::Unit& u, int R) const { return (unsigned)idx[u.slot * 256 + R]; }
};
struct MoeSched2 {
    static constexpr bool GATHER = false;
    const char* A; const char* W; LAS const int* tile; int nunits;
    __device__ __forceinline__ bool next(int i, pg8::Unit& u) const {
        if (i >= nunits) return false; const LAS int* t = tile + i * 8;
        u.e = __builtin_amdgcn_readfirstlane(t[0]); u.pm = __builtin_amdgcn_readfirstlane(t[1]); u.nrows = __builtin_amdgcn_readfirstlane(t[2]); u.pn = __builtin_amdgcn_readfirstlane(t[3]); u.ti = __builtin_amdgcn_readfirstlane(t[4]); u.slot = i;
        u.pa = A + (size_t)u.ti * 256 * DFF; u.pb = W + ((size_t)u.e * 1024 + (size_t)u.pn * 256) * DFF; return true; }
    __device__ __forceinline__ unsigned arow(const pg8::Unit&, int R) const { return (unsigned)R; }
};

__device__ __forceinline__ void p0_transpose_item(const float* W, int K, int N, bf16* WT, int glu_half, LAS float* scr, int item, int lane, int ldt, int nrep) {
    const int nblk = N / 32, kb = item / nblk, nb = item % nblk, k0 = 64 * kb, n0 = 32 * nb;
    int d0 = n0;
    if (glu_half && n0 < 2 * glu_half) { const int part = n0 / glu_half, ix = n0 % glu_half; d0 = (ix >> 7) * 256 + part * 128 + (ix & 127); }
    { float wv_[32];
#pragma unroll
      for (int i = 0; i < 32; ++i) wv_[i] = W[(size_t)(k0 + 2 * i + (lane >> 5)) * N + n0 + (lane & 31)];
#pragma unroll
      for (int i = 0; i < 32; ++i) scr[(2 * i + (lane >> 5)) * 33 + (lane & 31)] = wv_[i]; }
    LDS_WAIT(); asm volatile("" ::: "memory");
    const int c = lane & 7;
#pragma unroll
    for (int j = 0; j < 4; ++j) { const int n = (lane >> 3) + 8 * j; const LAS float* s = scr + (8 * c) * 33 + n;
        u32x4 o; o.x = f2bf(s[0 * 33]) | (f2bf(s[1 * 33]) << 16); o.y = f2bf(s[2 * 33]) | (f2bf(s[3 * 33]) << 16); o.z = f2bf(s[4 * 33]) | (f2bf(s[5 * 33]) << 16); o.w = f2bf(s[6 * 33]) | (f2bf(s[7 * 33]) << 16);
        for (int rp = 0; rp < nrep; ++rp) *(u32x4*)(WT + (size_t)(d0 + n) * ldt + rp * K + k0 + 8 * c) = o; }
    LDS_WAIT(); asm volatile("" ::: "memory");
}
__device__ __forceinline__ void p0_transpose_item_f8(const float* W, int K, int N, unsigned char* WT, int glu_half, LAS float* scr, int item, int lane, int drow = 0) {
    const int nblk = N / 32, kb = item / nblk, nb = item % nblk, k0 = 64 * kb, n0 = 32 * nb;
    int d0 = n0;
    if (glu_half && n0 < 2 * glu_half) { const int part = n0 / glu_half, ix = n0 % glu_half; d0 = (ix >> 7) * 256 + part * 128 + (ix & 127); }
    { float wv_[32];
#pragma unroll
      for (int i = 0; i < 32; ++i) wv_[i] = W[(size_t)(k0 + 2 * i + (lane >> 5)) * N + n0 + (lane & 31)];
#pragma unroll
      for (int i = 0; i < 32; ++i) scr[(2 * i + (lane >> 5)) * 33 + (lane & 31)] = wv_[i]; }
    LDS_WAIT(); asm volatile("" ::: "memory");
    const int n = lane >> 1, kh = (lane & 1) * 32; const LAS float* sp = scr + kh * 33 + n;
    unsigned w[8];
#pragma unroll
    for (int q = 0; q < 8; ++q) { int a = 0; a = __builtin_amdgcn_cvt_pk_fp8_f32(sp[(4 * q) * 33] * W8_SCALE, sp[(4 * q + 1) * 33] * W8_SCALE, a, false); a = __builtin_amdgcn_cvt_pk_fp8_f32(sp[(4 * q + 2) * 33] * W8_SCALE, sp[(4 * q + 3) * 33] * W8_SCALE, a, true); w[q] = (unsigned)a; }
    unsigned char* dst = WT + (size_t)(d0 + drow + n) * K + k0 + kh;
    *(u32x4*)dst = (u32x4){w[0], w[1], w[2], w[3]}; *(u32x4*)(dst + 16) = (u32x4){w[4], w[5], w[6], w[7]};
    LDS_WAIT(); asm volatile("" ::: "memory");
}
constexpr int CV_WIN = 16 * 224, CV_WBR = 3 * 8 * 32, CV_WOUT = 16 * 32, CV_W1 = 32 * 16 * 64, CV_W2 = 32 * 16 * 32, CV_LAYER = CV_WIN + CV_WBR + CV_WOUT + CV_W1 + CV_W2;
constexpr int CV_SLOT_A = 34000, CV_SLOT_B = 14000, CV_P0_L1 = CV_LAYER - CV_SLOT_A - CV_SLOT_B;
__device__ __forceinline__ void convert_items(Frame& F, int it0, int it1, int first, int stride) {
    LAS float* scr = (LAS float*)(F.lds + F.wave * 16384);
    for (int it = it0 + first; it < it1; it += stride) {
        const int l = it / CV_LAYER; int r = it - l * CV_LAYER;
        if (r < CV_WIN) { p0_transpose_item_f8(F.in[6] + (size_t)l * DM * INC, DM, INC, (unsigned char*)(F.ws + WS_WIN) + (size_t)l * INC * DM, 512, scr, r, F.lane); continue; } r -= CV_WIN;
        if (r < CV_WBR) { const int m = l * 3 + r / 256; p0_transpose_item(F.in[17] + (size_t)m * DB * DM, DB, DM, ((bf16*)(F.ws + WS_WBR)) + (size_t)m * DM * DB, 0, scr, r % 256, F.lane, DB, 1); continue; } r -= CV_WBR;
        if (r < CV_WOUT) { p0_transpose_item(F.in[18] + (size_t)l * DM * DM, DM, DM, ((bf16*)(F.ws + WS_WOUT)) + (size_t)l * DM * DM, 0, scr, r, F.lane, DM, 1); continue; } r -= CV_WOUT;
        if (r < CV_W1) { const int m = l * 32 + r / 1024; p0_transpose_item_f8(F.in[23] + (size_t)m * DM * 2048, DM, 2048, (unsigned char*)(F.ws + WS_W1) + (size_t)m * 2048 * DM, 1024, scr, r % 1024, F.lane); continue; } r -= CV_W1;
        { const int m = l * 32 + r / 512; p0_transpose_item_f8(F.in[25] + (size_t)m * DFF * DM, DFF, DM, (unsigned char*)(F.ws + WS_W2) + (size_t)m * DM * DFF, 0, scr, r % 512, F.lane); }
    }
}
__device__ __forceinline__ float fsilu(float x) { return x * fsigmoid(x); }
__device__ __forceinline__ void p0_prologue(Frame& F) {
    if (F.bid < 192) {
        LAS float* s = (LAS float*)F.lds;
        LAS float* red = (LAS float*)(F.lds + 17 * 4096);
        for (int i = F.tid; i < 17 * 1024; i += NTHR) { const int mi = i >> 10, k = i & 1023; s[i] = fsilu(mi < 16 ? F.in[1][mi * 1024 + k] : F.in[3][k]); }
        __syncthreads();
        const int layer = F.bid / 96, cg = F.bid % 96;
        const float* W = F.in[4] + (size_t)layer * DM * 6144 + cg * 64 + F.lane;
        float acc[17];
#pragma unroll
        for (int b = 0; b < 17; ++b) acc[b] = 0.f;
#pragma unroll 4
        for (int k = F.wave * 128; k < F.wave * 128 + 128; k += 4) {
            const float w0 = W[(size_t)k * 6144], w1 = W[(size_t)(k + 1) * 6144], w2 = W[(size_t)(k + 2) * 6144], w3 = W[(size_t)(k + 3) * 6144];
#pragma unroll
            for (int b = 0; b < 17; ++b) { const f32x4 sv = *(const LAS f32x4*)(s + b * 1024 + k); acc[b] += sv[0] * w0 + sv[1] * w1 + sv[2] * w2 + sv[3] * w3; }
        }
#pragma unroll
        for (int b = 0; b < 17; ++b) red[(F.wave * 17 + b) * 64 + F.lane] = acc[b];
        __syncthreads();
        for (int i = F.tid; i < 17 * 64; i += NTHR) { const int b = i >> 6, cl = i & 63; float t = 0.f;
#pragma unroll
            for (int w = 0; w < 8; ++w) t += red[(w * 17 + b) * 64 + cl];
            ((float*)(F.ws + WS_MOD))[((size_t)layer * 17 + b) * 6144 + cg * 64 + cl] = t + F.in[5][layer * 6144 + cg * 64 + cl]; }
        __syncthreads();
    } else if (F.bid == 255) {
        for (int i = F.tid; i < 1024; i += NTHR) { const int pos = i >> 4, fi = i & 15;
            double invf = 1.0; for (int q = 0; q < fi; ++q) invf *= 0.5623413251903491;
            const float ang = (float)pos * (float)invf;
            double a = (double)ang; const double tw = 6.283185307179586476925; a -= tw * __builtin_rint(a / tw);
            const double a2 = a * a; double sn = a, cs = 1.0, ts = a, tc = 1.0;
            for (int q = 1; q < 14; ++q) { tc *= -a2 / (double)((2 * q - 1) * (2 * q)); ts *= -a2 / (double)((2 * q) * (2 * q + 1)); cs += tc; sn += ts; }
            ((f32x2*)(F.ws + WS_ROPE))[i] = (f32x2){(float)cs, (float)sn}; }
    }
    __syncthreads();
    convert_items(F, 0, F.G == 256 ? CV_LAYER + CV_P0_L1 : 2 * CV_LAYER, F.bid * NWAVES + F.wave, F.G * NWAVES);
}
__device__ __forceinline__ void row_load(const float* p, int lane, f32x4 (&v)[4]) {
#pragma unroll
    for (int j = 0; j < 4; ++j) v[j] = ((const f32x4*)p)[lane + 64 * j];
}
__device__ __forceinline__ void row_ln(f32x4 (&v)[4]) {
    float s = 0.f;
#pragma unroll
    for (int j = 0; j < 4; ++j) s += (v[j][0] + v[j][1]) + (v[j][2] + v[j][3]);
    const float mean = wave_sum(s) * (1.f / DM); float q = 0.f;
#pragma unroll
    for (int j = 0; j < 4; ++j) { v[j] = v[j] - mean; q += (v[j][0] * v[j][0] + v[j][1] * v[j][1]) + (v[j][2] * v[j][2] + v[j][3] * v[j][3]); }
    const float rstd = 1.0f / sqrtf(wave_sum(q) * (1.f / DM) + LN_EPS);
#pragma unroll
    for (int j = 0; j < 4; ++j) v[j] = v[j] * rstd;
}
__device__ __forceinline__ void row_affine(f32x4 (&v)[4], const float* g, const float* b, int lane, bool plus1) {
#pragma unroll
    for (int j = 0; j < 4; ++j) { f32x4 gv = ((const f32x4*)g)[lane + 64 * j]; const f32x4 bv = ((const f32x4*)b)[lane + 64 * j]; if (plus1) gv = gv + 1.0f; v[j] = v[j] * gv + bv; }
}
__device__ __forceinline__ void row_store_bf16(bf16* p, int lane, const f32x4 (&v)[4]) {
#pragma unroll
    for (int j = 0; j < 4; ++j) { u32x2 w; w.x = f2bf(v[j][0]) | (f2bf(v[j][1]) << 16); w.y = f2bf(v[j][2]) | (f2bf(v[j][3]) << 16); ((u32x2*)p)[lane + 64 * j] = w; }
}
__device__ __forceinline__ void row_store_f8(unsigned char* p, int lane, const f32x4 (&v)[4]) {
#pragma unroll
    for (int j = 0; j < 4; ++j) { int a = 0; a = __builtin_amdgcn_cvt_pk_fp8_f32(v[j][0], v[j][1], a, false); a = __builtin_amdgcn_cvt_pk_fp8_f32(v[j][2], v[j][3], a, true); ((unsigned*)p)[lane + 64 * j] = (unsigned)a; }
}
__device__ __forceinline__ void row_store_f32(float* p, int lane, const f32x4 (&v)[4]) {
#pragma unroll
    for (int j = 0; j < 4; ++j) ((f32x4*)p)[lane + 64 * j] = v[j];
}
__device__ __forceinline__ int row_mi(int row) { return row < T_LAT ? (row >> 11) : 16; }

__device__ __forceinline__ void p1_modulate0(Frame& F) {
    const int gw = F.bid * NWAVES + F.wave, NGW = F.G * NWAVES;
    for (int row = gw; row < T_ALL; row += NGW) {
        f32x4 v[4]; row_load(row < T_LAT ? F.in[0] + (size_t)row * DM : F.in[2] + (size_t)(row - T_LAT) * DM, F.lane, v);
        row_ln(v); const float* md = ((float*)(F.ws + WS_MOD)) + (size_t)row_mi(row) * 6144; row_affine(v, md + 1024, md, F.lane, true);
        row_store_f8((unsigned char*)(F.ws + WS_H8) + (size_t)row * DM, F.lane, v);
    }
}
__device__ __forceinline__ f32x4 bf4(u32x2 w) { return (f32x4){bflo(w.x), bfhi(w.x), bflo(w.y), bfhi(w.y)}; }
__device__ __forceinline__ void p8_final(Frame& F, int layer, int nrows) {
    const int gw = F.bid * NWAVES + F.wave, NGW = F.G * NWAVES;
    u32x2 xn[4]; unsigned yn[4][4];
#define P8_LOAD(r_) do { const int rl_ = (r_); _Pragma("unroll") for (int j_ = 0; j_ < 4; ++j_) xn[j_] = ((const u32x2*)(((bf16*)(F.ws + WS_X)) + (size_t)rl_ * DM))[F.lane + 64 * j_]; \
        _Pragma("unroll") for (int j_ = 0; j_ < 4; ++j_) _Pragma("unroll") for (int k_ = 0; k_ < 4; ++k_) yn[j_][k_] = ((const unsigned*)(F.ws + WS_YK + ((size_t)rl_ * 4 + k_) * DM))[F.lane + 64 * j_]; } while (0)
    if (gw < nrows) P8_LOAD(gw);
    for (int row = gw; row < nrows; row += NGW) {
        f32x4 v[4]; unsigned yc[4][4];
#pragma unroll
        for (int j = 0; j < 4; ++j) { v[j] = bf4(xn[j]);
#pragma unroll
            for (int k = 0; k < 4; ++k) yc[j][k] = yn[j][k]; }
        if (row + NGW < nrows) P8_LOAD(row + NGW);
        const float* md = ((float*)(F.ws + WS_MOD)) + ((size_t)layer * 17 + row_mi(row)) * 6144;
#pragma unroll
        for (int j = 0; j < 4; ++j) { f32x4 y = (f32x4){0.f, 0.f, 0.f, 0.f};
#pragma unroll
            for (int k = 0; k < 4; ++k) { const int w = (int)yc[j][k]; const f32x2 lo = __builtin_amdgcn_cvt_pk_f32_fp8(w, false), hi2 = __builtin_amdgcn_cvt_pk_f32_fp8(w, true); y[0] += lo[0]; y[1] += lo[1]; y[2] += hi2[0]; y[3] += hi2[1]; }
            const f32x4 g2 = ((const f32x4*)(md + 5120))[F.lane + 64 * j]; if (ABL & 1) y = y * 0.f; v[j] = v[j] * ALPHA + g2 * y; }
        row_ln(v); row_affine(v, F.in[27] + layer * DM, F.in[28] + layer * DM, F.lane, false);
        if (layer == DEPTH - 1) { row_store_f32((float*)(F.out + (size_t)row * DM), F.lane, v); }
        else { row_store_bf16(((bf16*)(F.ws + WS_X)) + (size_t)row * DM, F.lane, v); row_ln(v); const float* mn = ((float*)(F.ws + WS_MOD)) + ((size_t)(layer + 1) * 17 + row_mi(row)) * 6144; row_affine(v, mn + 1024, mn, F.lane, true); row_store_f8((unsigned char*)(F.ws + WS_H8) + (size_t)row * DM, F.lane, v); }
    }
#undef P8_LOAD
}

constexpr int TS_STRIDE = 1028;
constexpr int P5_TS = 0, P5_PART = 16 * TS_STRIDE * 4, P5_LOG = P5_PART + 8 * 16 * 32 * 4, P5_REC = P5_LOG + 16 * 32 * 4;
__device__ __forceinline__ void p5_ln1_router(Frame& F, int layer, int nrows) {
    LAS float* TS = (LAS float*)(F.lds + P5_TS); LAS float* PART = (LAS float*)(F.lds + P5_PART); LAS float* LOG = (LAS float*)(F.lds + P5_LOG); LAS u32x4* REC = (LAS u32x4*)(F.lds + P5_REC);
    if (F.tid < 32) F.MISC[MI_LCNT + F.tid] = 0u;
    if (F.tid == 0) F.MISC[MI_NREC] = 0u;
    __syncthreads();
    const float* wr_ = F.in[21] + (size_t)layer * DM * NE; const float* br_ = F.in[22] + layer * NE;
    const int ngroups = nrows / 16;
    float wb0[32], wb1[32];
    { const float* bp = wr_ + (size_t)(F.wave * 128 + (F.lane >> 4)) * NE + (F.lane & 15);
#pragma unroll
      for (int s = 0; s < 32; ++s) { wb0[s] = bp[(size_t)(4 * s) * NE]; wb1[s] = bp[(size_t)(4 * s) * NE + 16]; } }
    const float brv = br_[F.tid & 31];
    f32x4 vpre[2][4]; u32x2 ypre[2][4], xraw[2][4];
#define P5_BAR() asm volatile("s_waitcnt lgkmcnt(0)\n\ts_barrier" ::: "memory")
#define P5_LOAD(g_) do { _Pragma("unroll") for (int rr = 0; rr < 2; ++rr) { const int row_ = (g_) * 16 + F.wave * 2 + rr; \
            if (layer == 0) row_load(row_ < T_LAT ? F.in[0] + (size_t)row_ * DM : F.in[2] + (size_t)(row_ - T_LAT) * DM, F.lane, vpre[rr]); \
            else { _Pragma("unroll") for (int j = 0; j < 4; ++j) xraw[rr][j] = ((const u32x2*)(((bf16*)(F.ws + WS_X)) + (size_t)row_ * DM))[F.lane + 64 * j]; } \
            _Pragma("unroll") for (int j = 0; j < 4; ++j) ypre[rr][j] = ((const u32x2*)(((bf16*)(F.ws + WS_MV)) + (size_t)row_ * DM))[F.lane + 64 * j]; } } while (0)
    if (F.bid < ngroups) P5_LOAD(F.bid);
    for (int g = F.bid; g < ngroups; g += F.G) {
        f32x4 vcur[2][4];
#pragma unroll
        for (int rr = 0; rr < 2; ++rr)
#pragma unroll
            for (int j = 0; j < 4; ++j) { const f32x4 xin = layer == 0 ? vpre[rr][j] : bf4(xraw[rr][j]); vcur[rr][j] = xin * ALPHA + bf4(ypre[rr][j]); }
        if (g + F.G < ngroups) P5_LOAD(g + F.G);
#pragma unroll
        for (int rr = 0; rr < 2; ++rr) { const int rl = F.wave * 2 + rr; const int row = g * 16 + rl;
            f32x4 v[4];
#pragma unroll
            for (int j = 0; j < 4; ++j) v[j] = vcur[rr][j];
            row_ln(v); row_affine(v, F.in[19] + layer * DM, F.in[20] + layer * DM, F.lane, false);
            row_store_bf16(((bf16*)(F.ws + WS_X)) + (size_t)row * DM, F.lane, v);
            row_ln(v); const float* md = ((float*)(F.ws + WS_MOD)) + ((size_t)layer * 17 + row_mi(row)) * 6144; row_affine(v, md + 4096, md + 3072, F.lane, true);
#pragma unroll
            for (int j = 0; j < 4; ++j) { int a = 0; a = __builtin_amdgcn_cvt_pk_fp8_f32(v[j][0], v[j][1], a, false); a = __builtin_amdgcn_cvt_pk_fp8_f32(v[j][2], v[j][3], a, true); ((unsigned*)(F.ws + WS_H8 + (size_t)row * DM))[F.lane + 64 * j] = (unsigned)a; }
#pragma unroll
            for (int j = 0; j < 4; ++j) *(LAS f32x4*)(TS + rl * TS_STRIDE + 4 * (F.lane + 64 * j)) = v[j];
        }
        P5_BAR();
        { f32x4 a0 = (f32x4){0.f, 0.f, 0.f, 0.f}, a1 = a0; const int r16 = F.lane & 15, kq = F.lane >> 4;
            const LAS float* ap = TS + r16 * TS_STRIDE + F.wave * 128 + kq;
#pragma unroll
            for (int s = 0; s < 32; ++s) { const float a = ap[4 * s];
                a0 = __builtin_amdgcn_mfma_f32_16x16x4f32(a, wb0[s], a0, 0, 0, 0); a1 = __builtin_amdgcn_mfma_f32_16x16x4f32(a, wb1[s], a1, 0, 0, 0); }
#pragma unroll
            for (int i = 0; i < 4; ++i) { PART[(F.wave * 16 + 4 * kq + i) * 32 + r16] = a0[i]; PART[(F.wave * 16 + 4 * kq + i) * 32 + 16 + r16] = a1[i]; } }
        P5_BAR();
        { const int rl = F.tid >> 5, e = F.tid & 31; float t = brv;
#pragma unroll
            for (int w = 0; w < 8; ++w) t += PART[(w * 16 + rl) * 32 + e];
            float lv[4]; int li[4];
#pragma unroll
            for (int k = 0; k < 4; ++k) { float bv = t; int bi = e;
#define P5_STEP(C) { const float ov = dppx<C>(bv); const int oi = dppxi<C>(bi); const bool take = (ov > bv) || (ov == bv && oi < bi); bv = take ? ov : bv; bi = take ? oi : bi; }
                P5_STEP(0xB1) P5_STEP(0x4E) P5_STEP(0x141) P5_STEP(0x140)
#undef P5_STEP
                { const unsigned vb_ = __builtin_bit_cast(unsigned, bv); const auto rv = __builtin_amdgcn_permlane16_swap(vb_, vb_, false, false); const auto ri_ = __builtin_amdgcn_permlane16_swap((unsigned)bi, (unsigned)bi, false, false);
                  const float va = __builtin_bit_cast(float, (unsigned)rv[0]), vb2 = __builtin_bit_cast(float, (unsigned)rv[1]); const int ia = (int)ri_[0], ib = (int)ri_[1];
                  const bool take = (vb2 > va) || (vb2 == va && ib < ia); bv = take ? vb2 : va; bi = take ? ib : ia; }
                lv[k] = bv; li[k] = bi; if (e == bi) t = -INFINITY; }
            if (e < 4) { const int row = g * 16 + rl;
                const float e1 = __expf(lv[1] - lv[0]), e2 = __expf(lv[2] - lv[0]), e3 = __expf(lv[3] - lv[0]); const float inv = 1.0f / (1.0f + e1 + e2 + e3);
                const float wk = (e == 0 ? 1.0f : (e == 1 ? e1 : (e == 2 ? e2 : e3))) * inv; const int ek = e == 0 ? li[0] : (e == 1 ? li[1] : (e == 2 ? li[2] : li[3]));
                const unsigned p = __hip_atomic_fetch_add((LAS unsigned*)&F.MISC[MI_LCNT + ek], 1u, __ATOMIC_RELAXED, __HIP_MEMORY_SCOPE_WORKGROUP);
                const unsigned ri = __hip_atomic_fetch_add((LAS unsigned*)&F.MISC[MI_NREC], 1u, __ATOMIC_RELAXED, __HIP_MEMORY_SCOPE_WORKGROUP);
                REC[ri] = (u32x4){(unsigned)ek, p, (unsigned)(row * 4 + e), __builtin_bit_cast(unsigned, wk)}; } }
        P5_BAR();
    }
#undef P5_LOAD
#undef P5_BAR
    if (F.tid < 32) { const unsigned n = F.MISC[MI_LCNT + F.tid]; unsigned base = 0u; if (n) base = __hip_atomic_fetch_add(F.ctl + CW_ECNT + (layer * 32 + F.tid) * 64, n, RLX_AGENT); F.MISC[MI_LBASE + F.tid] = base; }
    __syncthreads();
    { const int nrec = (int)F.MISC[MI_NREC];
      for (int i = F.tid; i < nrec; i += NTHR) { const u32x4 r = REC[i]; ((u32x2*)(F.ws + WS_LIST))[(size_t)r.x * LIST_CAP + F.MISC[MI_LBASE + r.x] + r.y] = (u32x2){r.z, r.w}; } }
    __syncthreads();
}

constexpr int CV_T = 32, CV_ROWS = CV_T + 30, CV_GIN = 65536;
__device__ __forceinline__ void conv_units(Frame& F, int layer, int ntot) {
    LAS unsigned short* gin = (LAS unsigned short*)(F.lds + CV_GIN);
    LAS float* cout = (LAS float*)F.lds;
    const int c = F.tid;
    float w[CONVK];
#pragma unroll
    for (int j = 0; j < CONVK; ++j) w[j] = F.in[7][(size_t)layer * CONVK * DB + j * DB + c];
    f32x2 wp[CONVK + 1];
#pragma unroll
    for (int j = 0; j <= CONVK; ++j) wp[j] = (f32x2){j < CONVK ? w[j] : 0.f, j >= 1 ? w[j - 1] : 0.f};
    const float bias = F.in[8][layer * DB + c];
    const f32x4 g0 = ((const f32x4*)(F.in[9] + layer * DB))[F.lane], g1 = ((const f32x4*)(F.in[9] + layer * DB))[F.lane + 64];
    const f32x4 b0 = ((const f32x4*)(F.in[10] + layer * DB))[F.lane], b1 = ((const f32x4*)(F.in[10] + layer * DB))[F.lane + 64];
    u32x4 v[8];
#define CV_DECODE(u_, base_, len_, t0_) const int s_ = (u_) < 1024 ? ((u_) >> 6) : 16 + (((u_) - 1024) >> 3), tt_ = (u_) < 1024 ? ((u_) & 63) : (((u_) - 1024) & 7); \
        const int base_ = s_ < 16 ? s_ * SEQ : T_LAT + (s_ - 16) * NCTX, len_ = s_ < 16 ? SEQ : NCTX, t0_ = tt_ * CV_T
#define CV_LOAD(u_) do { CV_DECODE(u_, bs_, ln_, tz_); _Pragma("unroll") for (int i = 0; i < 8; ++i) { const int p = F.tid + NTHR * i; const int r = p >> 6, ch = p & 63; const int t = tz_ - 15 + r; \
          v[i] = (u32x4){0u, 0u, 0u, 0u}; if (p < CV_ROWS * 64 && t >= 0 && t < ln_) v[i] = *(const u32x4*)(((bf16*)(F.ws + WS_U)) + (size_t)(bs_ + t) * INC + ch * 8); } } while (0)
#define CV_BAR() asm volatile("s_waitcnt lgkmcnt(0)\n\ts_barrier" ::: "memory")
    if (F.bid < ntot) CV_LOAD(F.bid);
    __syncthreads();
    for (int u = F.bid; u < ntot; u += F.G) {
        CV_DECODE(u, base, len, t0); (void)len;
#pragma unroll
        for (int i = 0; i < 8; ++i) { const int p = F.tid + NTHR * i; if (p < CV_ROWS * 64) *(LAS u32x4*)(gin + (p >> 6) * 512 + (p & 63) * 8) = v[i]; }
        if (u + F.G < ntot) CV_LOAD(u + F.G);
        CV_BAR();
#pragma unroll 1
        for (int g = 0; g < CV_T / 16; ++g) {
            f32x2 a2[8];
#pragma unroll
            for (int m = 0; m < 8; ++m) a2[m] = (f32x2){bias, bias};
#pragma unroll
            for (int r = 0; r < 46; ++r) { const float x = bf2f(gin[(16 * g + r) * 512 + c]); const f32x2 xx = (f32x2){x, x};
#pragma unroll
                for (int m = 0; m < 8; ++m) { const int j = r - 2 * m; if (j >= 0 && j <= CONVK) a2[m] = __builtin_elementwise_fma(wp[j], xx, a2[m]); } }
#pragma unroll
            for (int m = 0; m < 8; ++m) { cout[(16 * g + 2 * m) * 512 + c] = a2[m][0]; cout[(16 * g + 2 * m + 1) * 512 + c] = a2[m][1]; }
        }
        CV_BAR();
#pragma unroll 2
        for (int k = 0; k < CV_T / 8; ++k) { const int tk = F.wave * (CV_T / 8) + k;
            f32x4 v0 = *(const LAS f32x4*)(cout + tk * 512 + 4 * F.lane), v1 = *(const LAS f32x4*)(cout + tk * 512 + 256 + 4 * F.lane);
            float sm = (v0[0] + v0[1]) + (v0[2] + v0[3]) + (v1[0] + v1[1]) + (v1[2] + v1[3]);
            const float mean = wave_sum(sm) * (1.f / DB); v0 = v0 - mean; v1 = v1 - mean;
            float q = (v0[0] * v0[0] + v0[1] * v0[1]) + (v0[2] * v0[2] + v0[3] * v0[3]) + (v1[0] * v1[0] + v1[1] * v1[1]) + (v1[2] * v1[2] + v1[3] * v1[3]);
            const float rstd = 1.0f / sqrtf(wave_sum(q) * (1.f / DB) + LN_EPS);
            v0 = v0 * rstd * g0 + b0; v1 = v1 * rstd * g1 + b1;
            u32x2 o0, o1; o0.x = f2bf(fsilu(v0[0])) | (f2bf(fsilu(v0[1])) << 16); o0.y = f2bf(fsilu(v0[2])) | (f2bf(fsilu(v0[3])) << 16);
            o1.x = f2bf(fsilu(v1[0])) | (f2bf(fsilu(v1[1])) << 16); o1.y = f2bf(fsilu(v1[2])) | (f2bf(fsilu(v1[3])) << 16);
            bf16* dst = ((bf16*)(F.ws + WS_YA)) + (size_t)(base + t0 + tk) * DB; ((u32x2*)dst)[F.lane] = o0; ((u32x2*)dst)[F.lane + 64] = o1; }
    }
#undef CV_DECODE
#undef CV_LOAD
#undef CV_BAR
}

constexpr int ATT_KROW = 144, ATT_VROW = 144;
constexpr int ATT_KB = 64 * ATT_KROW, ATT_VB = 128 * ATT_VROW, ATT_BUF = ATT_KB + ATT_VB;
constexpr int ATT_RPB = 2 * ATT_BUF;
__device__ __forceinline__ int crow(int r, int hi) { return (r & 3) + 8 * (r >> 2) + 4 * hi; }

template <int DV, bool NAT>
__device__ __forceinline__ void attn_pass(Frame& F, const bf16* VT  , int kcol, int nA, int rowA0, int keyA0, int nB, int rowB0, int keyB0,
                                          const bf16x8 (&qf)[4], f32x16 (&o)[DV / 32], float& m_run, float& l_run,
                                          int my_r, int kr0, int qc, int wrow0 = 0, int w0 = 0) {
    const int tid = F.tid, lane = F.lane, q32 = lane & 31, hi = lane >> 5;
    const int nT = nA + nB;
    const int krow = tid >> 3, kch = tid & 7;
    u32x4 kreg, vreg[DV / 64], kreg1, vreg1[DV / 64];
#define ATT_LOAD2(t, KR, VR) do { const int t_ = (t); const int r0_ = t_ < nA ? rowA0 + 64 * t_ : rowB0 + 64 * (t_ - nA); const int k0_ = t_ < nA ? keyA0 + 64 * t_ : keyB0 + 64 * (t_ - nA); \
        KR = *(const u32x4*)(((bf16*)(F.ws + WS_U)) + (size_t)(r0_ + krow) * INC + kcol + kch * 8); \
        _Pragma("unroll") for (int i_ = 0; i_ < DV / 64; ++i_) { const int p_ = tid + NTHR * i_; VR[i_] = *(const u32x4*)(VT + (size_t)(p_ >> 3) * KEYS + k0_ + (p_ & 7) * 8); } } while (0)
#define ATT_STORE2(b, KR, VR) do { LAS unsigned char* kb_ = F.lds + (b) * ATT_BUF; *(LAS u32x4*)(kb_ + krow * ATT_KROW + kch * 16) = KR; \
        _Pragma("unroll") for (int i_ = 0; i_ < DV / 64; ++i_) { const int p_ = tid + NTHR * i_; LAS unsigned char* d_ = kb_ + ATT_KB + (p_ >> 3) * ATT_VROW + (p_ & 7) * 16; \
            *(LAS u32x4*)d_ = VR[i_]; } } while (0)
#define ATT_LOAD(t) ATT_LOAD2(t, kreg, vreg)
#define ATT_STORE(b) ATT_STORE2(b, kreg, vreg)
#define ATT_LBAR() asm volatile("s_waitcnt lgkmcnt(0)\n\ts_barrier" ::: "memory")
    ATT_LBAR();
    ATT_LOAD(0); if (NAT && nT > 1) ATT_LOAD2(1, kreg1, vreg1); ATT_STORE(0);
    ATT_LBAR();
    const int rs_my = NAT ? (my_r < 4 ? 0 : (my_r > 28 ? 24 : my_r - 4)) : 0;
    const int cs_my = NAT ? (qc < 8 ? 0 : (qc > 56 ? 48 : qc - 8)) : 0;
    const int rs_wlo = NAT ? (wrow0 < 4 ? 0 : (wrow0 > 28 ? 24 : wrow0 - 4)) : 0, rs_whi = NAT ? (wrow0 + 1 < 4 ? 0 : (wrow0 + 1 > 28 ? 24 : wrow0 + 1 - 4)) : 0;
    const int sig32 = (q32 & ~12) | ((q32 & 4) << 1) | ((q32 & 8) >> 1);
    auto tile = [&](const int t) __attribute__((always_inline)) {
        if (NAT && t < nA) {
          const int kr = kr0 + t;
          if (kr >= rs_wlo && kr < rs_whi + 8) {
            const LAS unsigned char* kb = F.lds + (t & 1) * ATT_BUF; const LAS unsigned char* vb = kb + ATT_KB;
            f32x16 p0;
#pragma unroll
            for (int i = 0; i < 16; ++i) p0[i] = 0.f;
            {   const unsigned ka = (unsigned)(unsigned long)kb + (unsigned)((w0 + sig32) * ATT_KROW + hi * 16);
                bf16x8 kf[4];
#define ATT_DSR(dst, addr, off) asm volatile("ds_read_b128 %0, %1 offset:%2" : "=v"(dst) : "v"(addr), "i"(off))
                ATT_DSR(kf[0], ka, 0); ATT_DSR(kf[1], ka, 32); ATT_DSR(kf[2], ka, 64); ATT_DSR(kf[3], ka, 96);
                asm volatile("s_waitcnt lgkmcnt(0)" : "+v"(kf[0]), "+v"(kf[1]), "+v"(kf[2]), "+v"(kf[3]));
#pragma unroll
                for (int d0 = 0; d0 < 4; ++d0) p0 = __builtin_amdgcn_mfma_f32_32x32x16_bf16(kf[d0], qf[d0], p0, 0, 0, 0);
#undef ATT_DSR
            }
            {   const bool rowok = (kr >= rs_my) && (kr < rs_my + 8);
                const LAS float* rpb = (const LAS float*)(F.lds + ATT_RPB) + (rowok ? kr - my_r + 7 : 7) * 31 + 15 - qc;
#pragma unroll
                for (int r = 0; r < 16; ++r) { const int kc = w0 + (r & 7) + 8 * hi + 16 * (r >> 3);
                    const bool v0 = rowok && ((unsigned)(kc - cs_my) < 16u);
                    const float bb0 = rpb[kc];
                    p0[r] = v0 ? p0[r] + bb0 : -INFINITY; }
            }
            float tm = p0[0];
#pragma unroll
            for (int r = 1; r < 16; ++r) tm = fmaxf(tm, p0[r]);
            if (__builtin_expect(__any(tm - m_run > 8.0f), 0)) { tm = fmaxf(tm, sx(tm, 32)) - m_run; const float dl = fmaxf(tm, 0.f);     m_run += dl; const float alpha = __builtin_amdgcn_exp2f(-dl); l_run *= alpha;
#pragma unroll
                for (int d = 0; d < DV / 32; ++d)
#pragma unroll
                    for (int r = 0; r < 16; ++r) o[d][r] *= alpha; }
            {   constexpr int ND = DV / 32;
                const unsigned va = (unsigned)(unsigned long)vb + (unsigned)(q32 * ATT_VROW + 16 * hi + 2 * w0);
                bf16x8 vA[2 * ND];
#define ATT_DSR(dst, addr, off) asm volatile("ds_read_b128 %0, %1 offset:%2" : "=v"(dst) : "v"(addr), "i"(off))
#pragma unroll
                for (int d = 0; d < ND; ++d) { ATT_DSR(vA[d], va, d * 32 * ATT_VROW); ATT_DSR(vA[ND + d], va, d * 32 * ATT_VROW + 32); }
#undef ATT_DSR
                float ls = 0.f;
#pragma unroll
                for (int r = 0; r < 16; ++r) { p0[r] = __builtin_amdgcn_exp2f(p0[r] - m_run); ls += p0[r]; }
                l_run += ls;
                u32x4 pw[2];
#pragma unroll
                for (int q = 0; q < 2; ++q) { const int s8 = 8 * q; pw[q].x = pk2(p0[s8 + 0], p0[s8 + 1]); pw[q].y = pk2(p0[s8 + 2], p0[s8 + 3]); pw[q].z = pk2(p0[s8 + 4], p0[s8 + 5]); pw[q].w = pk2(p0[s8 + 6], p0[s8 + 7]); }
                if constexpr (ND == 2) asm volatile("s_waitcnt lgkmcnt(0)" : "+v"(vA[0]), "+v"(vA[1]), "+v"(vA[2]), "+v"(vA[3]));
#pragma unroll
                for (int q = 0; q < 2; ++q)
#pragma unroll
                    for (int d = 0; d < ND; ++d) o[d] = __builtin_amdgcn_mfma_f32_32x32x16_bf16(vA[q * ND + d], __builtin_bit_cast(bf16x8, pw[q]), o[d], 0, 0, 0);
            }
          }
        } else {
            const LAS unsigned char* kb = F.lds + (t & 1) * ATT_BUF; const LAS unsigned char* vb = kb + ATT_KB;
            f32x16 p0, p1;
#pragma unroll
            for (int i = 0; i < 16; ++i) { p0[i] = 0.f; p1[i] = 0.f; }
            {
                const unsigned ka = (unsigned)(unsigned long)kb + (unsigned)(sig32 * ATT_KROW + hi * 16);
                bf16x8 kf[8];
#define ATT_DSR(dst, addr, off) asm volatile("ds_read_b128 %0, %1 offset:%2" : "=v"(dst) : "v"(addr), "i"(off))
                ATT_DSR(kf[0], ka, 0); ATT_DSR(kf[1], ka, 32 * ATT_KROW); ATT_DSR(kf[2], ka, 32); ATT_DSR(kf[3], ka, 32 * ATT_KROW + 32);
                ATT_DSR(kf[4], ka, 64); ATT_DSR(kf[5], ka, 32 * ATT_KROW + 64); ATT_DSR(kf[6], ka, 96); ATT_DSR(kf[7], ka, 32 * ATT_KROW + 96);
                asm volatile("s_waitcnt lgkmcnt(0)" : "+v"(kf[0]), "+v"(kf[1]), "+v"(kf[2]), "+v"(kf[3]), "+v"(kf[4]), "+v"(kf[5]), "+v"(kf[6]), "+v"(kf[7]));
#pragma unroll
                for (int d0 = 0; d0 < 4; ++d0) {
                    p0 = __builtin_amdgcn_mfma_f32_32x32x16_bf16(kf[2 * d0], qf[d0], p0, 0, 0, 0);
                    p1 = __builtin_amdgcn_mfma_f32_32x32x16_bf16(kf[2 * d0 + 1], qf[d0], p1, 0, 0, 0);
                }
            }
            float tm = fmaxf(p0[0], p1[0]);
#pragma unroll
            for (int r = 1; r < 16; ++r) tm = fmaxf(tm, fmaxf(p0[r], p1[r]));
            if (__builtin_expect(__any(tm - m_run > 8.0f), 0)) { tm = fmaxf(tm, sx(tm, 32)) - m_run; const float dl = fmaxf(tm, 0.f); m_run += dl; const float alpha = __builtin_amdgcn_exp2f(-dl); l_run *= alpha;
#pragma unroll
                for (int d = 0; d < DV / 32; ++d)
#pragma unroll
                    for (int r = 0; r < 16; ++r) o[d][r] *= alpha; }
            const bool shifted = __any(m_run != 0.f);
            float ls = 0.f;
            if (shifted) {
#pragma unroll
                for (int r = 0; r < 16; ++r) { p0[r] = __builtin_amdgcn_exp2f(p0[r] - m_run); ls += p0[r]; }
            } else {
#pragma unroll
                for (int r = 0; r < 16; ++r) { p0[r] = __builtin_amdgcn_exp2f(p0[r]); ls += p0[r]; }
            }
            {   constexpr int ND = DV / 32;
                const unsigned va = (unsigned)(unsigned long)vb + (unsigned)(q32 * ATT_VROW + 16 * hi);
                bf16x8 vA[2 * ND], vB[2 * ND];
#define ATT_PIN_WAIT(v) do { if constexpr (ND == 4) asm volatile("s_waitcnt lgkmcnt(0)" : "+v"(v[0]), "+v"(v[1]), "+v"(v[2]), "+v"(v[3]), "+v"(v[4]), "+v"(v[5]), "+v"(v[6]), "+v"(v[7])); \
                                  else asm volatile("s_waitcnt lgkmcnt(0)" : "+v"(v[0]), "+v"(v[1]), "+v"(v[2]), "+v"(v[3])); } while (0)
#pragma unroll
                for (int d = 0; d < ND; ++d) { ATT_DSR(vA[d], va, d * 32 * ATT_VROW); ATT_DSR(vA[ND + d], va, d * 32 * ATT_VROW + 32); }
                u32x4 pw[4];
#pragma unroll
                for (int q = 0; q < 2; ++q) { const int s8 = 8 * q; pw[q].x = pk2(p0[s8 + 0], p0[s8 + 1]); pw[q].y = pk2(p0[s8 + 2], p0[s8 + 3]); pw[q].z = pk2(p0[s8 + 4], p0[s8 + 5]); pw[q].w = pk2(p0[s8 + 6], p0[s8 + 7]); }
                ATT_PIN_WAIT(vA);
#pragma unroll
                for (int d = 0; d < ND; ++d) { ATT_DSR(vB[d], va, d * 32 * ATT_VROW + 64); ATT_DSR(vB[ND + d], va, d * 32 * ATT_VROW + 96); }
#pragma unroll
                for (int q = 0; q < 2; ++q)
#pragma unroll
                    for (int d = 0; d < ND; ++d) o[d] = __builtin_amdgcn_mfma_f32_32x32x16_bf16(vA[q * ND + d], __builtin_bit_cast(bf16x8, pw[q]), o[d], 0, 0, 0);
                if (shifted) {
#pragma unroll
                    for (int r = 0; r < 16; ++r) { p1[r] = __builtin_amdgcn_exp2f(p1[r] - m_run); ls += p1[r]; }
                } else {
#pragma unroll
                    for (int r = 0; r < 16; ++r) { p1[r] = __builtin_amdgcn_exp2f(p1[r]); ls += p1[r]; }
                }
#pragma unroll
                for (int q = 0; q < 2; ++q) { const int s8 = 8 * q; pw[2 + q].x = pk2(p1[s8 + 0], p1[s8 + 1]); pw[2 + q].y = pk2(p1[s8 + 2], p1[s8 + 3]); pw[2 + q].z = pk2(p1[s8 + 4], p1[s8 + 5]); pw[2 + q].w = pk2(p1[s8 + 6], p1[s8 + 7]); }
#pragma unroll
                for (int i = 0; i < 2 * ND; ++i) { __builtin_amdgcn_sched_group_barrier(0x008, 1, 0); __builtin_amdgcn_sched_group_barrier(0x002, 40 / (2 * ND) + 1, 0); }
                l_run += ls;
                ATT_PIN_WAIT(vB);
#pragma unroll
                for (int q = 0; q < 2; ++q)
#pragma unroll
                    for (int d = 0; d < ND; ++d) o[d] = __builtin_amdgcn_mfma_f32_32x32x16_bf16(vB[q * ND + d], __builtin_bit_cast(bf16x8, pw[2 + q]), o[d], 0, 0, 0);
#undef ATT_PIN_WAIT
            }
        }
    };
    if constexpr (NAT) {
        for (int t = 0; t < nT; t += 2) {
            if (t + 2 < nT) ATT_LOAD2(t + 2, kreg, vreg);
            tile(t);
            if (t + 1 < nT) ATT_STORE2(1, kreg1, vreg1);
            ATT_LBAR();
            if (t + 1 >= nT) break;
            if (t + 3 < nT) ATT_LOAD2(t + 3, kreg1, vreg1);
            tile(t + 1);
            if (t + 2 < nT) ATT_STORE2(0, kreg, vreg);
            ATT_LBAR();
        }
    } else {
    for (int t = 0; t < nT; ++t) {
        const bool more = t + 1 < nT;
        if (more) ATT_LOAD(t + 1);
        tile(t);
        if (more) ATT_STORE((t + 1) & 1);
        ATT_LBAR();
    }
    }
#undef ATT_LOAD
#undef ATT_STORE
#undef ATT_LOAD2
#undef ATT_LBAR
#undef ATT_STORE2
}
__device__ __forceinline__ void load_qf(const bf16* qrow  , int hi, bf16x8 (&qf)[4]) {
#pragma unroll
    for (int d0 = 0; d0 < 4; ++d0) qf[d0] = *(const bf16x8*)(qrow + d0 * 16 + hi * 8);
}
__device__ __forceinline__ void diff_unit(Frame& F, int layer, int b, int h, int qrow0, bool lat, const float lam, const float lam_init) {
    const int lane = F.lane, q32 = lane & 31, hi = lane >> 5; const int row = qrow0 + F.wave * 32 + q32;
    const bf16* VT = ((bf16*)(F.ws + WS_VTD)) + (size_t)((b * 4 + h) * 128) * KEYS;
    const int nB = lat ? 32 : 0;
    LAS unsigned* o1s = (LAS unsigned*)(F.lds + 65536) + F.wave * 2048 + lane;
    {   f32x16 o1[4]; bf16x8 qf[4]; load_qf(((bf16*)(F.ws + WS_U)) + (size_t)row * INC + C_DQ + 128 * h, hi, qf);
        float m = 0.f, l = 0.f;
#pragma unroll
        for (int d = 0; d < 4; ++d)
#pragma unroll
            for (int r = 0; r < 16; ++r) o1[d][r] = 0.f;
        attn_pass<128, false>(F, VT, C_DK + 128 * h, 4, T_LAT + b * NCTX, 0, nB, b * SEQ, NCTX, qf, o1, m, l, 0, 0, 0);
        l += sx(l, 32); const float il = 1.0f / l;
#pragma unroll
        for (int d = 0; d < 4; ++d)
#pragma unroll
            for (int r = 0; r < 8; ++r) o1s[(d * 8 + r) * 64] = pk2(o1[d][2 * r] * il, o1[d][2 * r + 1] * il); }
    {   f32x16 o2[4]; bf16x8 qf[4]; load_qf(((bf16*)(F.ws + WS_U)) + (size_t)row * INC + C_DQ + 128 * h + 64, hi, qf);
        float m = 0.f, l = 0.f;
#pragma unroll
        for (int d = 0; d < 4; ++d)
#pragma unroll
            for (int r = 0; r < 16; ++r) o2[d][r] = 0.f;
        attn_pass<128, false>(F, VT, C_DK + 128 * h + 64, 4, T_LAT + b * NCTX, 0, nB, b * SEQ, NCTX, qf, o2, m, l, 0, 0, 0);
        l += sx(l, 32); const float il = lam / l;
        float ss = 0.f;
#pragma unroll
        for (int d = 0; d < 4; ++d)
#pragma unroll
            for (int r = 0; r < 8; ++r) { const unsigned ow = o1s[(d * 8 + r) * 64]; const float a0 = bflo(ow) - il * o2[d][2 * r], a1 = bfhi(ow) - il * o2[d][2 * r + 1]; o2[d][2 * r] = a0; o2[d][2 * r + 1] = a1; ss += a0 * a0 + a1 * a1; }
        ss += sx(ss, 32);
        const float rn = (1.0f / sqrtf(ss * (1.0f / 128.0f) + LN_EPS)) * (1.0f - lam_init);
        const float* sg = F.in[15] + layer * 128;
        bf16* dst = ((bf16*)(F.ws + WS_YB)) + (size_t)row * DB + 128 * h;
#pragma unroll
        for (int d = 0; d < 4; ++d)
#pragma unroll
            for (int rp = 0; rp < 2; ++rp) { unsigned wx[2], wy[2];
#pragma unroll
                for (int k = 0; k < 2; ++k) { const int r4 = 2 * rp + k; const int dv = 32 * d + 8 * r4 + 4 * hi; const f32x4 g = *(const f32x4*)(sg + dv);
                    wx[k] = pk2(o2[d][4 * r4] * rn * g[0], o2[d][4 * r4 + 1] * rn * g[1]); wy[k] = pk2(o2[d][4 * r4 + 2] * rn * g[2], o2[d][4 * r4 + 3] * rn * g[3]); }
                swap32(wx[0], wx[1]); swap32(wy[0], wy[1]);
                *(u32x4*)(dst + 32 * d + 16 * rp + 8 * hi) = (u32x4){wx[0], wy[0], wx[1], wy[1]}; } }
}
__device__ __forceinline__ void nat_unit(Frame& F, int layer, int b, int h, int rq) {
    const int lane = F.lane, q32 = lane & 31, hi = lane >> 5;
    const int wrow0 = 4 * rq + 2 * (F.wave >> 2), c0 = 16 * (F.wave & 3);
    const int w0 = c0 < 8 ? 0 : (c0 - 8 > 32 ? 32 : c0 - 8);
    const int my_r = wrow0 + (q32 >> 4), qc = c0 + (q32 & 15); const int row = b * SEQ + 64 * my_r + qc;
    if ((F.G & 63) != 0) { __syncthreads(); LAS float* rp = (LAS float*)(F.lds + ATT_RPB); const float* src = F.in[16] + ((size_t)layer * 8 + h) * 465; for (int i = F.tid; i < 465; i += NTHR) rp[i] = src[i] * LOG2E; }
    const int r_lo = 4 * rq, r_hi = 4 * rq + 3;
    const int kr0 = r_lo < 4 ? 0 : (r_lo > 28 ? 24 : r_lo - 4); const int krl = (r_hi < 4 ? 0 : (r_hi > 28 ? 24 : r_hi - 4)) + 7;
    const int nloc = krl - kr0 + 1;
    bf16x8 qf[4]; load_qf(((bf16*)(F.ws + WS_U)) + (size_t)row * INC + C_NQ + 64 * h, hi, qf);
    f32x16 o[2]; float m = 0.f, l = 0.f;
#pragma unroll
    for (int d = 0; d < 2; ++d)
#pragma unroll
        for (int r = 0; r < 16; ++r) o[d][r] = 0.f;
    attn_pass<64, true>(F, ((bf16*)(F.ws + WS_VTN)) + (size_t)((b * 8 + h) * 64) * KEYS, C_NK + 64 * h, nloc, b * SEQ + 64 * kr0, NCTX + 64 * kr0, 4, T_LAT + b * NCTX, 0, qf, o, m, l, my_r, kr0, qc, __builtin_amdgcn_readfirstlane(wrow0), __builtin_amdgcn_readfirstlane(w0));
    l += sx(l, 32); const float il = 1.0f / l;
    bf16* dst = ((bf16*)(F.ws + WS_YC)) + (size_t)row * DB + 64 * h;
#pragma unroll
    for (int d = 0; d < 2; ++d)
#pragma unroll
        for (int rp = 0; rp < 2; ++rp) { unsigned wx[2], wy[2];
#pragma unroll
            for (int k = 0; k < 2; ++k) { const int r4 = 2 * rp + k; wx[k] = pk2(o[d][4 * r4] * il, o[d][4 * r4 + 1] * il); wy[k] = pk2(o[d][4 * r4 + 2] * il, o[d][4 * r4 + 3] * il); }
            swap32(wx[0], wx[1]); swap32(wy[0], wy[1]);
            *(u32x4*)(dst + 32 * d + 16 * rp + 8 * hi) = (u32x4){wx[0], wy[0], wx[1], wy[1]}; }
}
__device__ __forceinline__ void natctx_unit(Frame& F, int b, int h) {
    const int lane = F.lane, q32 = lane & 31, hi = lane >> 5; const int row = T_LAT + b * NCTX + F.wave * 32 + q32;
    bf16x8 qf[4]; load_qf(((bf16*)(F.ws + WS_U)) + (size_t)row * INC + C_NQ + 64 * h, hi, qf);
    f32x16 o[2]; float m = 0.f, l = 0.f;
#pragma unroll
    for (int d = 0; d < 2; ++d)
#pragma unroll
        for (int r = 0; r < 16; ++r) o[d][r] = 0.f;
    attn_pass<64, false>(F, ((bf16*)(F.ws + WS_VTN)) + (size_t)((b * 8 + h) * 64) * KEYS, C_NK + 64 * h, 4, T_LAT + b * NCTX, 0, 0, 0, 0, qf, o, m, l, 0, 0, 0);
    l += sx(l, 32); const float il = 1.0f / l;
    bf16* dst = ((bf16*)(F.ws + WS_YC)) + (size_t)row * DB + 64 * h;
#pragma unroll
    for (int d = 0; d < 2; ++d)
#pragma unroll
        for (int rp = 0; rp < 2; ++rp) { unsigned wx[2], wy[2];
#pragma unroll
            for (int k = 0; k < 2; ++k) { const int r4 = 2 * rp + k; wx[k] = pk2(o[d][4 * r4] * il, o[d][4 * r4 + 1] * il); wy[k] = pk2(o[d][4 * r4 + 2] * il, o[d][4 * r4 + 3] * il); }
            swap32(wx[0], wx[1]); swap32(wy[0], wy[1]);
            *(u32x4*)(dst + 32 * d + 16 * rp + 8 * hi) = (u32x4){wx[0], wy[0], wx[1], wy[1]}; }
}

constexpr int N_PHASES = 2 + 8 * DEPTH;
struct Args { const float* in[29]; float* out; unsigned char* ws; int ph_lo, ph_hi; };
__global__ void diag_nan_scan(const float* out, unsigned* res) {
    const int row = blockIdx.x; bool bad = false;
    for (int c = threadIdx.x; c < DM; c += blockDim.x) { const float v = out[(size_t)row * DM + c]; if (!(fabsf(v) < 3.0e38f)) bad = true; }
    if (__syncthreads_or(bad) && threadIdx.x == 0) { atomicAdd(&res[0], 1u); atomicMin(&res[1], (unsigned)row); atomicMax(&res[2], (unsigned)row); }
}
__global__ void diag_fill(float* out, const unsigned* res, int which) {
    float c = 0.f; if (which == 0) c = (float)res[0] / 16.f; if (which == 1) c = (float)(res[1] >> 8) + 1.f; if (which == 2) c = (float)(res[2] >> 8) + 1.f; if (which == 3) c = (float)(res[1] & 255) + 1.f;
    for (size_t i = (size_t)blockIdx.x * blockDim.x + threadIdx.x; i < (size_t)T_LAT * DM; i += (size_t)gridDim.x * blockDim.x) out[i] = c;
}
#ifndef DIAG_MODE
#define DIAG_MODE 34
#endif
__global__ void diag_copy_kernel(const unsigned char* ws, float* out) {
    for (size_t i = (size_t)blockIdx.x * blockDim.x + threadIdx.x; i < (size_t)T_LAT * DM; i += (size_t)gridDim.x * blockDim.x) {
        const int r = (int)(i >> 10), c = (int)(i & 1023); float v = 0.f;
        if (DIAG_MODE == 0) v = ((const float*)(ws + WS_X))[i];
        if (DIAG_MODE == 1) { const bf16* U = (const bf16*)(ws + WS_U); for (int k = 0; k < 7; ++k) v += bf2f(U[(size_t)r * INC + c + 1024 * k]) + bf2f(U[(size_t)(T_LAT + (r & 4095)) * INC + c + 1024 * k]);
            if (i < (size_t)16 * 4 * 128 * KEYS) v += bf2f(((const bf16*)(ws + WS_VTD))[i]) + bf2f(((const bf16*)(ws + WS_VTN))[i]); }
        if (DIAG_MODE == 2) { v = c < 512 ? bf2f(((const bf16*)(ws + WS_YA))[(size_t)r * DB + c]) + 2.f * bf2f(((const bf16*)(ws + WS_YB))[(size_t)r * DB + c]) : bf2f(((const bf16*)(ws + WS_YC))[(size_t)r * DB + c - 512]);
            v += c < 512 ? bf2f(((const bf16*)(ws + WS_YA))[(size_t)(T_LAT + (r & 4095)) * DB + c]) + 2.f * bf2f(((const bf16*)(ws + WS_YB))[(size_t)(T_LAT + (r & 4095)) * DB + c]) : bf2f(((const bf16*)(ws + WS_YC))[(size_t)(T_LAT + (r & 4095)) * DB + c - 512]); }
        if (DIAG_MODE == 6) { const bf16* U = (const bf16*)(ws + WS_U); for (int k = 4; k < 7; ++k) v += bf2f(U[(size_t)r * INC + c + 1024 * k]) + bf2f(U[(size_t)(T_LAT + (r & 4095)) * INC + c + 1024 * k]); }
        if (DIAG_MODE == 7) { const bf16* U = (const bf16*)(ws + WS_U); const int cc = c & 511; v = bf2f(U[(size_t)r * INC + cc]) + bf2f(U[(size_t)r * INC + 1024 + c]) + bf2f(U[(size_t)r * INC + 2560 + c]) + bf2f(U[(size_t)(T_LAT + (r & 4095)) * INC + cc]) + bf2f(U[(size_t)(T_LAT + (r & 4095)) * INC + 1024 + c]) + bf2f(U[(size_t)(T_LAT + (r & 4095)) * INC + 2560 + c]); }
        if (DIAG_MODE == 8) { const bf16* W = (const bf16*)(ws + WS_WIN); v = bf2f(W[(size_t)(r % 7168) * DM + c]) + bf2f(W[(size_t)(7168 + (r % 7168)) * DM + c]); }
        if (DIAG_MODE == 20) { const unsigned* ctl = (const unsigned*)(ws + WS_CTL); unsigned t = 0; for (int e = 0; e < 32; ++e) t += ctl[CW_ECNT + e * 64]; v = 10.f * (float)t / 147456.f; }
        if (DIAG_MODE == 21) { const bf16* Y = (const bf16*)(ws + WS_YK); float a = 0.f; for (int k = 0; k < 256; ++k) a += fabsf(bf2f(Y[(size_t)k * 500009 + (i & 65535)])); v = 100.f * a / 256.f; }
        if (DIAG_MODE == 22) { const bf16* Y = (const bf16*)(ws + WS_U); float a = 0.f; for (int k = 0; k < 256; ++k) a += fabsf(bf2f(Y[(size_t)k * 500009 + (i & 65535)])); v = 100.f * a / 256.f; }
        if (DIAG_MODE == 23) { const u32x2* L = (const u32x2*)(ws + WS_LIST); float a = 0.f; for (int e = 0; e < 32; ++e) for (int k = 0; k < 8; ++k) a += __builtin_bit_cast(float, L[(size_t)e * LIST_CAP + k * 100].y); v = 100.f * a / 256.f; }
        if (DIAG_MODE == 24) { const u32x2* L = (const u32x2*)(ws + WS_LIST); float a = 0.f; for (int e = 0; e < 32; ++e) for (int k = 0; k < 8; ++k) a += (L[(size_t)e * LIST_CAP + k * 100].x < 131072u) ? 1.f : 0.f; v = 10.f * a / 256.f; }
        if (DIAG_MODE == 25) { const unsigned short* Y = (const unsigned short*)(ws + WS_YK); float a = 0.f; for (int k = 0; k < 256; ++k) a += (Y[(size_t)k * 500009 + (i & 65535)] != 0xAAAAu) ? 1.f : 0.f; v = 10.f * a / 256.f; }
        if (DIAG_MODE == 27) { const u32x2* L = (const u32x2*)(ws + WS_LIST); float a = 0.f; for (int e = 0; e < 32; ++e) for (int k = 0; k < 8; ++k) a += (float)(L[(size_t)e * LIST_CAP + k * 100].y >> 20); v = a / 256.f; }
        if (DIAG_MODE == 28) { const u32x2* L = (const u32x2*)(ws + WS_LIST); float a = 0.f; for (int e = 0; e < 32; ++e) for (int k = 0; k < 8; ++k) { const float w = __builtin_bit_cast(float, L[(size_t)e * LIST_CAP + k * 100].y); a += (w > 0.01f && w < 1.0f) ? 1.f : 0.f; } v = a / 25.6f; }
        if (DIAG_MODE == 29) { const u32x2* L = (const u32x2*)(ws + WS_LIST); float a = 0.f; for (int e = 0; e < 32; ++e) for (int k = 0; k < 8; ++k) a += ((L[(size_t)e * LIST_CAP + k * 100].y >> 20) > 2000u) ? 1.f : 0.f; v = a / 25.6f; }
        if (DIAG_MODE == 31) { const u32x2* L = (const u32x2*)(ws + WS_LIST); v = 100.f * __builtin_bit_cast(float, L[5].y); }
        if (DIAG_MODE == 32) { const u32x2* L = (const u32x2*)(ws + WS_LIST); v = (float)(L[5].y >> 20); }
        if (DIAG_MODE == 33) { v = 25.f; }
        if (DIAG_MODE == 34) { const u32x2* L = (const u32x2*)(ws + WS_LIST); const unsigned y = L[5].y; v = (y > 0x3C000000u && y < 0x3F800001u) ? 25.f : ((y >> 20) < 944u ? 50.f : 75.f); }
        if (DIAG_MODE == 3) { const bf16* Z = (const bf16*)(ws + WS_MB); v = bf2f(Z[(size_t)r * DM + c]);
#if !defined(DIAG_ONEJ)
 v += bf2f(Z[(size_t)r * 3072 + 1024 + c]) + bf2f(Z[(size_t)r * 3072 + 2048 + c]);
#endif
 }
        if (DIAG_MODE == 4) v = ((const float*)(ws + WS_MV))[i];
        if (DIAG_MODE == 5) v = bf2f(((const bf16*)(ws + WS_H))[i]);
        out[i] = v; }
}
#ifndef PHASE_MASK
#define PHASE_MASK 0xffffffffu
#endif
#define PMASK(k) ((PHASE_MASK >> (((k) < 2) ? (k) : 2 + (((k) - 2) & 7))) & 1u)
#define IN(k) (PMASK(k) && lo <= (k) && (k) < hi)
#define LAUNDER() do { int wv_ = F.wave0; asm volatile("" : "+s"(wv_)); const int t_ = (wv_ << 6) | lane_now(); F.tid = t_; F.lane = t_ & 63; F.wave = wv_; unsigned char* w_ = args.ws; asm volatile("" : "+s"(w_)); F.ws = (GAS unsigned char*)w_; F.ctl = (gu32*)(w_ + WS_CTL); unsigned long long z_ = 0; asm volatile("" : "+s"(z_)); F.in = args.in + z_; int b_ = blockIdx.x, g_ = gridDim.x; asm volatile("" : "+s"(b_), "+s"(g_)); F.bid = b_; F.G = g_; } while (0)
#define SEAM(k) do { if (IN(k) && IN((k) + 1)) xcd_barrier(bar); } while (0)
template <int layer>
__device__ __forceinline__ void layer_phases(Frame& F, const Args& args, const XcdBarrier& bar, const int lo, const int hi, const int vcu) {
        const int pb = 2 + 8 * layer;
        const bool with_ctx = layer < DEPTH - 1;
        const int nrows = with_ctx ? T_ALL : T_LAT;
        if (IN(pb + 0)) { LAUNDER();
            pg8::StaticOrder S; S.init_bytes((unsigned char*)(F.ws + WS_H8), DM, (unsigned char*)(F.ws + WS_WIN) + (size_t)layer * INC * DM, DM, T_ALL, INC, F.G, F.bid);
            EpiWin E{F.ws, W8_INV};
            pg8::gemm_phase<EpiWin, pg8::StaticOrder, true>(F.lds, F.wave, DM, DM, S, E);
        } SEAM(pb + 0);
        if (IN(pb + 1)) { LAUNDER();
#ifndef UNIT_MASK
#define UNIT_MASK 15
#endif
            const int nsq = with_ctx ? 576 : 512;
            const float lam_init = 0.8f - 0.6f * expf(-0.3f * (float)layer);
            const float lam = expf(wave_sum(F.in[11][layer * 64 + F.lane] * F.in[12][layer * 64 + F.lane])) - expf(wave_sum(F.in[13][layer * 64 + F.lane] * F.in[14][layer * 64 + F.lane])) + lam_init;
            if (UNIT_MASK & 1) for (int u = vcu; u < nsq; u += F.G) { const bool lat = u < 512; const int b = lat ? (u >> 5) : ((u - 512) >> 2), h = lat ? ((u >> 3) & 3) : ((u - 512) & 3);
                diff_unit(F, layer, b, h, lat ? b * SEQ + (u & 7) * 256 : T_LAT + b * NCTX, lat, lam, lam_init); }
            { __syncthreads(); LAS float* rp = (LAS float*)(F.lds + ATT_RPB); const float* src = F.in[16] + ((size_t)layer * 8 + ((vcu >> 3) & 7)) * 465; for (int i = F.tid; i < 465; i += NTHR) rp[i] = src[i] * LOG2E; }
            if (UNIT_MASK & 2) for (int u = vcu; u < 1024; u += F.G) nat_unit(F, layer, u >> 6, (u >> 3) & 7, u & 7);
            if (UNIT_MASK & 4) conv_units(F, layer, 2 * nsq);
            if ((UNIT_MASK & 8) && with_ctx) for (int u = F.bid; u < 128; u += F.G) natctx_unit(F, u >> 3, u & 7);
            __syncthreads();
        } SEAM(pb + 1);
        if (IN(pb + 2)) { LAUNDER();
            MergeOrder S; S.Y = (const char*)(F.ws + WS_YA); S.W = (const char*)(((bf16*)(F.ws + WS_WBR)) + (size_t)layer * 3 * DM * DB); S.T.init(nullptr, DB, nullptr, DB, nrows, DM, F.G, F.bid);
            EpiMB E{((bf16*)(F.ws + WS_U)), ((bf16*)(F.ws + WS_MB))};
            pg8::gemm_phase<EpiMB, MergeOrder>(F.lds, F.wave, DB * 2, DB * 2, S, E);
            if (layer == 0 && F.G == 256 && F.bid >= 64) convert_items(F, CV_LAYER + CV_P0_L1, CV_LAYER + CV_P0_L1 + CV_SLOT_A, (F.bid - 64) * NWAVES + F.wave, 192 * NWAVES);
        } SEAM(pb + 2);
        if (IN(pb + 3)) { LAUNDER();
            pg8::StaticOrder S; S.init(((bf16*)(F.ws + WS_MB)), DM, ((bf16*)(F.ws + WS_WOUT)) + (size_t)layer * DM * DM, DM, nrows, DM, F.G, F.bid);
            EpiWout E{((float*)(F.ws + WS_MOD)) + (size_t)layer * 17 * 6144 + 2048, ((bf16*)(F.ws + WS_MV))};
            pg8::gemm_phase<EpiWout, pg8::StaticOrder>(F.lds, F.wave, DM * 2, DM * 2, S, E);
            if (layer == 0 && F.G == 256 && F.bid >= 64) convert_items(F, CV_LAYER + CV_P0_L1 + CV_SLOT_A, 2 * CV_LAYER, (F.bid - 64) * NWAVES + F.wave, 192 * NWAVES);
        } SEAM(pb + 3);
        if (IN(pb + 4)) { LAUNDER(); p5_ln1_router(F, layer, nrows); } SEAM(pb + 4);
        if (IN(pb + 5)) { LAUNDER();
            moe_build_tiles(F, layer, 8, true);
            MoeSched1 S{(const char*)(F.ws + WS_H8), (const char*)(F.ws + WS_W1 + (size_t)layer * NE * 2048 * DM), (LAS const int*)(F.lds + TILE_OFF), (LAS const unsigned short*)(F.lds + IDX_OFF), (int)F.MISC[MI_NUNITS]};
            EpiMoe1 E{(unsigned char*)(F.ws + WS_U), F.in[24] + (size_t)layer * NE * 2048};
            pg8::gemm_phase<EpiMoe1, MoeSched1, true>(F.lds, F.wave, DM, DM, S, E);
        } SEAM(pb + 5);
        if (IN(pb + 6)) { LAUNDER();
            moe_build_tiles(F, layer, 4, false);
            MoeSched2 S{(const char*)(F.ws + WS_U), (const char*)(F.ws + WS_W2 + (size_t)layer * NE * DM * DFF), (LAS const int*)(F.lds + TILE_OFF), (int)F.MISC[MI_NUNITS]};
            EpiMoe2 E{(unsigned char*)(F.ws + WS_YK), F.in[26] + (size_t)layer * NE * DM, ((u32x2*)(F.ws + WS_LIST))};
            pg8::gemm_phase<EpiMoe2, MoeSched2, true>(F.lds, F.wave, DFF, DFF, S, E);
        } SEAM(pb + 6);
        if (IN(pb + 7)) { LAUNDER(); p8_final(F, layer, nrows); } SEAM(pb + 7);
    }
__global__ void __launch_bounds__(NTHR, 2) fwd_kernel(Args args) {
    extern __shared__ __attribute__((aligned(16))) unsigned char lds_raw[];
    Frame F;
    F.lds = (LAS unsigned char*)lds_raw;
    F.MISC = (volatile LAS unsigned*)(F.lds + MISC_OFF);
    F.tid = threadIdx.x; F.lane = F.tid & 63; F.wave = __builtin_amdgcn_readfirstlane(F.tid >> 6); F.wave0 = F.wave; F.G = gridDim.x; F.bid = blockIdx.x;
    unsigned char* ws = args.ws;
    F.ctl = (gu32*)(ws + WS_CTL);
    F.in = args.in; F.out = (GAS float*)args.out; F.ws = (GAS unsigned char*)ws;
    for (int u = F.tid; u < (LDS_BYTES - MISC_OFF) / 4; u += NTHR) ((LAS unsigned*)(F.lds + MISC_OFF))[u] = 0u;
    __syncthreads();
    const int lo = args.ph_lo, hi = args.ph_hi;
    XcdBarrier bar; bar.bar = (unsigned*)(F.ctl + CW_BAR); bar.x = 0; bar.st = nullptr; bar.w0 = F.wave0;
    if (hi - lo > 1) { bar = xcd_barrier_post((unsigned*)(F.ctl + CW_BAR), F.MISC + MI_BAR); bar.w0 = F.wave0; }
    const int vcu = (F.G % 8 == 0) ? (F.bid % 8) * (F.G / 8) + F.bid / 8 : F.bid;

    if (IN(0)) { LAUNDER(); p0_prologue(F); } SEAM(0);
    if (IN(1)) { LAUNDER(); p1_modulate0(F); } SEAM(1);

    layer_phases<0>(F, args, bar, lo, hi, vcu);
    layer_phases<1>(F, args, bar, lo, hi, vcu);
#undef IN
#undef SEAM
}

extern "C" void kernel_launch(void* const* d_in, const int* in_sizes, int n_in, void* d_out, int out_size, void* d_ws, size_t ws_size, hipStream_t stream) {
    static int grid = 0;
    if (grid == 0) {
        if (n_in != 29 || out_size != T_LAT * DM || ws_size < WS_END) { fprintf(stderr, "kernel_launch: unexpected shapes (n_in %d out %d ws %zu need %zu)\n", n_in, out_size, ws_size, (size_t)WS_END); grid = -1; return; }
        int dev = 0, cus = 0, per_cu = 0;
        if (hipGetDevice(&dev) != hipSuccess || hipDeviceGetAttribute(&cus, hipDeviceAttributeMultiprocessorCount, dev) != hipSuccess) { grid = -1; return; }
        if (hipFuncSetAttribute((const void*)fwd_kernel, hipFuncAttributeMaxDynamicSharedMemorySize, LDS_BYTES) != hipSuccess) { fprintf(stderr, "kernel_launch: hipFuncSetAttribute failed\n"); grid = -1; return; }
        if (hipOccupancyMaxActiveBlocksPerMultiprocessor(&per_cu, (const void*)fwd_kernel, NTHR, LDS_BYTES) != hipSuccess || per_cu < 1) fprintf(stderr, "kernel_launch: occupancy query reports %d\n", per_cu);
        (void)hipGetLastError();
        grid = cus < 256 ? cus : 256;
        if (grid != 256) fprintf(stderr, "kernel_launch: %d CUs; this kernel is sized for 256\n", cus);
    }
    if (grid < 0) return;
    if (hipMemsetAsync((char*)d_ws + WS_CTL, 0, CTL_ZERO_BYTES, stream) != hipSuccess) return;
    Args a{};
    for (int i = 0; i < 29; ++i) a.in[i] = (const float*)d_in[i];
    a.out = (float*)d_out; a.ws = (unsigned char*)d_ws;
#if MK_ONE_LAUNCH
    a.ph_lo = 0; a.ph_hi = N_PHASES;
    hipLaunchKernelGGL(fwd_kernel, dim3(grid), dim3(NTHR), LDS_BYTES, stream, a);
#else
    const int np = DIAG_STOP ? DIAG_STOP : N_PHASES;
    for (int p = 0; p < np; ++p) { a.ph_lo = p; a.ph_hi = p + 1; hipLaunchKernelGGL(fwd_kernel, dim3(grid), dim3(NTHR), LDS_BYTES, stream, a); }
#ifdef DIAG_NAN
    { unsigned* res = (unsigned*)((char*)d_ws + 512 * 1024); hipMemsetAsync(res, 0, 4, stream); hipMemsetAsync(res + 1, 0xFF, 4, stream); hipMemsetAsync(res + 2, 0, 4, stream);
      hipLaunchKernelGGL(diag_nan_scan, dim3(T_LAT), dim3(256), 0, stream, (const float*)d_out, res);
      hipLaunchKernelGGL(diag_fill, dim3(2048), dim3(256), 0, stream, (float*)d_out, (const unsigned*)res, DIAG_NAN); }
#endif
    if (DIAG_STOP) hipLaunchKernelGGL(diag_copy_kernel, dim3(2048), dim3(256), 0, stream, (const unsigned char*)d_ws, (float*)d_out);
#endif
}
```

```cpp
#include <hip/hip_runtime.h>
#include <cstdio>
#include <cstdint>

#define DIAG_GATEPLAIN 0
#ifndef ABL
#define ABL 0
#endif
#ifndef DIAG_STOP
#define DIAG_STOP 0
#endif
#ifndef MK_ONE_LAUNCH
#define MK_ONE_LAUNCH 1
#endif

#define LAS __attribute__((address_space(3)))
#define GAS __attribute__((address_space(1)))
typedef unsigned short bf16;
typedef short bf16x8 __attribute__((ext_vector_type(8)));
typedef float f32x4 __attribute__((ext_vector_type(4)));
typedef float f32x2 __attribute__((ext_vector_type(2)));
typedef float f32x16 __attribute__((ext_vector_type(16)));
typedef float f32x8 __attribute__((ext_vector_type(8)));
typedef unsigned u32x4 __attribute__((ext_vector_type(4)));
typedef unsigned u32x2 __attribute__((ext_vector_type(2)));
typedef GAS unsigned gu32;

constexpr int NB = 16, SEQ = 2048, NCTX = 256, DM = 1024, DB = 512, DEPTH = 2;
constexpr int T_LAT = NB * SEQ, T_CTX = NB * NCTX, T_ALL = T_LAT + T_CTX;
constexpr int INC = 7168, NE = 32, TOPK = 4, DFF = 1024, CONVK = 31;
constexpr int KEYS = NCTX + SEQ;
constexpr int C_DQ = 1024, C_DK = 1536, C_DV = 2048, C_NQ = 2560, C_NK = 3072, C_NV = 3584, C_G = 4096;
constexpr float LN_EPS = 1e-6f, ALPHA = 1.4142135623730951f, LOG2E = 1.4426950408889634f;
constexpr float QSCALE = 0.125f * LOG2E;
constexpr int LIST_CAP = T_ALL;

constexpr size_t MiB = 1u << 20;
constexpr size_t WS_CTL = 0, CTL_ZERO_BYTES = 1 * MiB;
constexpr size_t WS_MOD = 1 * MiB;
constexpr size_t WS_ROPE = 3 * MiB;
constexpr size_t WS_LIST = 4 * MiB;
constexpr size_t WS_WIN = 16 * MiB;
constexpr size_t WS_WBR = WS_WIN + 28 * MiB;
constexpr size_t WS_WOUT = WS_WBR + 6 * MiB;
constexpr size_t WS_W1 = WS_WOUT + 4 * MiB;
constexpr size_t WS_W2 = WS_W1 + 128 * MiB;
constexpr size_t WS_WIN8 = WS_W2 + 64 * MiB;
constexpr size_t WS_H8 = WS_WIN8 + 8 * MiB;
constexpr size_t WS_H = WS_H8 + 36 * MiB;
constexpr size_t WS_X = WS_H + 72 * MiB;
constexpr size_t WS_U = WS_X + 144 * MiB;
constexpr size_t WS_MV = WS_U;
constexpr size_t WS_YA = WS_U + 504 * MiB;
constexpr size_t WS_YB = WS_YA + 36 * MiB;
constexpr size_t WS_YC = WS_YB + 36 * MiB;
constexpr size_t WS_MB = WS_YC + 36 * MiB;
constexpr size_t WS_Z = WS_MB;
constexpr size_t WS_YK = WS_YA;
constexpr size_t WS_VTD = WS_Z + 216 * MiB;
constexpr size_t WS_VTN = WS_VTD + 36 * MiB;
constexpr size_t WS_END = WS_VTN + 36 * MiB;
static_assert(WS_END <= 2048 * MiB, "workspace map");
constexpr int MAX_TILES = 608;

constexpr int CW_TMO = 0, CW_CODE = 1;
constexpr int CW_BAR = 4096;
constexpr int CW_ECNT = 16384;

constexpr int RING_BYTES = 131072;
constexpr int IDX_OFF = RING_BYTES;
constexpr int TILE_OFF = IDX_OFF + 24 * 512;
constexpr int MISC_OFF = TILE_OFF + 24 * 32;
constexpr int LDS_BYTES = 147456;
static_assert(MISC_OFF + 2048 <= LDS_BYTES, "LDS map");
constexpr int NWAVES = 8, NTHR = 512;

__device__ __forceinline__ unsigned f2bf(float f) { unsigned u = __builtin_bit_cast(unsigned, f); return (u + 0x7fffu + ((u >> 16) & 1u)) >> 16; }
typedef __bf16 bf16x2_t __attribute__((ext_vector_type(2)));
__device__ __forceinline__ unsigned pk2(float lo, float hi) { const f32x2 v = {lo, hi}; const bf16x2_t b = __builtin_convertvector(v, bf16x2_t); return __builtin_bit_cast(unsigned, b); }
__device__ __forceinline__ float bf2f(unsigned short b) { return __builtin_bit_cast(float, (unsigned)b << 16); }
__device__ __forceinline__ float bflo(unsigned w) { return __builtin_bit_cast(float, w << 16); }
__device__ __forceinline__ float bfhi(unsigned w) { return __builtin_bit_cast(float, w & 0xffff0000u); }
__device__ __forceinline__ float fsigmoid(float x) { return __builtin_amdgcn_rcpf(1.0f + __builtin_amdgcn_exp2f(-x * LOG2E)); }
__device__ __forceinline__ int lane_now() { int l; asm volatile("v_mbcnt_lo_u32_b32 %0, -1, 0\n\tv_mbcnt_hi_u32_b32 %0, -1, %0" : "=v"(l)); return l; }
__device__ __forceinline__ float sx(float v, int m) { return __builtin_bit_cast(float, __builtin_amdgcn_ds_bpermute((lane_now() ^ m) << 2, __builtin_bit_cast(int, v))); }
__device__ __forceinline__ void swap32(unsigned& x, unsigned& y) { const auto r = __builtin_amdgcn_permlane32_swap(x, y, false, false); x = r[0]; y = r[1]; }
template <int CTRL> __device__ __forceinline__ float dppx(float v) { return __builtin_bit_cast(float, __builtin_amdgcn_update_dpp(0, __builtin_bit_cast(int, v), CTRL, 0xF, 0xF, false)); }
template <int CTRL> __device__ __forceinline__ int dppxi(int v) { return __builtin_amdgcn_update_dpp(0, v, CTRL, 0xF, 0xF, false); }
__device__ __forceinline__ float wave_sum(float v) {
    v += dppx<0xB1>(v); v += dppx<0x4E>(v); v += dppx<0x141>(v); v += dppx<0x140>(v);
    { const unsigned b = __builtin_bit_cast(unsigned, v); const auto r = __builtin_amdgcn_permlane16_swap(b, b, false, false); v = __builtin_bit_cast(float, (unsigned)r[0]) + __builtin_bit_cast(float, (unsigned)r[1]); }
    { const unsigned b = __builtin_bit_cast(unsigned, v); const auto r = __builtin_amdgcn_permlane32_swap(b, b, false, false); v = __builtin_bit_cast(float, (unsigned)r[0]) + __builtin_bit_cast(float, (unsigned)r[1]); }
    return v;
}
#define LDS_WAIT() asm volatile("s_waitcnt lgkmcnt(0)" ::: "memory")
#define VM_WAIT() asm volatile("s_waitcnt vmcnt(0)" ::: "memory")
#define RLX_AGENT __ATOMIC_RELAXED, __HIP_MEMORY_SCOPE_AGENT

#define XB_TMO      128
#define XB_XCNT(j)  (256  + 64 * (j))
#define XB_XSUB(j)  (1280 + 64 * (j))
#define XB_XGEN(j)  (2304 + 64 * (j))
#define XB_TOP      3328
#define XB_TOPGEN   3392
#define XCD_BAR_WORDS 3456
#define XB_SPIN_CAP (1u << 22)
__device__ __forceinline__ unsigned xb_ld(unsigned* p)              { return __hip_atomic_load(p, __ATOMIC_RELAXED, __HIP_MEMORY_SCOPE_AGENT); }
__device__ __forceinline__ unsigned xb_add(unsigned* p, unsigned v) { return __hip_atomic_fetch_add(p, v, __ATOMIC_RELAXED, __HIP_MEMORY_SCOPE_AGENT); }
__device__ __forceinline__ unsigned xb_xcc_id() { return (unsigned)__builtin_amdgcn_s_getreg((3 << 11) | 20) & 0xFu; }
#define XB_SPIN(cond, bar) do { unsigned _sp = 0; while (cond) { __builtin_amdgcn_s_sleep(1); \
    if ((++_sp & 255u) == 0u) { if (xb_ld(&(bar)[XB_TMO])) break; if (_sp > XB_SPIN_CAP) { atomicAdd(&(bar)[XB_TMO], 1u); break; } } } } while (0)
struct XcdBarrier { unsigned* bar; unsigned x; volatile LAS unsigned* st; int w0; };
__device__ __forceinline__ XcdBarrier xcd_barrier_post(unsigned* bar, volatile LAS unsigned* st) {
    XcdBarrier b; b.bar = bar; b.x = xb_xcc_id(); b.st = st;
    if (threadIdx.x == 0) (void)xb_add(&bar[XB_XCNT(b.x)], 1u);
    return b;
}
__device__ __forceinline__ void xcd_barrier_complete(unsigned* bar, unsigned x, unsigned& nloc, unsigned& nx) {
    const unsigned G = gridDim.x * gridDim.y * gridDim.z;
    unsigned sum, cnt, mine, sp = 0u;
    for (;;) {
        sum = 0u; cnt = 0u; mine = 0u;
#pragma unroll
        for (unsigned j = 0; j < 16; ++j) { const unsigned c = xb_ld(&bar[XB_XCNT(j)]); sum += c; cnt += (c > 0u) ? 1u : 0u; mine = (j == x) ? c : mine; }
        if (sum == G) break;
        __builtin_amdgcn_s_sleep(1);
        if ((++sp & 255u) == 0u) { if (xb_ld(&bar[XB_TMO])) break; if (sp > XB_SPIN_CAP) { atomicAdd(&bar[XB_TMO], 1u); break; } }
    }
    nloc = mine > 0u ? mine : 1u; nx = cnt > 0u ? cnt : 1u;
}
__device__ __forceinline__ void xcd_barrier(const XcdBarrier& b) {
    asm volatile("s_waitcnt vmcnt(0)" ::: "memory");
    __syncthreads();
    if (b.w0 == 0 && lane_now() == 0) {
        unsigned* bar = b.bar;
        __builtin_amdgcn_s_waitcnt(0);
        unsigned nloc = b.st[0], nx = b.st[1];
        if (nloc == 0u) { xcd_barrier_complete(bar, b.x, nloc, nx); b.st[0] = nloc; b.st[1] = nx; }
        const unsigned old = xb_add(&bar[XB_XSUB(b.x)], 1u);
        const unsigned gen = old / nloc;
        if (old + 1u == (gen + 1u) * nloc) {
            __builtin_amdgcn_fence(__ATOMIC_RELEASE, "agent");
            asm volatile("s_waitcnt vmcnt(0)" ::: "memory");
            const unsigned og = xb_add(&bar[XB_TOP], 1u);
            const unsigned tg = og / nx;
            if (og + 1u == (tg + 1u) * nx) xb_add(&bar[XB_TOPGEN], 1u);
            else XB_SPIN(xb_ld(&bar[XB_TOPGEN]) == tg, bar);
            __builtin_amdgcn_fence(__ATOMIC_ACQUIRE, "agent");
            xb_add(&bar[XB_XGEN(b.x)], 1u);
            asm volatile("s_waitcnt vmcnt(0)" ::: "memory");
        } else {
            XB_SPIN(xb_ld(&bar[XB_XGEN(b.x)]) == gen, bar);
            __builtin_amdgcn_fence(__ATOMIC_ACQUIRE, "agent");
            asm volatile("s_waitcnt vmcnt(0)" ::: "memory");
        }
    }
    __syncthreads();
}

namespace pg8 {
typedef int v8i_t __attribute__((ext_vector_type(8)));
typedef int v4i_t __attribute__((ext_vector_type(4)));
constexpr int BM = 256, BK = 64, HALF = 128, HTB = HALF * BK * 2, STAGE_BYTES = 8 * HTB, NXCD = 8, WGM = 8;
__host__ __device__ __forceinline__ int lds_byte(int r, int c) { const int st = (r >> 4) * 2 + (c >> 5), rr = r & 15, cc = c & 31, ob = rr * 64 + cc * 2; return st * 1024 + (ob ^ (((ob >> 9) & 1) << 5)); }
__host__ __device__ __forceinline__ void stage_rc(int b, int& R, int& C) { const int st = b / 1024, sb = b % 1024, swz = sb ^ (((sb >> 9) & 1) << 5); R = (st >> 1) * 16 + swz / 64; C = (st & 1) * 32 + (swz % 64) / 2; }
__host__ __device__ __forceinline__ int perm32(int rho) { const int n = rho >> 4, i = rho & 15; return 8 * (i >> 2) + 4 * n + (i & 3); }

struct Unit { const char* pa; const char* pb; int pm, pn, e, nrows, ti, slot; };

struct StaticOrder {
    static constexpr bool GATHER = false;
    const char* A; const char* Bt; int lda, K; int nM, nN, nwg, G, c;
    __device__ __forceinline__ void init(const bf16* A_, int lda_, const bf16* Bt_, int K_, int M, int N, int G_, int c_) { A = (const char*)A_; Bt = (const char*)Bt_; lda = lda_ * 2; K = K_ * 2; nM = M / BM; nN = N / BM; nwg = nM * nN; G = G_; c = c_; }
    __device__ __forceinline__ void init_bytes(const void* A_, int ldab, const void* Bt_, int Kb, int M, int N, int G_, int c_) { A = (const char*)A_; Bt = (const char*)Bt_; lda = ldab; K = Kb; nM = M / BM; nN = N / BM; nwg = nM * nN; G = G_; c = c_; }
    __device__ __forceinline__ bool next(int i, Unit& u) const {
        const long L = (long)i * G + c; if (L >= nwg) return false;
        int wgid = (int)L; { const int q = nwg / NXCD, r = nwg % NXCD, xcd = wgid % NXCD, off = wgid / NXCD; wgid = (xcd < r ? xcd * (q + 1) : r * (q + 1) + (xcd - r) * q) + off; }
        const int nig = WGM * nN, gid = wgid / nig, fm = gid * WGM, gsz = (nM - fm) < WGM ? (nM - fm) : WGM;
        u.pm = fm + ((wgid % nig) % gsz); u.pn = (wgid % nig) / gsz; u.e = 0; u.nrows = 256; u.ti = u.pm; u.slot = 0;
        u.pa = A + (size_t)u.pm * BM * lda; u.pb = Bt + (size_t)u.pn * BM * K; return true;
    }
    __device__ __forceinline__ unsigned arow(const Unit&, int R) const { return (unsigned)R; }
};

template <class Epi, class Sched, bool FP8 = false>
__device__ __forceinline__ void gemm_phase(LAS unsigned char* lds, const int wid, const int Kb, const int ldab, const Sched& S, const Epi& E) {
    const int lane = lane_now(), tid = (wid << 6) | lane, wr = wid >> 2, wc = wid & 3, fr = lane & 15, fq = lane >> 4;
    int sc7f = 0x7f7f7f7f; if (FP8) asm volatile("" : "+v"(sc7f));
    int nt = Kb / 128; asm volatile("" : "+s"(nt));
    unsigned voffB[1]; const size_t row64B = (size_t)64 * Kb;
    { int R0, C0; stage_rc(tid * 16, R0, C0); const int Rb = Epi::PERM ? ((R0 & ~31) + perm32(R0 & 31)) : R0; voffB[0] = (unsigned)(Rb * Kb + C0 * 2); }
    const size_t kstep = (size_t)(BK * 2);
    const size_t hstepB = (size_t)HALF * Kb;
    const unsigned ldsw = (unsigned)wid * 1024u;
    const int aoff = lds_byte(wr * 64 + fr, fq * 8), boff = lds_byte(wc * 32 + fr, fq * 8);
#define PG8_SA(b, h) (((b) * 2 + (h)) * HTB)
#define PG8_SB(b, h) ((4 + (b) * 2 + (h)) * HTB)
#define PG8_STAGE(bufoff, gbase, v0, v1) do { const char* gb_ = (const char*)(gbase); const unsigned l0_ = (unsigned)(unsigned long)lds + (unsigned)(bufoff) + ldsw, l1_ = l0_ + 8192u; unsigned keep_; \
        asm volatile("s_mov_b32 %0, m0\n\ts_mov_b32 m0, %4\n\ts_nop 0\n\tglobal_load_lds_dwordx4 %1, %3\n\ts_mov_b32 m0, %5\n\ts_nop 0\n\tglobal_load_lds_dwordx4 %2, %3\n\ts_mov_b32 m0, %0" \
                     : "=&s"(keep_) : "v"(v0), "v"(v1), "s"(gb_), "s"(l0_), "s"(l1_) : "memory"); } while (0)
#define PG8_STB(bufoff, gbase) do { const char* gb_ = (const char*)(gbase); const char* gc_ = gb_ + row64B; const unsigned l0_ = (unsigned)(unsigned long)lds + (unsigned)(bufoff) + ldsw, l1_ = l0_ + 8192u; unsigned keep_; \
        asm volatile("s_mov_b32 %0, m0\n\ts_mov_b32 m0, %4\n\ts_nop 0\n\tglobal_load_lds_dwordx4 %1, %2\n\ts_mov_b32 m0, %5\n\ts_nop 0\n\tglobal_load_lds_dwordx4 %1, %3\n\ts_mov_b32 m0, %0" \
                     : "=&s"(keep_) : "v"(voffB[0]), "s"(gb_), "s"(gc_), "s"(l0_), "s"(l1_) : "memory"); } while (0)
#define PG8_LDA(dst, b, h) do { if constexpr (FP8) { _Pragma("unroll") for (int m = 0; m < 4; ++m) { const v4i_t lo_ = *(const LAS v4i_t*)(lds + PG8_SA(b, h) + aoff + m * 2048), hi_ = *(const LAS v4i_t*)(lds + PG8_SA(b, h) + aoff + m * 2048 + 1024); dst##8[m] = __builtin_shufflevector(lo_, hi_, 0, 1, 2, 3, 4, 5, 6, 7); } } \
        else { _Pragma("unroll") for (int m = 0; m < 4; ++m) _Pragma("unroll") for (int k = 0; k < 2; ++k) dst[m][k] = *(const LAS bf16x8*)(lds + PG8_SA(b, h) + aoff + m * 2048 + k * 1024); } } while (0)
#define PG8_LDB(dst, b, h) do { if constexpr (FP8) { _Pragma("unroll") for (int n = 0; n < 2; ++n) { const v4i_t lo_ = *(const LAS v4i_t*)(lds + PG8_SB(b, h) + boff + n * 2048), hi_ = *(const LAS v4i_t*)(lds + PG8_SB(b, h) + boff + n * 2048 + 1024); dst##8[n] = __builtin_shufflevector(lo_, hi_, 0, 1, 2, 3, 4, 5, 6, 7); } } \
        else { _Pragma("unroll") for (int n = 0; n < 2; ++n) _Pragma("unroll") for (int k = 0; k < 2; ++k) dst[n][k] = *(const LAS bf16x8*)(lds + PG8_SB(b, h) + boff + n * 2048 + k * 1024); } } while (0)
#define PG8_MMA(ai, bj, At, Bt) do { __builtin_amdgcn_s_setprio(1); if constexpr (FP8) { _Pragma("unroll") for (int m = 0; m < 4; ++m) _Pragma("unroll") for (int n = 0; n < 2; ++n) \
        acc[ai][bj][m][n] = __builtin_amdgcn_mfma_scale_f32_16x16x128_f8f6f4(Bt##8[n], At##8[m], acc[ai][bj][m][n], 0, 0, 0, sc7f, 0, sc7f); } else { \
        _Pragma("unroll") for (int m = 0; m < 4; ++m) _Pragma("unroll") for (int n = 0; n < 2; ++n) _Pragma("unroll") for (int k = 0; k < 2; ++k) \
        acc[ai][bj][m][n] = __builtin_amdgcn_mfma_f32_16x16x32_bf16(Bt[n][k], At[m][k], acc[ai][bj][m][n], 0, 0, 0); } __builtin_amdgcn_s_setprio(0); } while (0)
#define PG8_WAIT_V(n) asm volatile("s_waitcnt vmcnt(" #n ")" ::: "memory")
#define PG8_WAIT_L(n) asm volatile("s_waitcnt lgkmcnt(" #n ")" ::: "memory")
#define PG8_BAR __builtin_amdgcn_s_barrier()
#define PG8_SCHED __builtin_amdgcn_sched_barrier(0)
#define PG8_VOFF(dst, u) do { const int t2_ = Sched::GATHER ? ((wid << 6) | lane_now()) : tid; _Pragma("unroll") for (int i = 0; i < 2; ++i) { int R_, C_; stage_rc(t2_ * 16 + i * 8192, R_, C_); \
        _Pragma("unroll") for (int h = 0; h < 2; ++h) dst[h][i] = (unsigned)(S.arow(u, h * HALF + R_) * (unsigned)ldab + (unsigned)C_ * 2u); } } while (0)
    Unit cur, nxt; int ui = 0;
    if (!S.next(0, cur)) return;
    f32x4 acc[2][2][4][2];
#pragma unroll
    for (int a = 0; a < 2; ++a)
#pragma unroll
        for (int b = 0; b < 2; ++b)
#pragma unroll
            for (int m = 0; m < 4; ++m)
#pragma unroll
                for (int n = 0; n < 2; ++n) acc[a][b][m][n] = (f32x4){0.f, 0.f, 0.f, 0.f};
    bf16x8 At[4][2], B0[2][2], B1[2][2]; v8i_t At8[4], B08[2], B18[2];
    unsigned vc[2][2];
    PG8_VOFF(vc, cur);
    const char* cA = cur.pa; const char* cB = cur.pb;
    PG8_STB(PG8_SB(0, 0), cB); PG8_STB(PG8_SB(0, 1), cB + hstepB); PG8_STAGE(PG8_SA(0, 0), cA, vc[0][0], vc[0][1]); PG8_STAGE(PG8_SA(0, 1), cA, vc[1][0], vc[1][1]);
    if (wr == 1) PG8_BAR;
    PG8_WAIT_V(2); PG8_BAR;
    PG8_STB(PG8_SB(1, 0), cB + kstep); PG8_STAGE(PG8_SA(1, 0), cA + kstep, vc[0][0], vc[0][1]); PG8_STB(PG8_SB(1, 1), cB + hstepB + kstep);
    PG8_WAIT_V(6); PG8_BAR;
    for (;;) {
        const bool has_next = S.next(ui + 1, nxt);
        const char* nA = has_next ? nxt.pa : cA; const char* nB = has_next ? nxt.pb : cB;
        asm volatile(".p2align 6");
#pragma nounroll
        for (int t = 0; t < nt; t += 2) {
            const bool last = (t == nt - 2);
            const char* a1 = cA + (size_t)(t + 1) * kstep;
            const char* a2 = last ? nA : cA + (size_t)(t + 2) * kstep; const char* b2 = last ? nB : cB + (size_t)(t + 2) * kstep;
            const char* a3 = a2 + kstep; const char* b3 = b2 + kstep;
            unsigned v2_00 = vc[0][0], v2_01 = vc[0][1], v2_10 = vc[1][0], v2_11 = vc[1][1];
            if (Sched::GATHER && last && has_next) { unsigned vn[2][2]; PG8_VOFF(vn, nxt); v2_00 = vn[0][0]; v2_01 = vn[0][1]; v2_10 = vn[1][0]; v2_11 = vn[1][1]; }
            PG8_LDB(B0, 0, 0); PG8_LDB(B1, 0, 1); PG8_SCHED; PG8_LDA(At, 0, 0); PG8_STAGE(PG8_SA(1, 1), a1, vc[1][0], vc[1][1]);
            PG8_WAIT_V(8); PG8_WAIT_L(0); PG8_BAR; PG8_MMA(0, 0, At, B0); PG8_MMA(0, 1, At, B1); PG8_BAR; PG8_SCHED;
            PG8_LDA(At, 0, 1); PG8_STB(PG8_SB(0, 0), b2); PG8_STB(PG8_SB(0, 1), b2 + hstepB); PG8_STAGE(PG8_SA(0, 0), a2, v2_00, v2_01);
            PG8_WAIT_V(8); PG8_WAIT_L(0); PG8_BAR; PG8_MMA(1, 0, At, B0); PG8_MMA(1, 1, At, B1); PG8_BAR; PG8_SCHED;
            PG8_LDB(B0, 1, 0); PG8_LDB(B1, 1, 1); PG8_SCHED; PG8_LDA(At, 1, 0); PG8_STAGE(PG8_SA(0, 1), a2, v2_10, v2_11);
            PG8_WAIT_V(8); PG8_WAIT_L(0); PG8_BAR; PG8_MMA(0, 0, At, B0); PG8_MMA(0, 1, At, B1); PG8_BAR; PG8_SCHED;
            PG8_LDA(At, 1, 1); PG8_STB(PG8_SB(1, 0), b3); PG8_STB(PG8_SB(1, 1), b3 + hstepB); PG8_STAGE(PG8_SA(1, 0), a3, v2_00, v2_01);
            PG8_WAIT_V(8); PG8_WAIT_L(0); PG8_BAR; PG8_MMA(1, 0, At, B0); PG8_MMA(1, 1, At, B1); PG8_BAR; PG8_SCHED;
        }
        if (wr == 0) PG8_BAR;
        { const int l_ = lane_now(); E(acc, cur, wr, wc, l_ & 15, l_ >> 4); }
        if (!has_next) break;
        if (!E.carry(cur)) {
#pragma unroll
        for (int a = 0; a < 2; ++a)
#pragma unroll
            for (int b = 0; b < 2; ++b)
#pragma unroll
                for (int m = 0; m < 4; ++m)
#pragma unroll
                    for (int n = 0; n < 2; ++n) acc[a][b][m][n] = (f32x4){0.f, 0.f, 0.f, 0.f};
        }
        cur = nxt; cA = nA; cB = nB; ++ui;
        if (Sched::GATHER) { PG8_VOFF(vc, cur); }
        if (wr == 1) PG8_BAR;
    }
    PG8_WAIT_V(0);
    PG8_BAR;
#undef PG8_SA
#undef PG8_SB
#undef PG8_STAGE
#undef PG8_STB
#undef PG8_LDA
#undef PG8_LDB
#undef PG8_MMA
#undef PG8_WAIT_V
#undef PG8_WAIT_L
#undef PG8_BAR
#undef PG8_SCHED
#undef PG8_VOFF
}
}

struct Frame {
    LAS unsigned char* lds;
    volatile LAS unsigned* MISC;
    gu32* ctl;
    int tid, lane, wave, G, bid, wave0;
    const float* const* in;
    GAS float* out; GAS unsigned char* ws;
};

constexpr int MI_BAR = 8;
constexpr int MI_NUNITS = 16;
constexpr int MI_NREC = 17;
constexpr int MI_LCNT = 32;
constexpr int MI_LBASE = 64;

constexpr float W8_SCALE = 64.0f, W8_INV = 1.0f / 64.0f;
__device__ __forceinline__ u32x2 pack8_f8(const float (&x)[8]) { u32x2 w; int a = 0, b = 0; a = __builtin_amdgcn_cvt_pk_fp8_f32(x[0], x[1], a, false); a = __builtin_amdgcn_cvt_pk_fp8_f32(x[2], x[3], a, true); b = __builtin_amdgcn_cvt_pk_fp8_f32(x[4], x[5], b, false); b = __builtin_amdgcn_cvt_pk_fp8_f32(x[6], x[7], b, true); w.x = (unsigned)a; w.y = (unsigned)b; return w; }
__device__ __forceinline__ u32x4 pack8(const float (&x)[8]) { u32x4 w; w.x = pk2(x[0], x[1]); w.y = pk2(x[2], x[3]); w.z = pk2(x[4], x[5]); w.w = pk2(x[6], x[7]); return w; }
#define ACC8(x, A, ai, bj, m) do { const f32x4 _a = A[ai][bj][m][0], _b = A[ai][bj][m][1]; x[0] = _a[0]; x[1] = _a[1]; x[2] = _a[2]; x[3] = _a[3]; x[4] = _b[0]; x[5] = _b[1]; x[6] = _b[2]; x[7] = _b[3]; } while (0)

struct EpiWin {
    static constexpr bool PERM = true;
    __device__ __forceinline__ bool carry(const pg8::Unit&) const { return false; }
    GAS unsigned char* ws; float asc;
    __device__ __forceinline__ void operator()(const f32x4 (&acc)[2][2][4][2], const pg8::Unit& u, int wr, int wc, int fr, int fq) const {
        bf16* const U = (bf16*)(ws + WS_U); bf16* const VTD = (bf16*)(ws + WS_VTD); bf16* const VTN = (bf16*)(ws + WS_VTN); const f32x2* const rope = (const f32x2*)(ws + WS_ROPE);
        const int pn = u.pn; const int row0 = u.pm * 256 + wr * 64 + fr; const int cw = wc * 32 + 8 * fq;
        if (pn < 4) {
#pragma unroll
            for (int ai = 0; ai < 2; ++ai)
#pragma unroll
                for (int m = 0; m < 4; ++m) { const int row = row0 + ai * 128 + m * 16; float v[8];
#pragma unroll
                    for (int h = 0; h < 2; ++h) { f32x4 e = acc[ai][1][m][h] * (-asc * LOG2E);
#pragma unroll
                        for (int q = 0; q < 4; ++q) e[q] = __builtin_amdgcn_exp2f(e[q]);
                        e = e + 1.0f;
#pragma unroll
                        for (int q = 0; q < 4; ++q) e[q] = __builtin_amdgcn_rcpf(e[q]);
                        const f32x4 o = (acc[ai][0][m][h] * asc) * e; v[4 * h] = o[0]; v[4 * h + 1] = o[1]; v[4 * h + 2] = o[2]; v[4 * h + 3] = o[3]; }
                    *(u32x4*)(U + (size_t)row * INC + 128 * pn + cw) = pack8(v); }
        } else if (pn < 8) {
            const bool latent = u.pm < 128; const float sc = ((pn < 6) ? QSCALE : 1.f) * asc;
#pragma unroll
            for (int ai = 0; ai < 2; ++ai)
#pragma unroll
                for (int m = 0; m < 4; ++m) { const int row = row0 + ai * 128 + m * 16; const int l = row & 2047; const int pos = (wc & 1) ? (l & 63) : (l >> 6);
#pragma unroll
                    for (int bj = 0; bj < 2; ++bj) { float x[8]; ACC8(x, acc, ai, bj, m);
                        if (latent) {
                            const f32x4* rp = (const f32x4*)(rope + pos * 16 + 8 * (fq & 1));
                            const f32x4 r0 = rp[0], r1 = rp[1], r2 = rp[2], r3 = rp[3];
                            const float cs[8] = {r0[0], r0[2], r1[0], r1[2], r2[0], r2[2], r3[0], r3[2]}, sn[8] = {r0[1], r0[3], r1[1], r1[3], r2[1], r2[3], r3[1], r3[3]};
#pragma unroll
                            for (int j = 0; j < 8; ++j) { const unsigned xb = __builtin_bit_cast(unsigned, x[j]); const auto sw = __builtin_amdgcn_permlane32_swap(xb, xb, false, false);
                                const float p = (fq < 2) ? -__builtin_bit_cast(float, (unsigned)sw[1]) : __builtin_bit_cast(float, (unsigned)sw[0]); x[j] = x[j] * cs[j] + p * sn[j]; }
                        }
#pragma unroll
                        for (int j = 0; j < 8; ++j) x[j] *= sc;
                        *(u32x4*)(U + (size_t)row * INC + 256 * pn + 128 * bj + cw) = pack8(x); } }
        } else if (pn == 8 || pn == 9 || pn == 14 || pn == 15) {
            const bool isd = pn < 10;
#pragma unroll
            for (int ai = 0; ai < 2; ++ai)
#pragma unroll
                for (int m = 0; m < 4; ++m) { const int row = row0 + ai * 128 + m * 16; int b, key;
                    if (row < T_LAT) { b = row >> 11; key = NCTX + (row & 2047); } else { const int rc = row - T_LAT; b = rc >> 8; key = rc & 255; }
#pragma unroll
                    for (int bj = 0; bj < 2; ++bj) { float x[8]; ACC8(x, acc, ai, bj, m);
                        bf16* dst;
                        if (isd) { const int head = (pn - 8) * 2 + bj; dst = VTD + ((size_t)((b * 4 + head) * 128 + cw)) * KEYS + key; }
                        else { const int head = (pn - 14) * 4 + bj * 2 + (wc >> 1); dst = VTN + ((size_t)((b * 8 + head) * 64 + (cw & 63))) * KEYS + key; }
#pragma unroll
                        for (int j = 0; j < 8; j += 2) { const unsigned w2 = pk2(x[j] * asc, x[j + 1] * asc);
                            dst[(size_t)j * KEYS] = (bf16)(w2 & 0xffffu); dst[(size_t)(j + 1) * KEYS] = (bf16)(w2 >> 16); } } }
        } else if (pn < 14 || DIAG_GATEPLAIN) {
            const float sc = ((pn < 12) ? QSCALE : 1.f) * asc;
#pragma unroll
            for (int ai = 0; ai < 2; ++ai)
#pragma unroll
                for (int m = 0; m < 4; ++m) { const int row = row0 + ai * 128 + m * 16;
#pragma unroll
                    for (int bj = 0; bj < 2; ++bj) { const f32x4 xa = acc[ai][bj][m][0] * sc, xb = acc[ai][bj][m][1] * sc; const float x[8] = {xa[0], xa[1], xa[2], xa[3], xb[0], xb[1], xb[2], xb[3]};
                        *(u32x4*)(U + (size_t)row * INC + 256 * pn + 128 * bj + cw) = pack8(x); } }
        } else {
#pragma unroll
            for (int ai = 0; ai < 2; ++ai)
#pragma unroll
                for (int m = 0; m < 4; ++m) { const int row = row0 + ai * 128 + m * 16;
#pragma unroll
                    for (int bj = 0; bj < 2; ++bj) { float x[8];
#pragma unroll
                        for (int h = 0; h < 2; ++h) { f32x4 e = acc[ai][bj][m][h] * (-asc * LOG2E);
#pragma unroll
                            for (int q = 0; q < 4; ++q) x[4 * h + q] = fminf(__builtin_amdgcn_exp2f(e[q]), 1.0e12f); }
                        *(u32x4*)(U + (size_t)row * INC + 256 * pn + 128 * bj + cw) = pack8(x); } }
        }
    }
};

struct EpiMB {
    static constexpr bool PERM = true;
    const bf16* U; bf16* MB;
    __device__ __forceinline__ bool carry(const pg8::Unit& u) const { return u.e < 2; }
    __device__ __forceinline__ void operator()(f32x4 (&acc)[2][2][4][2], const pg8::Unit& u, int wr, int wc, int fr, int fq) const {
        const int row0 = u.pm * 256 + wr * 64 + fr; const int cw = wc * 32 + 8 * fq; const int j = u.e;
#pragma unroll
        for (int ai = 0; ai < 2; ++ai) {
            u32x4 gw[4][2], gn[4][2];
#pragma unroll
            for (int m = 0; m < 4; ++m)
#pragma unroll
                for (int bj = 0; bj < 2; ++bj) { const int row = row0 + ai * 128 + m * 16, col = 256 * u.pn + 128 * bj + cw; const bf16* gp = U + (size_t)row * INC + C_G + 1024 * j + col;
                    gw[m][bj] = *(const u32x4*)gp; gn[m][bj] = (j < 2) ? *(const u32x4*)(gp + 1024) : (u32x4){0u, 0u, 0u, 0u}; }
#pragma unroll
            for (int m = 0; m < 4; ++m)
#pragma unroll
                for (int bj = 0; bj < 2; ++bj) { const int row = row0 + ai * 128 + m * 16, col = 256 * u.pn + 128 * bj + cw;
                    const u32x4 g4 = gw[m][bj], n4 = gn[m][bj];
                    f32x4 ga = (f32x4){bflo(g4.x), bfhi(g4.x), bflo(g4.y), bfhi(g4.y)} + 1.0f, gb = (f32x4){bflo(g4.z), bfhi(g4.z), bflo(g4.w), bfhi(g4.w)} + 1.0f;
#pragma unroll
                    for (int q = 0; q < 4; ++q) { ga[q] = __builtin_amdgcn_rcpf(ga[q]); gb[q] = __builtin_amdgcn_rcpf(gb[q]); }
                    if (j < 2) {
                        const f32x4 na = (f32x4){bflo(n4.x), bfhi(n4.x), bflo(n4.y), bfhi(n4.y)} + 1.0f, nb = (f32x4){bflo(n4.z), bfhi(n4.z), bflo(n4.w), bfhi(n4.w)} + 1.0f;
                        acc[ai][bj][m][0] = (acc[ai][bj][m][0] * ga) * na; acc[ai][bj][m][1] = (acc[ai][bj][m][1] * gb) * nb;
                    } else {
                        const f32x4 xa = acc[ai][bj][m][0] * ga, xb = acc[ai][bj][m][1] * gb; const float x[8] = {xa[0], xa[1], xa[2], xa[3], xb[0], xb[1], xb[2], xb[3]};
                        *(u32x4*)(MB + (size_t)row * DM + col) = pack8(x); } }
        }
    }
};
struct MergeOrder {
    static constexpr bool GATHER = false;
    const char* Y; const char* W; pg8::StaticOrder T;
    __device__ __forceinline__ bool next(int i, pg8::Unit& u) const {
        const int t = i / 3, j = i - 3 * t; if (!T.next(t, u)) return false;
        u.e = j; u.pa = Y + (size_t)j * (36 * MiB) + (size_t)u.pm * 256 * (DB * 2); u.pb = W + ((size_t)j * DM + (size_t)u.pn * 256) * (DB * 2); return true; }
    __device__ __forceinline__ unsigned arow(const pg8::Unit&, int R) const { return (unsigned)R; }
};

struct EpiWout {
    static constexpr bool PERM = true;
    __device__ __forceinline__ bool carry(const pg8::Unit&) const { return false; }
    const float* g1base; bf16* YG;
    __device__ __forceinline__ void operator()(const f32x4 (&acc)[2][2][4][2], const pg8::Unit& u, int wr, int wc, int fr, int fq) const {
        const int row0 = u.pm * 256 + wr * 64 + fr; const int cw = wc * 32 + 8 * fq;
        const bool latent = u.pm < 128; const int mi = latent ? (u.pm >> 3) : 16;
        const float* g1 = g1base + (size_t)mi * 6144;
        f32x4 gv[2][2];
#pragma unroll
        for (int bj = 0; bj < 2; ++bj) { const int col = 256 * u.pn + 128 * bj + cw; gv[bj][0] = *(const f32x4*)(g1 + col); gv[bj][1] = *(const f32x4*)(g1 + col + 4); }
#pragma unroll
        for (int ai = 0; ai < 2; ++ai)
#pragma unroll
            for (int m = 0; m < 4; ++m) { const int row = row0 + ai * 128 + m * 16;
#pragma unroll
                for (int bj = 0; bj < 2; ++bj) { const int col = 256 * u.pn + 128 * bj + cw; float x[8]; ACC8(x, acc, ai, bj, m);
#pragma unroll
                    for (int q = 0; q < 4; ++q) { x[q] *= gv[bj][0][q]; x[4 + q] *= gv[bj][1][q]; }
                    *(u32x4*)(YG + (size_t)row * DM + col) = pack8(x); } }
    }
};

struct EpiMoe1 {
    static constexpr bool PERM = true;
    __device__ __forceinline__ bool carry(const pg8::Unit&) const { return false; }
    unsigned char* ACT; const float* b1;
    __device__ __forceinline__ void operator()(const f32x4 (&acc)[2][2][4][2], const pg8::Unit& u, int wr, int wc, int fr, int fq) const {
        const int cw = wc * 32 + 8 * fq; const int col = 128 * u.pn + cw;
        const float* bg = b1 + (size_t)u.e * 2048 + col; const float* bl = bg + 1024;
        const f32x4 bga = *(const f32x4*)bg, bgb = *(const f32x4*)(bg + 4), bla = *(const f32x4*)bl, blb = *(const f32x4*)(bl + 4);
        const f32x4 bl1a = bla + 1.0f, bl1b = blb + 1.0f;
#pragma unroll
        for (int ai = 0; ai < 2; ++ai)
#pragma unroll
            for (int m = 0; m < 4; ++m) { const int R = ai * 128 + wr * 64 + m * 16 + fr; float g[8];
#pragma unroll
                for (int h = 0; h < 2; ++h) { f32x4 gl = acc[ai][0][m][h] * W8_INV + (h ? bgb : bga); f32x4 l1 = acc[ai][1][m][h] * W8_INV + (h ? bl1b : bl1a);
#pragma unroll
                    for (int q = 0; q < 4; ++q) { gl[q] = fminf(gl[q], 7.0f); l1[q] = __builtin_amdgcn_fmed3f(l1[q], -6.0f, 8.0f); }
                    f32x4 e = gl * (-1.702f * LOG2E);
#pragma unroll
                    for (int q = 0; q < 4; ++q) e[q] = __builtin_amdgcn_exp2f(e[q]);
                    e = e + 1.0f;
#pragma unroll
                    for (int q = 0; q < 4; ++q) e[q] = __builtin_amdgcn_rcpf(e[q]);
                    const f32x4 o = (gl * e) * l1;
                    g[4 * h] = o[0]; g[4 * h + 1] = o[1]; g[4 * h + 2] = o[2]; g[4 * h + 3] = o[3]; }
                *(u32x2*)(ACT + ((size_t)u.ti * 256 + R) * DFF + col) = pack8_f8(g); }
    }
};

struct EpiMoe2 {
    static constexpr bool PERM = true;
    __device__ __forceinline__ bool carry(const pg8::Unit&) const { return false; }
    unsigned char* YK; const float* b2; const u32x2* LIST;
    __device__ __forceinline__ void operator()(const f32x4 (&acc)[2][2][4][2], const pg8::Unit& u, int wr, int wc, int fr, int fq) const {
        const int cw = wc * 32 + 8 * fq;
        const u32x2* lst = LIST + (size_t)u.e * LIST_CAP + u.pm * 256;
        u32x2 ent[2][4];
#pragma unroll
        for (int ai = 0; ai < 2; ++ai)
#pragma unroll
            for (int m = 0; m < 4; ++m) { const int R = ai * 128 + wr * 64 + m * 16 + fr; ent[ai][m] = lst[R < u.nrows ? R : u.nrows - 1]; }
        f32x4 bv[2][2];
#pragma unroll
        for (int bj = 0; bj < 2; ++bj) { const float* bb = b2 + (size_t)u.e * DM + 256 * u.pn + 128 * bj + cw; bv[bj][0] = *(const f32x4*)bb; bv[bj][1] = *(const f32x4*)(bb + 4); }
#pragma unroll
        for (int ai = 0; ai < 2; ++ai)
#pragma unroll
            for (int m = 0; m < 4; ++m) { const int R = ai * 128 + wr * 64 + m * 16 + fr;
                if (R < u.nrows) { const unsigned tokslot = ent[ai][m].x, wbits = ent[ai][m].y; const float w = __uint_as_float(wbits);
#pragma unroll
                    for (int bj = 0; bj < 2; ++bj) { const int col = 256 * u.pn + 128 * bj + cw;
                        const f32x4 xa = (acc[ai][bj][m][0] * W8_INV + bv[bj][0]) * w, xb = (acc[ai][bj][m][1] * W8_INV + bv[bj][1]) * w;
                        const float x[8] = {xa[0], xa[1], xa[2], xa[3], xb[0], xb[1], xb[2], xb[3]};
                        *(u32x2*)(YK + (size_t)tokslot * DM + col) = pack8_f8(x); } } }
    }
};

__device__ __forceinline__ void moe_build_tiles(Frame& F, int layer, int NPN, bool gather) {
    LAS int* tile = (LAS int*)(F.lds + TILE_OFF); LAS unsigned short* idx = (LAS unsigned short*)(F.lds + IDX_OFF);
    if (F.tid == 0) F.MISC[MI_NUNITS] = 0u;
    if (F.tid < NE) F.MISC[MI_LCNT + F.tid] = __hip_atomic_load(F.ctl + CW_ECNT + (layer * 32 + F.tid) * 64, RLX_AGENT);
    __syncthreads();
    if (F.tid < 24) {
        const int gx = F.G >> 3, v = (F.bid >> 3) + gx * F.tid; const int ti = (F.bid & 7) + 8 * (v / NPN), pn = v % NPN;
        int accum = 0, fe = -1, fpm = 0, fn = 0;
        for (int e = 0; e < NE; ++e) { const int cnt = (int)F.MISC[MI_LCNT + e]; const int te = (cnt + 255) >> 8;
            if (fe < 0 && ti < accum + te) { fe = e; fpm = ti - accum; fn = cnt - 256 * fpm; if (fn > 256) fn = 256; } accum += te; }
        LAS int* t = tile + F.tid * 8; t[0] = fe < 0 ? 0 : fe; t[1] = fpm; t[2] = fn; t[3] = pn; t[4] = ti; t[5] = fe >= 0 ? 1 : 0;
        if (fe >= 0) __hip_atomic_fetch_add((LAS unsigned*)&F.MISC[MI_NUNITS], 1u, __ATOMIC_RELAXED, __HIP_MEMORY_SCOPE_WORKGROUP);
    }
    __syncthreads();
    if (gather) {
        const int nu = (int)F.MISC[MI_NUNITS];
        for (int k0 = 0; k0 < nu * 256; k0 += 12 * NTHR) {
            unsigned tk[12];
#pragma unroll
            for (int q = 0; q < 12; ++q) { const int k = k0 + q * NTHR + F.tid; tk[q] = 0u;
                if (k < nu * 256) { const int i = k >> 8, R = k & 255; const LAS int* t = tile + i * 8; const int n = t[2]; const int Rc = R < n ? R : n - 1; tk[q] = ((u32x2*)(F.ws + WS_LIST))[(size_t)t[0] * LIST_CAP + t[1] * 256 + Rc].x; } }
#pragma unroll
            for (int q = 0; q < 12; ++q) { const int k = k0 + q * NTHR + F.tid; if (k < nu * 256) idx[k] = (unsigned short)(tk[q] >> 2); }
        }
        __syncthreads();
    }
}
struct MoeSched1 {
    static constexpr bool GATHER = true;
    const char* A; const char* W; LAS const int* tile; LAS const unsigned short* idx; int nunits;
    __device__ __forceinline__ bool next(int i, pg8::Unit& u) const {
        if (i >= nunits) return false; const LAS int* t = tile + i * 8;
        u.e = __builtin_amdgcn_readfirstlane(t[0]); u.pm = __builtin_amdgcn_readfirstlane(t[1]); u.nrows = __builtin_amdgcn_readfirstlane(t[2]); u.pn = __builtin_amdgcn_readfirstlane(t[3]); u.ti = __builtin_amdgcn_readfirstlane(t[4]); u.slot = i;
        u.pa = A; u.pb = W + ((size_t)u.e * 2048 + (size_t)u.pn * 256) * DM; return true; }
    __device__ __forceinline__ unsigned arow(const pg8::Unit& u, int R) const { return (unsigned)idx[u.slot * 256 + R]; }
};
struct MoeSched2 {
    static constexpr bool GATHER = false;
    const char* A; const char* W; LAS const int* tile; int nunits;
    __device__ __forceinline__ bool next(int i, pg8::Unit& u) const {
        if (i >= nunits) return false; const LAS int* t = tile + i * 8;
        u.e = __builtin_amdgcn_readfirstlane(t[0]); u.pm = __builtin_amdgcn_readfirstlane(t[1]); u.nrows = __builtin_amdgcn_readfirstlane(t[2]); u.pn = __builtin_amdgcn_readfirstlane(t[3]); u.ti = __builtin_amdgcn_readfirstlane(t[4]); u.slot = i;
        u.pa = A + (size_t)u.ti * 256 * DFF; u.pb = W + ((size_t)u.e * 1024 + (size_t)u.pn * 256) * DFF; return true; }
    __device__ __forceinline__ unsigned arow(const pg8::Unit&, int R) const { return (unsigned)R; }
};

__device__ __forceinline__ void p0_transpose_item(const float* W, int K, int N, bf16* WT, int glu_half, LAS float* scr, int item, int lane, int ldt, int nrep) {
    const int nblk = N / 32, kb = item / nblk, nb = item % nblk, k0 = 64 * kb, n0 = 32 * nb;
    int d0 = n0;
    if (glu_half && n0 < 2 * glu_half) { const int part = n0 / glu_half, ix = n0 % glu_half; d0 = (ix >> 7) * 256 + part * 128 + (ix & 127); }
    { float wv_[32];
#pragma unroll
      for (int i = 0; i < 32; ++i) wv_[i] = W[(size_t)(k0 + 2 * i + (lane >> 5)) * N + n0 + (lane & 31)];
#pragma unroll
      for (int i = 0; i < 32; ++i) scr[(2 * i + (lane >> 5)) * 33 + (lane & 31)] = wv_[i]; }
    LDS_WAIT(); asm volatile("" ::: "memory");
    const int c = lane & 7;
#pragma unroll
    for (int j = 0; j < 4; ++j) { const int n = (lane >> 3) + 8 * j; const LAS float* s = scr + (8 * c) * 33 + n;
        u32x4 o; o.x = f2bf(s[0 * 33]) | (f2bf(s[1 * 33]) << 16); o.y = f2bf(s[2 * 33]) | (f2bf(s[3 * 33]) << 16); o.z = f2bf(s[4 * 33]) | (f2bf(s[5 * 33]) << 16); o.w = f2bf(s[6 * 33]) | (f2bf(s[7 * 33]) << 16);
        for (int rp = 0; rp < nrep; ++rp) *(u32x4*)(WT + (size_t)(d0 + n) * ldt + rp * K + k0 + 8 * c) = o; }
    LDS_WAIT(); asm volatile("" ::: "memory");
}
__device__ __forceinline__ void p0_transpose_item_f8(const float* W, int K, int N, unsigned char* WT, int glu_half, LAS float* scr, int item, int lane, int drow = 0) {
    const int nblk = N / 32, kb = item / nblk, nb = item % nblk, k0 = 64 * kb, n0 = 32 * nb;
    int d0 = n0;
    if (glu_half && n0 < 2 * glu_half) { const int part = n0 / glu_half, ix = n0 % glu_half; d0 = (ix >> 7) * 256 + part * 128 + (ix & 127); }
    { float wv_[32];
#pragma unroll
      for (int i = 0; i < 32; ++i) wv_[i] = W[(size_t)(k0 + 2 * i + (lane >> 5)) * N + n0 + (lane & 31)];
#pragma unroll
      for (int i = 0; i < 32; ++i) scr[(2 * i + (lane >> 5)) * 33 + (lane & 31)] = wv_[i]; }
    LDS_WAIT(); asm volatile("" ::: "memory");
    const int n = lane >> 1, kh = (lane & 1) * 32; const LAS float* sp = scr + kh * 33 + n;
    unsigned w[8];
#pragma unroll
    for (int q = 0; q < 8; ++q) { int a = 0; a = __builtin_amdgcn_cvt_pk_fp8_f32(sp[(4 * q) * 33] * W8_SCALE, sp[(4 * q + 1) * 33] * W8_SCALE, a, false); a = __builtin_amdgcn_cvt_pk_fp8_f32(sp[(4 * q + 2) * 33] * W8_SCALE, sp[(4 * q + 3) * 33] * W8_SCALE, a, true); w[q] = (unsigned)a; }
    unsigned char* dst = WT + (size_t)(d0 + drow + n) * K + k0 + kh;
    *(u32x4*)dst = (u32x4){w[0], w[1], w[2], w[3]}; *(u32x4*)(dst + 16) = (u32x4){w[4], w[5], w[6], w[7]};
    LDS_WAIT(); asm volatile("" ::: "memory");
}
constexpr int CV_WIN = 16 * 224, CV_WBR = 3 * 8 * 32, CV_WOUT = 16 * 32, CV_W1 = 32 * 16 * 64, CV_W2 = 32 * 16 * 32, CV_LAYER = CV_WIN + CV_WBR + CV_WOUT + CV_W1 + CV_W2;
constexpr int CV_SLOT_A = 34000, CV_SLOT_B = 14000, CV_P0_L1 = CV_LAYER - CV_SLOT_A - CV_SLOT_B;
__device__ __forceinline__ void convert_items(Frame& F, int it0, int it1, int first, int stride) {
    LAS float* scr = (LAS float*)(F.lds + F.wave * 16384);
    for (int it = it0 + first; it < it1; it += stride) {
        const int l = it / CV_LAYER; int r = it - l * CV_LAYER;
        if (r < CV_WIN) { p0_transpose_item_f8(F.in[6] + (size_t)l * DM * INC, DM, INC, (unsigned char*)(F.ws + WS_WIN) + (size_t)l * INC * DM, 512, scr, r, F.lane); continue; } r -= CV_WIN;
        if (r < CV_WBR) { const int m = l * 3 + r / 256; p0_transpose_item(F.in[17] + (size_t)m * DB * DM, DB, DM, ((bf16*)(F.ws + WS_WBR)) + (size_t)m * DM * DB, 0, scr, r % 256, F.lane, DB, 1); continue; } r -= CV_WBR;
        if (r < CV_WOUT) { p0_transpose_item(F.in[18] + (size_t)l * DM * DM, DM, DM, ((bf16*)(F.ws + WS_WOUT)) + (size_t)l * DM * DM, 0, scr, r, F.lane, DM, 1); continue; } r -= CV_WOUT;
        if (r < CV_W1) { const int m = l * 32 + r / 1024; p0_transpose_item_f8(F.in[23] + (size_t)m * DM * 2048, DM, 2048, (unsigned char*)(F.ws + WS_W1) + (size_t)m * 2048 * DM, 1024, scr, r % 1024, F.lane); continue; } r -= CV_W1;
        { const int m = l * 32 + r / 512; p0_transpose_item_f8(F.in[25] + (size_t)m * DFF * DM, DFF, DM, (unsigned char*)(F.ws + WS_W2) + (size_t)m * DM * DFF, 0, scr, r % 512, F.lane); }
    }
}
__device__ __forceinline__ float fsilu(float x) { return x * fsigmoid(x); }
__device__ __forceinline__ void p0_prologue(Frame& F) {
    if (F.bid < 192) {
        LAS float* s = (LAS float*)F.lds;
        LAS float* red = (LAS float*)(F.lds + 17 * 4096);
        for (int i = F.tid; i < 17 * 1024; i += NTHR) { const int mi = i >> 10, k = i & 1023; s[i] = fsilu(mi < 16 ? F.in[1][mi * 1024 + k] : F.in[3][k]); }
        __syncthreads();
        const int layer = F.bid / 96, cg = F.bid % 96;
        const float* W = F.in[4] + (size_t)layer * DM * 6144 + cg * 64 + F.lane;
        float acc[17];
#pragma unroll
        for (int b = 0; b < 17; ++b) acc[b] = 0.f;
#pragma unroll 4
        for (int k = F.wave * 128; k < F.wave * 128 + 128; k += 4) {
            const float w0 = W[(size_t)k * 6144], w1 = W[(size_t)(k + 1) * 6144], w2 = W[(size_t)(k + 2) * 6144], w3 = W[(size_t)(k + 3) * 6144];
#pragma unroll
            for (int b = 0; b < 17; ++b) { const f32x4 sv = *(const LAS f32x4*)(s + b * 1024 + k); acc[b] += sv[0] * w0 + sv[1] * w1 + sv[2] * w2 + sv[3] * w3; }
        }
#pragma unroll
        for (int b = 0; b < 17; ++b) red[(F.wave * 17 + b) * 64 + F.lane] = acc[b];
        __syncthreads();
        for (int i = F.tid; i < 17 * 64; i += NTHR) { const int b = i >> 6, cl = i & 63; float t = 0.f;
#pragma unroll
            for (int w = 0; w < 8; ++w) t += red[(w * 17 + b) * 64 + cl];
            ((float*)(F.ws + WS_MOD))[((size_t)layer * 17 + b) * 6144 + cg * 64 + cl] = t + F.in[5][layer * 6144 + cg * 64 + cl]; }
        __syncthreads();
    } else if (F.bid == 255) {
        for (int i = F.tid; i < 1024; i += NTHR) { const int pos = i >> 4, fi = i & 15;
            double invf = 1.0; for (int q = 0; q < fi; ++q) invf *= 0.5623413251903491;
            const float ang = (float)pos * (float)invf;
            double a = (double)ang; const double tw = 6.283185307179586476925; a -= tw * __builtin_rint(a / tw);
            const double a2 = a * a; double sn = a, cs = 1.0, ts = a, tc = 1.0;
            for (int q = 1; q < 14; ++q) { tc *= -a2 / (double)((2 * q - 1) * (2 * q)); ts *= -a2 / (double)((2 * q) * (2 * q + 1)); cs += tc; sn += ts; }
            ((f32x2*)(F.ws + WS_ROPE))[i] = (f32x2){(float)cs, (float)sn}; }
    }
    __syncthreads();
    convert_items(F, 0, F.G == 256 ? CV_LAYER + CV_P0_L1 : 2 * CV_LAYER, F.bid * NWAVES + F.wave, F.G * NWAVES);
}
__device__ __forceinline__ void row_load(const float* p, int lane, f32x4 (&v)[4]) {
#pragma unroll
    for (int j = 0; j < 4; ++j) v[j] = ((const f32x4*)p)[lane + 64 * j];
}
__device__ __forceinline__ void row_ln(f32x4 (&v)[4]) {
    float s = 0.f;
#pragma unroll
    for (int j = 0; j < 4; ++j) s += (v[j][0] + v[j][1]) + (v[j][2] + v[j][3]);
    const float mean = wave_sum(s) * (1.f / DM); float q = 0.f;
#pragma unroll
    for (int j = 0; j < 4; ++j) { v[j] = v[j] - mean; q += (v[j][0] * v[j][0] + v[j][1] * v[j][1]) + (v[j][2] * v[j][2] + v[j][3] * v[j][3]); }
    const float rstd = 1.0f / sqrtf(wave_sum(q) * (1.f / DM) + LN_EPS);
#pragma unroll
    for (int j = 0; j < 4; ++j) v[j] = v[j] * rstd;
}
__device__ __forceinline__ void row_affine(f32x4 (&v)[4], const float* g, const float* b, int lane, bool plus1) {
#pragma unroll
    for (int j = 0; j < 4; ++j) { f32x4 gv = ((const f32x4*)g)[lane + 64 * j]; const f32x4 bv = ((const f32x4*)b)[lane + 64 * j]; if (plus1) gv = gv + 1.0f; v[j] = v[j] * gv + bv; }
}
__device__ __forceinline__ void row_store_bf16(bf16* p, int lane, const f32x4 (&v)[4]) {
#pragma unroll
    for (int j = 0; j < 4; ++j) { u32x2 w; w.x = pk2(v[j][0], v[j][1]); w.y = pk2(v[j][2], v[j][3]); ((u32x2*)p)[lane + 64 * j] = w; }
}
__device__ __forceinline__ void row_store_f8(unsigned char* p, int lane, const f32x4 (&v)[4]) {
#pragma unroll
    for (int j = 0; j < 4; ++j) { int a = 0; a = __builtin_amdgcn_cvt_pk_fp8_f32(v[j][0], v[j][1], a, false); a = __builtin_amdgcn_cvt_pk_fp8_f32(v[j][2], v[j][3], a, true); ((unsigned*)p)[lane + 64 * j] = (unsigned)a; }
}
__device__ __forceinline__ void row_store_f32(float* p, int lane, const f32x4 (&v)[4]) {
#pragma unroll
    for (int j = 0; j < 4; ++j) ((f32x4*)p)[lane + 64 * j] = v[j];
}
__device__ __forceinline__ int row_mi(int row) { return row < T_LAT ? (row >> 11) : 16; }

__device__ __forceinline__ void p1_modulate0(Frame& F) {
    const int gw = F.bid * NWAVES + F.wave, NGW = F.G * NWAVES;
    for (int row = gw; row < T_ALL; row += NGW) {
        f32x4 v[4]; row_load(row < T_LAT ? F.in[0] + (size_t)row * DM : F.in[2] + (size_t)(row - T_LAT) * DM, F.lane, v);
        row_ln(v); const float* md = ((float*)(F.ws + WS_MOD)) + (size_t)row_mi(row) * 6144; row_affine(v, md + 1024, md, F.lane, true);
        row_store_f8((unsigned char*)(F.ws + WS_H8) + (size_t)row * DM, F.lane, v);
    }
}
__device__ __forceinline__ f32x4 bf4(u32x2 w) { return (f32x4){bflo(w.x), bfhi(w.x), bflo(w.y), bfhi(w.y)}; }
__device__ __forceinline__ void p8_final(Frame& F, int layer, int nrows) {
    const int gw = F.bid * NWAVES + F.wave, NGW = F.G * NWAVES;
    u32x2 xn[4]; unsigned yn[4][4];
#define P8_LOAD(r_) do { const int rl_ = (r_); _Pragma("unroll") for (int j_ = 0; j_ < 4; ++j_) xn[j_] = ((const u32x2*)(((bf16*)(F.ws + WS_X)) + (size_t)rl_ * DM))[F.lane + 64 * j_]; \
        _Pragma("unroll") for (int j_ = 0; j_ < 4; ++j_) _Pragma("unroll") for (int k_ = 0; k_ < 4; ++k_) yn[j_][k_] = ((const unsigned*)(F.ws + WS_YK + ((size_t)rl_ * 4 + k_) * DM))[F.lane + 64 * j_]; } while (0)
    if (gw < nrows) P8_LOAD(gw);
    for (int row = gw; row < nrows; row += NGW) {
        f32x4 v[4]; unsigned yc[4][4];
#pragma unroll
        for (int j = 0; j < 4; ++j) { v[j] = bf4(xn[j]);
#pragma unroll
            for (int k = 0; k < 4; ++k) yc[j][k] = yn[j][k]; }
        if (row + NGW < nrows) P8_LOAD(row + NGW);
        const float* md = ((float*)(F.ws + WS_MOD)) + ((size_t)layer * 17 + row_mi(row)) * 6144;
#pragma unroll
        for (int j = 0; j < 4; ++j) { f32x4 y = (f32x4){0.f, 0.f, 0.f, 0.f};
#pragma unroll
            for (int k = 0; k < 4; ++k) { const int w = (int)yc[j][k]; const f32x2 lo = __builtin_amdgcn_cvt_pk_f32_fp8(w, false), hi2 = __builtin_amdgcn_cvt_pk_f32_fp8(w, true); y[0] += lo[0]; y[1] += lo[1]; y[2] += hi2[0]; y[3] += hi2[1]; }
            const f32x4 g2 = ((const f32x4*)(md + 5120))[F.lane + 64 * j]; if (ABL & 1) y = y * 0.f; v[j] = v[j] * ALPHA + g2 * y; }
        row_ln(v); row_affine(v, F.in[27] + layer * DM, F.in[28] + layer * DM, F.lane, false);
        if (layer == DEPTH - 1) { row_store_f32((float*)(F.out + (size_t)row * DM), F.lane, v); }
        else { row_store_bf16(((bf16*)(F.ws + WS_X)) + (size_t)row * DM, F.lane, v); row_ln(v); const float* mn = ((float*)(F.ws + WS_MOD)) + ((size_t)(layer + 1) * 17 + row_mi(row)) * 6144; row_affine(v, mn + 1024, mn, F.lane, true); row_store_f8((unsigned char*)(F.ws + WS_H8) + (size_t)row * DM, F.lane, v); }
    }
#undef P8_LOAD
}

constexpr int TS_STRIDE = 1028;
constexpr int P5_TS = 0, P5_PART = 16 * TS_STRIDE * 4, P5_LOG = P5_PART + 8 * 16 * 32 * 4, P5_REC = P5_LOG + 16 * 32 * 4;
__device__ __forceinline__ void p5_ln1_router(Frame& F, int layer, int nrows) {
    LAS float* TS = (LAS float*)(F.lds + P5_TS); LAS float* PART = (LAS float*)(F.lds + P5_PART); LAS float* LOG = (LAS float*)(F.lds + P5_LOG); LAS u32x4* REC = (LAS u32x4*)(F.lds + P5_REC);
    if (F.tid < 32) F.MISC[MI_LCNT + F.tid] = 0u;
    if (F.tid == 0) F.MISC[MI_NREC] = 0u;
    __syncthreads();
    const float* wr_ = F.in[21] + (size_t)layer * DM * NE; const float* br_ = F.in[22] + layer * NE;
    const int ngroups = nrows / 16;
    float wb0[32], wb1[32];
    { const float* bp = wr_ + (size_t)(F.wave * 128 + (F.lane >> 4)) * NE + (F.lane & 15);
#pragma unroll
      for (int s = 0; s < 32; ++s) { wb0[s] = bp[(size_t)(4 * s) * NE]; wb1[s] = bp[(size_t)(4 * s) * NE + 16]; } }
    const float brv = br_[F.tid & 31];
    f32x4 vpre[2][4]; u32x2 ypre[2][4], xraw[2][4];
#define P5_BAR() asm volatile("s_waitcnt lgkmcnt(0)\n\ts_barrier" ::: "memory")
#define P5_LOAD(g_) do { _Pragma("unroll") for (int rr = 0; rr < 2; ++rr) { const int row_ = (g_) * 16 + F.wave * 2 + rr; \
            if (layer == 0) row_load(row_ < T_LAT ? F.in[0] + (size_t)row_ * DM : F.in[2] + (size_t)(row_ - T_LAT) * DM, F.lane, vpre[rr]); \
            else { _Pragma("unroll") for (int j = 0; j < 4; ++j) xraw[rr][j] = ((const u32x2*)(((bf16*)(F.ws + WS_X)) + (size_t)row_ * DM))[F.lane + 64 * j]; } \
            _Pragma("unroll") for (int j = 0; j < 4; ++j) ypre[rr][j] = ((const u32x2*)(((bf16*)(F.ws + WS_MV)) + (size_t)row_ * DM))[F.lane + 64 * j]; } } while (0)
    if (F.bid < ngroups) P5_LOAD(F.bid);
    for (int g = F.bid; g < ngroups; g += F.G) {
        f32x4 vcur[2][4];
#pragma unroll
        for (int rr = 0; rr < 2; ++rr)
#pragma unroll
            for (int j = 0; j < 4; ++j) { const f32x4 xin = layer == 0 ? vpre[rr][j] : bf4(xraw[rr][j]); vcur[rr][j] = xin * ALPHA + bf4(ypre[rr][j]); }
        if (g + F.G < ngroups) P5_LOAD(g + F.G);
#pragma unroll
        for (int rr = 0; rr < 2; ++rr) { const int rl = F.wave * 2 + rr; const int row = g * 16 + rl;
            f32x4 v[4];
#pragma unroll
            for (int j = 0; j < 4; ++j) v[j] = vcur[rr][j];
            row_ln(v); row_affine(v, F.in[19] + layer * DM, F.in[20] + layer * DM, F.lane, false);
            row_store_bf16(((bf16*)(F.ws + WS_X)) + (size_t)row * DM, F.lane, v);
            row_ln(v); const float* md = ((float*)(F.ws + WS_MOD)) + ((size_t)layer * 17 + row_mi(row)) * 6144; row_affine(v, md + 4096, md + 3072, F.lane, true);
#pragma unroll
            for (int j = 0; j < 4; ++j) { int a = 0; a = __builtin_amdgcn_cvt_pk_fp8_f32(v[j][0], v[j][1], a, false); a = __builtin_amdgcn_cvt_pk_fp8_f32(v[j][2], v[j][3], a, true); ((unsigned*)(F.ws + WS_H8 + (size_t)row * DM))[F.lane + 64 * j] = (unsigned)a; }
#pragma unroll
            for (int j = 0; j < 4; ++j) *(LAS f32x4*)(TS + rl * TS_STRIDE + 4 * (F.lane + 64 * j)) = v[j];
        }
        P5_BAR();
        { f32x4 a0 = (f32x4){0.f, 0.f, 0.f, 0.f}, a1 = a0; const int r16 = F.lane & 15, kq = F.lane >> 4;
            const LAS float* ap = TS + r16 * TS_STRIDE + F.wave * 128 + kq;
#pragma unroll
            for (int s = 0; s < 32; ++s) { const float a = ap[4 * s];
                a0 = __builtin_amdgcn_mfma_f32_16x16x4f32(a, wb0[s], a0, 0, 0, 0); a1 = __builtin_amdgcn_mfma_f32_16x16x4f32(a, wb1[s], a1, 0, 0, 0); }
#pragma unroll
            for (int i = 0; i < 4; ++i) { PART[(F.wave * 16 + 4 * kq + i) * 32 + r16] = a0[i]; PART[(F.wave * 16 + 4 * kq + i) * 32 + 16 + r16] = a1[i]; } }
        P5_BAR();
        { const int rl = F.tid >> 5, e = F.tid & 31; float t = brv;
#pragma unroll
            for (int w = 0; w < 8; ++w) t += PART[(w * 16 + rl) * 32 + e];
            float lv[4]; int li[4];
#pragma unroll
            for (int k = 0; k < 4; ++k) { float bv = t; int bi = e;
#define P5_STEP(C) { const float ov = dppx<C>(bv); const int oi = dppxi<C>(bi); const bool take = (ov > bv) || (ov == bv && oi < bi); bv = take ? ov : bv; bi = take ? oi : bi; }
                P5_STEP(0xB1) P5_STEP(0x4E) P5_STEP(0x141) P5_STEP(0x140)
#undef P5_STEP
                { const unsigned vb_ = __builtin_bit_cast(unsigned, bv); const auto rv = __builtin_amdgcn_permlane16_swap(vb_, vb_, false, false); const auto ri_ = __builtin_amdgcn_permlane16_swap((unsigned)bi, (unsigned)bi, false, false);
                  const float va = __builtin_bit_cast(float, (unsigned)rv[0]), vb2 = __builtin_bit_cast(float, (unsigned)rv[1]); const int ia = (int)ri_[0], ib = (int)ri_[1];
                  const bool take = (vb2 > va) || (vb2 == va && ib < ia); bv = take ? vb2 : va; bi = take ? ib : ia; }
                lv[k] = bv; li[k] = bi; if (e == bi) t = -INFINITY; }
            if (e < 4) { const int row = g * 16 + rl;
                const float e1 = __expf(lv[1] - lv[0]), e2 = __expf(lv[2] - lv[0]), e3 = __expf(lv[3] - lv[0]); const float inv = 1.0f / (1.0f + e1 + e2 + e3);
                const float wk = (e == 0 ? 1.0f : (e == 1 ? e1 : (e == 2 ? e2 : e3))) * inv; const int ek = e == 0 ? li[0] : (e == 1 ? li[1] : (e == 2 ? li[2] : li[3]));
                const unsigned p = __hip_atomic_fetch_add((LAS unsigned*)&F.MISC[MI_LCNT + ek], 1u, __ATOMIC_RELAXED, __HIP_MEMORY_SCOPE_WORKGROUP);
                const unsigned ri = __hip_atomic_fetch_add((LAS unsigned*)&F.MISC[MI_NREC], 1u, __ATOMIC_RELAXED, __HIP_MEMORY_SCOPE_WORKGROUP);
                REC[ri] = (u32x4){(unsigned)ek, p, (unsigned)(row * 4 + e), __builtin_bit_cast(unsigned, wk)}; } }
        P5_BAR();
    }
#undef P5_LOAD
#undef P5_BAR
    if (F.tid < 32) { const unsigned n = F.MISC[MI_LCNT + F.tid]; unsigned base = 0u; if (n) base = __hip_atomic_fetch_add(F.ctl + CW_ECNT + (layer * 32 + F.tid) * 64, n, RLX_AGENT); F.MISC[MI_LBASE + F.tid] = base; }
    __syncthreads();
    { const int nrec = (int)F.MISC[MI_NREC];
      for (int i = F.tid; i < nrec; i += NTHR) { const u32x4 r = REC[i]; ((u32x2*)(F.ws + WS_LIST))[(size_t)r.x * LIST_CAP + F.MISC[MI_LBASE + r.x] + r.y] = (u32x2){r.z, r.w}; } }
    __syncthreads();
}

constexpr int CV_T = 32, CV_ROWS = CV_T + 30, CV_GIN = 65536;
__device__ __forceinline__ void conv_units(Frame& F, int layer, int ntot) {
    LAS unsigned short* gin = (LAS unsigned short*)(F.lds + CV_GIN);
    LAS float* cout = (LAS float*)F.lds;
    const int c = F.tid;
    float w[CONVK];
#pragma unroll
    for (int j = 0; j < CONVK; ++j) w[j] = F.in[7][(size_t)layer * CONVK * DB + j * DB + c];
    f32x2 wp[CONVK + 1];
#pragma unroll
    for (int j = 0; j <= CONVK; ++j) wp[j] = (f32x2){j < CONVK ? w[j] : 0.f, j >= 1 ? w[j - 1] : 0.f};
    const float bias = F.in[8][layer * DB + c];
    const f32x4 g0 = ((const f32x4*)(F.in[9] + layer * DB))[F.lane], g1 = ((const f32x4*)(F.in[9] + layer * DB))[F.lane + 64];
    const f32x4 b0 = ((const f32x4*)(F.in[10] + layer * DB))[F.lane], b1 = ((const f32x4*)(F.in[10] + layer * DB))[F.lane + 64];
    u32x4 v[8];
#define CV_DECODE(u_, base_, len_, t0_) const int s_ = (u_) < 1024 ? ((u_) >> 6) : 16 + (((u_) - 1024) >> 3), tt_ = (u_) < 1024 ? ((u_) & 63) : (((u_) - 1024) & 7); \
        const int base_ = s_ < 16 ? s_ * SEQ : T_LAT + (s_ - 16) * NCTX, len_ = s_ < 16 ? SEQ : NCTX, t0_ = tt_ * CV_T
#define CV_LOAD(u_) do { CV_DECODE(u_, bs_, ln_, tz_); _Pragma("unroll") for (int i = 0; i < 8; ++i) { const int p = F.tid + NTHR * i; const int r = p >> 6, ch = p & 63; const int t = tz_ - 15 + r; \
          v[i] = (u32x4){0u, 0u, 0u, 0u}; if (p < CV_ROWS * 64 && t >= 0 && t < ln_) v[i] = *(const u32x4*)(((bf16*)(F.ws + WS_U)) + (size_t)(bs_ + t) * INC + ch * 8); } } while (0)
#define CV_BAR() asm volatile("s_waitcnt lgkmcnt(0)\n\ts_barrier" ::: "memory")
    const bool bal = (F.G == 256 && ntot == 1152);
    auto unit_at = [&](const int k) __attribute__((always_inline)) -> int {
        if (!bal) { const int u_ = F.bid + F.G * k; return u_ < ntot ? u_ : -1; }
        if (k < 4) return F.bid + 256 * k;
        const int m8 = F.bid & 7; return (k == 4 && m8 >= 2 && m8 <= 5) ? 1024 + (m8 - 2) * 32 + (F.bid >> 3) : -1; };
    { const int u0 = unit_at(0); if (u0 >= 0) CV_LOAD(u0); }
    __syncthreads();
    for (int k = 0; ; ++k) {
        const int u = unit_at(k); if (u < 0) break;
        CV_DECODE(u, base, len, t0); (void)len;
#pragma unroll
        for (int i = 0; i < 8; ++i) { const int p = F.tid + NTHR * i; if (p < CV_ROWS * 64) *(LAS u32x4*)(gin + (p >> 6) * 512 + (p & 63) * 8) = v[i]; }
        { const int un = unit_at(k + 1); if (un >= 0) CV_LOAD(un); }
        CV_BAR();
#pragma unroll 1
        for (int g = 0; g < CV_T / 16; ++g) {
            f32x2 a2[8];
#pragma unroll
            for (int m = 0; m < 8; ++m) a2[m] = (f32x2){bias, bias};
#pragma unroll
            for (int r = 0; r < 46; ++r) { const float x = bf2f(gin[(16 * g + r) * 512 + c]); const f32x2 xx = (f32x2){x, x};
#pragma unroll
                for (int m = 0; m < 8; ++m) { const int j = r - 2 * m; if (j >= 0 && j <= CONVK) a2[m] = __builtin_elementwise_fma(wp[j], xx, a2[m]); } }
#pragma unroll
            for (int m = 0; m < 8; ++m) { cout[(16 * g + 2 * m) * 512 + c] = a2[m][0]; cout[(16 * g + 2 * m + 1) * 512 + c] = a2[m][1]; }
        }
        CV_BAR();
#pragma unroll 2
        for (int k = 0; k < CV_T / 8; ++k) { const int tk = F.wave * (CV_T / 8) + k;
            f32x4 v0 = *(const LAS f32x4*)(cout + tk * 512 + 4 * F.lane), v1 = *(const LAS f32x4*)(cout + tk * 512 + 256 + 4 * F.lane);
            float sm = (v0[0] + v0[1]) + (v0[2] + v0[3]) + (v1[0] + v1[1]) + (v1[2] + v1[3]);
            const float mean = wave_sum(sm) * (1.f / DB); v0 = v0 - mean; v1 = v1 - mean;
            float q = (v0[0] * v0[0] + v0[1] * v0[1]) + (v0[2] * v0[2] + v0[3] * v0[3]) + (v1[0] * v1[0] + v1[1] * v1[1]) + (v1[2] * v1[2] + v1[3] * v1[3]);
            const float rstd = 1.0f / sqrtf(wave_sum(q) * (1.f / DB) + LN_EPS);
            v0 = v0 * rstd * g0 + b0; v1 = v1 * rstd * g1 + b1;
            u32x2 o0, o1; o0.x = pk2(fsilu(v0[0]), fsilu(v0[1])); o0.y = pk2(fsilu(v0[2]), fsilu(v0[3]));
            o1.x = pk2(fsilu(v1[0]), fsilu(v1[1])); o1.y = pk2(fsilu(v1[2]), fsilu(v1[3]));
            bf16* dst = ((bf16*)(F.ws + WS_YA)) + (size_t)(base + t0 + tk) * DB; ((u32x2*)dst)[F.lane] = o0; ((u32x2*)dst)[F.lane + 64] = o1; }
    }
#undef CV_DECODE
#undef CV_LOAD
#undef CV_BAR
}

constexpr int ATT_KROW = 144, ATT_VROW = 144;
constexpr int ATT_KB = 64 * ATT_KROW, ATT_VB = 128 * ATT_VROW, ATT_BUF = ATT_KB + ATT_VB;
constexpr int ATT_RPB = 2 * ATT_BUF;
__device__ __forceinline__ float sum16(const f32x16& p) {
    const f32x8 a = __builtin_shufflevector(p, p, 0, 1, 2, 3, 4, 5, 6, 7) + __builtin_shufflevector(p, p, 8, 9, 10, 11, 12, 13, 14, 15);
    const f32x4 b = __builtin_shufflevector(a, a, 0, 1, 2, 3) + __builtin_shufflevector(a, a, 4, 5, 6, 7);
    return (b[0] + b[2]) + (b[1] + b[3]);
}
__device__ __forceinline__ int crow(int r, int hi) { return (r & 3) + 8 * (r >> 2) + 4 * hi; }

template <int DV, bool NAT>
__device__ __forceinline__ void attn_pass(Frame& F, const bf16* VT  , int kcol, int nA, int rowA0, int keyA0, int nB, int rowB0, int keyB0,
                                          const bf16x8 (&qf)[4], f32x16 (&o)[DV / 32], float& m_run, float& l_run,
                                          int my_r, int kr0, int qc, int wrow0 = 0, int w0 = 0) {
    const int tid = F.tid, lane = F.lane, q32 = lane & 31, hi = lane >> 5;
    const int nT = nA + nB;
    const int krow = tid >> 3, kch = tid & 7;
    u32x4 kreg, vreg[DV / 64], kreg1, vreg1[DV / 64];
#define ATT_LOAD2(t, KR, VR) do { const int t_ = (t); const int r0_ = t_ < nA ? rowA0 + 64 * t_ : rowB0 + 64 * (t_ - nA); const int k0_ = t_ < nA ? keyA0 + 64 * t_ : keyB0 + 64 * (t_ - nA); \
        KR = *(const u32x4*)(((bf16*)(F.ws + WS_U)) + (size_t)(r0_ + krow) * INC + kcol + kch * 8); \
        _Pragma("unroll") for (int i_ = 0; i_ < DV / 64; ++i_) { const int p_ = tid + NTHR * i_; VR[i_] = *(const u32x4*)(VT + (size_t)(p_ >> 3) * KEYS + k0_ + (p_ & 7) * 8); } } while (0)
#define ATT_STORE2(b, KR, VR) do { LAS unsigned char* kb_ = F.lds + (b) * ATT_BUF; *(LAS u32x4*)(kb_ + krow * ATT_KROW + kch * 16) = KR; \
        _Pragma("unroll") for (int i_ = 0; i_ < DV / 64; ++i_) { const int p_ = tid + NTHR * i_; LAS unsigned char* d_ = kb_ + ATT_KB + (p_ >> 3) * ATT_VROW + (p_ & 7) * 16; \
            *(LAS u32x4*)d_ = VR[i_]; } } while (0)
#define ATT_LOAD(t) ATT_LOAD2(t, kreg, vreg)
#define ATT_STORE(b) ATT_STORE2(b, kreg, vreg)
#define ATT_LBAR() asm volatile("s_waitcnt lgkmcnt(0)\n\ts_barrier" ::: "memory")
    ATT_LBAR();
    ATT_LOAD(0); if (NAT && nT > 1) ATT_LOAD2(1, kreg1, vreg1); ATT_STORE(0);
    ATT_LBAR();
    const int rs_my = NAT ? (my_r < 4 ? 0 : (my_r > 28 ? 24 : my_r - 4)) : 0;
    const int cs_my = NAT ? (qc < 8 ? 0 : (qc > 56 ? 48 : qc - 8)) : 0;
    const int rs_wlo = NAT ? (wrow0 < 4 ? 0 : (wrow0 > 28 ? 24 : wrow0 - 4)) : 0, rs_whi = NAT ? (wrow0 + 1 < 4 ? 0 : (wrow0 + 1 > 28 ? 24 : wrow0 + 1 - 4)) : 0;
    const int sig32 = (q32 & ~12) | ((q32 & 4) << 1) | ((q32 & 8) >> 1);
    auto tile = [&](const int t) __attribute__((always_inline)) {
        if (NAT && t < nA) {
          const int kr = kr0 + t;
          if (kr >= rs_wlo && kr < rs_whi + 8) {
            const LAS unsigned char* kb = F.lds + (t & 1) * ATT_BUF; const LAS unsigned char* vb = kb + ATT_KB;
            f32x16 p0;
#pragma unroll
            for (int i = 0; i < 16; ++i) p0[i] = 0.f;
            {   const unsigned ka = (unsigned)(unsigned long)kb + (unsigned)((w0 + sig32) * ATT_KROW + hi * 16);
                bf16x8 kf[4];
#define ATT_DSR(dst, addr, off) asm volatile("ds_read_b128 %0, %1 offset:%2" : "=v"(dst) : "v"(addr), "i"(off))
                ATT_DSR(kf[0], ka, 0); ATT_DSR(kf[1], ka, 32); ATT_DSR(kf[2], ka, 64); ATT_DSR(kf[3], ka, 96);
                asm volatile("s_waitcnt lgkmcnt(0)" : "+v"(kf[0]), "+v"(kf[1]), "+v"(kf[2]), "+v"(kf[3]));
#pragma unroll
                for (int d0 = 0; d0 < 4; ++d0) p0 = __builtin_amdgcn_mfma_f32_32x32x16_bf16(kf[d0], qf[d0], p0, 0, 0, 0);
#undef ATT_DSR
            }
            {   const bool rowok = (kr >= rs_my) && (kr < rs_my + 8);
                const LAS float* rpb = (const LAS float*)(F.lds + ATT_RPB) + (rowok ? kr - my_r + 7 : 7) * 31 + 15 - qc;
#pragma unroll
                for (int r = 0; r < 16; ++r) { const int kc = w0 + (r & 7) + 8 * hi + 16 * (r >> 3);
                    const bool v0 = rowok && ((unsigned)(kc - cs_my) < 16u);
                    const float bb0 = rpb[kc];
                    p0[r] = v0 ? p0[r] + bb0 : -INFINITY; }
            }
            float tm = p0[0];
#pragma unroll
            for (int r = 1; r < 16; ++r) tm = fmaxf(tm, p0[r]);
            if (__builtin_expect(__any(tm - m_run > 8.0f), 0)) { tm = fmaxf(tm, sx(tm, 32)) - m_run; const float dl = fmaxf(tm, 0.f);     m_run += dl; const float alpha = __builtin_amdgcn_exp2f(-dl); l_run *= alpha;
#pragma unroll
                for (int d = 0; d < DV / 32; ++d)
#pragma unroll
                    for (int r = 0; r < 16; ++r) o[d][r] *= alpha; }
            {   constexpr int ND = DV / 32;
                const unsigned va = (unsigned)(unsigned long)vb + (unsigned)(q32 * ATT_VROW + 16 * hi + 2 * w0);
                bf16x8 vA[2 * ND];
#define ATT_DSR(dst, addr, off) asm volatile("ds_read_b128 %0, %1 offset:%2" : "=v"(dst) : "v"(addr), "i"(off))
#pragma unroll
                for (int d = 0; d < ND; ++d) { ATT_DSR(vA[d], va, d * 32 * ATT_VROW); ATT_DSR(vA[ND + d], va, d * 32 * ATT_VROW + 32); }
#undef ATT_DSR
                float ls = 0.f;
#pragma unroll
                for (int r = 0; r < 16; ++r) p0[r] = __builtin_amdgcn_exp2f(p0[r] - m_run);
                ls += sum16(p0);
                l_run += ls;
                u32x4 pw[2];
#pragma unroll
                for (int q = 0; q < 2; ++q) { const int s8 = 8 * q; pw[q].x = pk2(p0[s8 + 0], p0[s8 + 1]); pw[q].y = pk2(p0[s8 + 2], p0[s8 + 3]); pw[q].z = pk2(p0[s8 + 4], p0[s8 + 5]); pw[q].w = pk2(p0[s8 + 6], p0[s8 + 7]); }
                if constexpr (ND == 2) asm volatile("s_waitcnt lgkmcnt(0)" : "+v"(vA[0]), "+v"(vA[1]), "+v"(vA[2]), "+v"(vA[3]));
#pragma unroll
                for (int q = 0; q < 2; ++q)
#pragma unroll
                    for (int d = 0; d < ND; ++d) o[d] = __builtin_amdgcn_mfma_f32_32x32x16_bf16(vA[q * ND + d], __builtin_bit_cast(bf16x8, pw[q]), o[d], 0, 0, 0);
            }
          }
        } else {
            const LAS unsigned char* kb = F.lds + (t & 1) * ATT_BUF; const LAS unsigned char* vb = kb + ATT_KB;
            f32x16 p0, p1;
#pragma unroll
            for (int i = 0; i < 16; ++i) { p0[i] = 0.f; p1[i] = 0.f; }
            {
                const unsigned ka = (unsigned)(unsigned long)kb + (unsigned)(sig32 * ATT_KROW + hi * 16);
                bf16x8 kf[8];
#define ATT_DSR(dst, addr, off) asm volatile("ds_read_b128 %0, %1 offset:%2" : "=v"(dst) : "v"(addr), "i"(off))
                ATT_DSR(kf[0], ka, 0); ATT_DSR(kf[1], ka, 32 * ATT_KROW); ATT_DSR(kf[2], ka, 32); ATT_DSR(kf[3], ka, 32 * ATT_KROW + 32);
                ATT_DSR(kf[4], ka, 64); ATT_DSR(kf[5], ka, 32 * ATT_KROW + 64); ATT_DSR(kf[6], ka, 96); ATT_DSR(kf[7], ka, 32 * ATT_KROW + 96);
                asm volatile("s_waitcnt lgkmcnt(0)" : "+v"(kf[0]), "+v"(kf[1]), "+v"(kf[2]), "+v"(kf[3]), "+v"(kf[4]), "+v"(kf[5]), "+v"(kf[6]), "+v"(kf[7]));
#pragma unroll
                for (int d0 = 0; d0 < 4; ++d0) {
                    p0 = __builtin_amdgcn_mfma_f32_32x32x16_bf16(kf[2 * d0], qf[d0], p0, 0, 0, 0);
                    p1 = __builtin_amdgcn_mfma_f32_32x32x16_bf16(kf[2 * d0 + 1], qf[d0], p1, 0, 0, 0);
                }
            }
            float tm = fmaxf(p0[0], p1[0]);
#pragma unroll
            for (int r = 1; r < 16; ++r) tm = fmaxf(tm, fmaxf(p0[r], p1[r]));
            if (__builtin_expect(__any(tm - m_run > 8.0f), 0)) { tm = fmaxf(tm, sx(tm, 32)) - m_run; const float dl = fmaxf(tm, 0.f); m_run += dl; const float alpha = __builtin_amdgcn_exp2f(-dl); l_run *= alpha;
#pragma unroll
                for (int d = 0; d < DV / 32; ++d)
#pragma unroll
                    for (int r = 0; r < 16; ++r) o[d][r] *= alpha; }
            const bool shifted = __any(m_run != 0.f);
            float ls = 0.f;
            if (shifted) {
#pragma unroll
                for (int r = 0; r < 16; ++r) p0[r] = __builtin_amdgcn_exp2f(p0[r] - m_run);
                ls += sum16(p0);
            } else {
#pragma unroll
                for (int r = 0; r < 16; ++r) p0[r] = __builtin_amdgcn_exp2f(p0[r]);
                ls += sum16(p0);
            }
            {   constexpr int ND = DV / 32;
                const unsigned va = (unsigned)(unsigned long)vb + (unsigned)(q32 * ATT_VROW + 16 * hi);
                bf16x8 vA[2 * ND], vB[2 * ND];
#define ATT_PIN_WAIT(v) do { if constexpr (ND == 4) asm volatile("s_waitcnt lgkmcnt(0)" : "+v"(v[0]), "+v"(v[1]), "+v"(v[2]), "+v"(v[3]), "+v"(v[4]), "+v"(v[5]), "+v"(v[6]), "+v"(v[7])); \
                                  else asm volatile("s_waitcnt lgkmcnt(0)" : "+v"(v[0]), "+v"(v[1]), "+v"(v[2]), "+v"(v[3])); } while (0)
#pragma unroll
                for (int d = 0; d < ND; ++d) { ATT_DSR(vA[d], va, d * 32 * ATT_VROW); ATT_DSR(vA[ND + d], va, d * 32 * ATT_VROW + 32); }
                u32x4 pw[4];
#pragma unroll
                for (int q = 0; q < 2; ++q) { const int s8 = 8 * q; pw[q].x = pk2(p0[s8 + 0], p0[s8 + 1]); pw[q].y = pk2(p0[s8 + 2], p0[s8 + 3]); pw[q].z = pk2(p0[s8 + 4], p0[s8 + 5]); pw[q].w = pk2(p0[s8 + 6], p0[s8 + 7]); }
                ATT_PIN_WAIT(vA);
#pragma unroll
                for (int d = 0; d < ND; ++d) { ATT_DSR(vB[d], va, d * 32 * ATT_VROW + 64); ATT_DSR(vB[ND + d], va, d * 32 * ATT_VROW + 96); }
#pragma unroll
                for (int q = 0; q < 2; ++q)
#pragma unroll
                    for (int d = 0; d < ND; ++d) o[d] = __builtin_amdgcn_mfma_f32_32x32x16_bf16(vA[q * ND + d], __builtin_bit_cast(bf16x8, pw[q]), o[d], 0, 0, 0);
                if (shifted) {
#pragma unroll
                    for (int r = 0; r < 16; ++r) p1[r] = __builtin_amdgcn_exp2f(p1[r] - m_run);
                ls += sum16(p1);
                } else {
#pragma unroll
                    for (int r = 0; r < 16; ++r) p1[r] = __builtin_amdgcn_exp2f(p1[r]);
                ls += sum16(p1);
                }
#pragma unroll
                for (int q = 0; q < 2; ++q) { const int s8 = 8 * q; pw[2 + q].x = pk2(p1[s8 + 0], p1[s8 + 1]); pw[2 + q].y = pk2(p1[s8 + 2], p1[s8 + 3]); pw[2 + q].z = pk2(p1[s8 + 4], p1[s8 + 5]); pw[2 + q].w = pk2(p1[s8 + 6], p1[s8 + 7]); }
#pragma unroll
                for (int i = 0; i < 2 * ND; ++i) { __builtin_amdgcn_sched_group_barrier(0x008, 1, 0); __builtin_amdgcn_sched_group_barrier(0x002, 40 / (2 * ND) + 1, 0); }
                l_run += ls;
                ATT_PIN_WAIT(vB);
#pragma unroll
                for (int q = 0; q < 2; ++q)
#pragma unroll
                    for (int d = 0; d < ND; ++d) o[d] = __builtin_amdgcn_mfma_f32_32x32x16_bf16(vB[q * ND + d], __builtin_bit_cast(bf16x8, pw[2 + q]), o[d], 0, 0, 0);
#undef ATT_PIN_WAIT
            }
        }
    };
    if constexpr (NAT) {
        asm volatile(".p2align 6");
        for (int t = 0; t < nT; t += 2) {
            if (t + 2 < nT) ATT_LOAD2(t + 2, kreg, vreg);
            tile(t);
            if (t + 1 < nT) ATT_STORE2(1, kreg1, vreg1);
            ATT_LBAR();
            if (t + 1 >= nT) break;
            if (t + 3 < nT) ATT_LOAD2(t + 3, kreg1, vreg1);
            tile(t + 1);
            if (t + 2 < nT) ATT_STORE2(0, kreg, vreg);
            ATT_LBAR();
        }
    } else {
    asm volatile(".p2align 6");
    for (int t = 0; t < nT; ++t) {
        const bool more = t + 1 < nT;
        if (more) ATT_LOAD(t + 1);
        tile(t);
        if (more) ATT_STORE((t + 1) & 1);
        ATT_LBAR();
    }
    }
#undef ATT_LOAD
#undef ATT_STORE
#undef ATT_LOAD2
#undef ATT_LBAR
#undef ATT_STORE2
}
__device__ __forceinline__ void load_qf(const bf16* qrow  , int hi, bf16x8 (&qf)[4]) {
#pragma unroll
    for (int d0 = 0; d0 < 4; ++d0) qf[d0] = *(const bf16x8*)(qrow + d0 * 16 + hi * 8);
}
__device__ __forceinline__ void diff_unit(Frame& F, int layer, int b, int h, int qrow0, bool lat, const float lam, const float lam_init) {
    const int lane = F.lane, q32 = lane & 31, hi = lane >> 5; const int row = qrow0 + F.wave * 32 + q32;
    const bf16* VT = ((bf16*)(F.ws + WS_VTD)) + (size_t)((b * 4 + h) * 128) * KEYS;
    const int nB = lat ? 32 : 0;
    LAS unsigned* o1s = (LAS unsigned*)(F.lds + 65536) + F.wave * 2048 + lane;
    {   f32x16 o1[4]; bf16x8 qf[4]; load_qf(((bf16*)(F.ws + WS_U)) + (size_t)row * INC + C_DQ + 128 * h, hi, qf);
        float m = 0.f, l = 0.f;
#pragma unroll
        for (int d = 0; d < 4; ++d)
#pragma unroll
            for (int r = 0; r < 16; ++r) o1[d][r] = 0.f;
        attn_pass<128, false>(F, VT, C_DK + 128 * h, 4, T_LAT + b * NCTX, 0, nB, b * SEQ, NCTX, qf, o1, m, l, 0, 0, 0);
        l += sx(l, 32); const float il = 1.0f / l;
#pragma unroll
        for (int d = 0; d < 4; ++d)
#pragma unroll
            for (int r = 0; r < 8; ++r) o1s[(d * 8 + r) * 64] = pk2(o1[d][2 * r] * il, o1[d][2 * r + 1] * il); }
    {   f32x16 o2[4]; bf16x8 qf[4]; load_qf(((bf16*)(F.ws + WS_U)) + (size_t)row * INC + C_DQ + 128 * h + 64, hi, qf);
        float m = 0.f, l = 0.f;
#pragma unroll
        for (int d = 0; d < 4; ++d)
#pragma unroll
            for (int r = 0; r < 16; ++r) o2[d][r] = 0.f;
        attn_pass<128, false>(F, VT, C_DK + 128 * h + 64, 4, T_LAT + b * NCTX, 0, nB, b * SEQ, NCTX, qf, o2, m, l, 0, 0, 0);
        l += sx(l, 32); const float il = lam / l;
        float ss = 0.f;
#pragma unroll
        for (int d = 0; d < 4; ++d)
#pragma unroll
            for (int r = 0; r < 8; ++r) { const unsigned ow = o1s[(d * 8 + r) * 64]; const float a0 = bflo(ow) - il * o2[d][2 * r], a1 = bfhi(ow) - il * o2[d][2 * r + 1]; o2[d][2 * r] = a0; o2[d][2 * r + 1] = a1; ss += a0 * a0 + a1 * a1; }
        ss += sx(ss, 32);
        const float rn = (1.0f / sqrtf(ss * (1.0f / 128.0f) + LN_EPS)) * (1.0f - lam_init);
        const float* sg = F.in[15] + layer * 128;
        bf16* dst = ((bf16*)(F.ws + WS_YB)) + (size_t)row * DB + 128 * h;
#pragma unroll
        for (int d = 0; d < 4; ++d)
#pragma unroll
            for (int rp = 0; rp < 2; ++rp) { unsigned wx[2], wy[2];
#pragma unroll
                for (int k = 0; k < 2; ++k) { const int r4 = 2 * rp + k; const int dv = 32 * d + 8 * r4 + 4 * hi; const f32x4 g = *(const f32x4*)(sg + dv);
                    wx[k] = pk2(o2[d][4 * r4] * rn * g[0], o2[d][4 * r4 + 1] * rn * g[1]); wy[k] = pk2(o2[d][4 * r4 + 2] * rn * g[2], o2[d][4 * r4 + 3] * rn * g[3]); }
                swap32(wx[0], wx[1]); swap32(wy[0], wy[1]);
                *(u32x4*)(dst + 32 * d + 16 * rp + 8 * hi) = (u32x4){wx[0], wy[0], wx[1], wy[1]}; } }
}
__device__ __forceinline__ void nat_unit(Frame& F, int layer, int b, int h, int rq) {
    const int lane = F.lane, q32 = lane & 31, hi = lane >> 5;
    const int wrow0 = 4 * rq + 2 * (F.wave >> 2), c0 = 16 * (F.wave & 3);
    const int w0 = c0 < 8 ? 0 : (c0 - 8 > 32 ? 32 : c0 - 8);
    const int my_r = wrow0 + (q32 >> 4), qc = c0 + (q32 & 15); const int row = b * SEQ + 64 * my_r + qc;
    if ((F.G & 63) != 0) { __syncthreads(); LAS float* rp = (LAS float*)(F.lds + ATT_RPB); const float* src = F.in[16] + ((size_t)layer * 8 + h) * 465; for (int i = F.tid; i < 465; i += NTHR) rp[i] = src[i] * LOG2E; }
    const int r_lo = 4 * rq, r_hi = 4 * rq + 3;
    const int kr0 = r_lo < 4 ? 0 : (r_lo > 28 ? 24 : r_lo - 4); const int krl = (r_hi < 4 ? 0 : (r_hi > 28 ? 24 : r_hi - 4)) + 7;
    const int nloc = krl - kr0 + 1;
    bf16x8 qf[4]; load_qf(((bf16*)(F.ws + WS_U)) + (size_t)row * INC + C_NQ + 64 * h, hi, qf);
    f32x16 o[2]; float m = 0.f, l = 0.f;
#pragma unroll
    for (int d = 0; d < 2; ++d)
#pragma unroll
        for (int r = 0; r < 16; ++r) o[d][r] = 0.f;
    attn_pass<64, true>(F, ((bf16*)(F.ws + WS_VTN)) + (size_t)((b * 8 + h) * 64) * KEYS, C_NK + 64 * h, nloc, b * SEQ + 64 * kr0, NCTX + 64 * kr0, 4, T_LAT + b * NCTX, 0, qf, o, m, l, my_r, kr0, qc, __builtin_amdgcn_readfirstlane(wrow0), __builtin_amdgcn_readfirstlane(w0));
    l += sx(l, 32); const float il = 1.0f / l;
    bf16* dst = ((bf16*)(F.ws + WS_YC)) + (size_t)row * DB + 64 * h;
#pragma unroll
    for (int d = 0; d < 2; ++d)
#pragma unroll
        for (int rp = 0; rp < 2; ++rp) { unsigned wx[2], wy[2];
#pragma unroll
            for (int k = 0; k < 2; ++k) { const int r4 = 2 * rp + k; wx[k] = pk2(o[d][4 * r4] * il, o[d][4 * r4 + 1] * il); wy[k] = pk2(o[d][4 * r4 + 2] * il, o[d][4 * r4 + 3] * il); }
            swap32(wx[0], wx[1]); swap32(wy[0], wy[1]);
            *(u32x4*)(dst + 32 * d + 16 * rp + 8 * hi) = (u32x4){wx[0], wy[0], wx[1], wy[1]}; }
}
__device__ __forceinline__ void natctx_unit(Frame& F, int b, int h) {
    const int lane = F.lane, q32 = lane & 31, hi = lane >> 5; const int row = T_LAT + b * NCTX + F.wave * 32 + q32;
    bf16x8 qf[4]; load_qf(((bf16*)(F.ws + WS_U)) + (size_t)row * INC + C_NQ + 64 * h, hi, qf);
    f32x16 o[2]; float m = 0.f, l = 0.f;
#pragma unroll
    for (int d = 0; d < 2; ++d)
#pragma unroll
        for (int r = 0; r < 16; ++r) o[d][r] = 0.f;
    attn_pass<64, false>(F, ((bf16*)(F.ws + WS_VTN)) + (size_t)((b * 8 + h) * 64) * KEYS, C_NK + 64 * h, 4, T_LAT + b * NCTX, 0, 0, 0, 0, qf, o, m, l, 0, 0, 0);
    l += sx(l, 32); const float il = 1.0f / l;
    bf16* dst = ((bf16*)(F.ws + WS_YC)) + (size_t)row * DB + 64 * h;
#pragma unroll
    for (int d = 0; d < 2; ++d)
#pragma unroll
        for (int rp = 0; rp < 2; ++rp) { unsigned wx[2], wy[2];
#pragma unroll
            for (int k = 0; k < 2; ++k) { const int r4 = 2 * rp + k; wx[k] = pk2(o[d][4 * r4] * il, o[d][4 * r4 + 1] * il); wy[k] = pk2(o[d][4 * r4 + 2] * il, o[d][4 * r4 + 3] * il); }
            swap32(wx[0], wx[1]); swap32(wy[0], wy[1]);
            *(u32x4*)(dst + 32 * d + 16 * rp + 8 * hi) = (u32x4){wx[0], wy[0], wx[1], wy[1]}; }
}

constexpr int N_PHASES = 2 + 8 * DEPTH;
struct Args { const float* in[29]; float* out; unsigned char* ws; int ph_lo, ph_hi; };
__global__ void diag_nan_scan(const float* out, unsigned* res) {
    const int row = blockIdx.x; bool bad = false;
    for (int c = threadIdx.x; c < DM; c += blockDim.x) { const float v = out[(size_t)row * DM + c]; if (!(fabsf(v) < 3.0e38f)) bad = true; }
    if (__syncthreads_or(bad) && threadIdx.x == 0) { atomicAdd(&res[0], 1u); atomicMin(&res[1], (unsigned)row); atomicMax(&res[2], (unsigned)row); }
}
__global__ void diag_fill(float* out, const unsigned* res, int which) {
    float c = 0.f; if (which == 0) c = (float)res[0] / 16.f; if (which == 1) c = (float)(res[1] >> 8) + 1.f; if (which == 2) c = (float)(res[2] >> 8) + 1.f; if (which == 3) c = (float)(res[1] & 255) + 1.f;
    for (size_t i = (size_t)blockIdx.x * blockDim.x + threadIdx.x; i < (size_t)T_LAT * DM; i += (size_t)gridDim.x * blockDim.x) out[i] = c;
}
#ifndef DIAG_MODE
#define DIAG_MODE 34
#endif
__global__ void diag_copy_kernel(const unsigned char* ws, float* out) {
    for (size_t i = (size_t)blockIdx.x * blockDim.x + threadIdx.x; i < (size_t)T_LAT * DM; i += (size_t)gridDim.x * blockDim.x) {
        const int r = (int)(i >> 10), c = (int)(i & 1023); float v = 0.f;
        if (DIAG_MODE == 0) v = ((const float*)(ws + WS_X))[i];
        if (DIAG_MODE == 1) { const bf16* U = (const bf16*)(ws + WS_U); for (int k = 0; k < 7; ++k) v += bf2f(U[(size_t)r * INC + c + 1024 * k]) + bf2f(U[(size_t)(T_LAT + (r & 4095)) * INC + c + 1024 * k]);
            if (i < (size_t)16 * 4 * 128 * KEYS) v += bf2f(((const bf16*)(ws + WS_VTD))[i]) + bf2f(((const bf16*)(ws + WS_VTN))[i]); }
        if (DIAG_MODE == 2) { v = c < 512 ? bf2f(((const bf16*)(ws + WS_YA))[(size_t)r * DB + c]) + 2.f * bf2f(((const bf16*)(ws + WS_YB))[(size_t)r * DB + c]) : bf2f(((const bf16*)(ws + WS_YC))[(size_t)r * DB + c - 512]);
            v += c < 512 ? bf2f(((const bf16*)(ws + WS_YA))[(size_t)(T_LAT + (r & 4095)) * DB + c]) + 2.f * bf2f(((const bf16*)(ws + WS_YB))[(size_t)(T_LAT + (r & 4095)) * DB + c]) : bf2f(((const bf16*)(ws + WS_YC))[(size_t)(T_LAT + (r & 4095)) * DB + c - 512]); }
        if (DIAG_MODE == 6) { const bf16* U = (const bf16*)(ws + WS_U); for (int k = 4; k < 7; ++k) v += bf2f(U[(size_t)r * INC + c + 1024 * k]) + bf2f(U[(size_t)(T_LAT + (r & 4095)) * INC + c + 1024 * k]); }
        if (DIAG_MODE == 7) { const bf16* U = (const bf16*)(ws + WS_U); const int cc = c & 511; v = bf2f(U[(size_t)r * INC + cc]) + bf2f(U[(size_t)r * INC + 1024 + c]) + bf2f(U[(size_t)r * INC + 2560 + c]) + bf2f(U[(size_t)(T_LAT + (r & 4095)) * INC + cc]) + bf2f(U[(size_t)(T_LAT + (r & 4095)) * INC + 1024 + c]) + bf2f(U[(size_t)(T_LAT + (r & 4095)) * INC + 2560 + c]); }
        if (DIAG_MODE == 8) { const bf16* W = (const bf16*)(ws + WS_WIN); v = bf2f(W[(size_t)(r % 7168) * DM + c]) + bf2f(W[(size_t)(7168 + (r % 7168)) * DM + c]); }
        if (DIAG_MODE == 20) { const unsigned* ctl = (const unsigned*)(ws + WS_CTL); unsigned t = 0; for (int e = 0; e < 32; ++e) t += ctl[CW_ECNT + e * 64]; v = 10.f * (float)t / 147456.f; }
        if (DIAG_MODE == 21) { const bf16* Y = (const bf16*)(ws + WS_YK); float a = 0.f; for (int k = 0; k < 256; ++k) a += fabsf(bf2f(Y[(size_t)k * 500009 + (i & 65535)])); v = 100.f * a / 256.f; }
        if (DIAG_MODE == 22) { const bf16* Y = (const bf16*)(ws + WS_U); float a = 0.f; for (int k = 0; k < 256; ++k) a += fabsf(bf2f(Y[(size_t)k * 500009 + (i & 65535)])); v = 100.f * a / 256.f; }
        if (DIAG_MODE == 23) { const u32x2* L = (const u32x2*)(ws + WS_LIST); float a = 0.f; for (int e = 0; e < 32; ++e) for (int k = 0; k < 8; ++k) a += __builtin_bit_cast(float, L[(size_t)e * LIST_CAP + k * 100].y); v = 100.f * a / 256.f; }
        if (DIAG_MODE == 24) { const u32x2* L = (const u32x2*)(ws + WS_LIST); float a = 0.f; for (int e = 0; e < 32; ++e) for (int k = 0; k < 8; ++k) a += (L[(size_t)e * LIST_CAP + k * 100].x < 131072u) ? 1.f : 0.f; v = 10.f * a / 256.f; }
        if (DIAG_MODE == 25) { const unsigned short* Y = (const unsigned short*)(ws + WS_YK); float a = 0.f; for (int k = 0; k < 256; ++k) a += (Y[(size_t)k * 500009 + (i & 65535)] != 0xAAAAu) ? 1.f : 0.f; v = 10.f * a / 256.f; }
        if (DIAG_MODE == 27) { const u32x2* L = (const u32x2*)(ws + WS_LIST); float a = 0.f; for (int e = 0; e < 32; ++e) for (int k = 0; k < 8; ++k) a += (float)(L[(size_t)e * LIST_CAP + k * 100].y >> 20); v = a / 256.f; }
        if (DIAG_MODE == 28) { const u32x2* L = (const u32x2*)(ws + WS_LIST); float a = 0.f; for (int e = 0; e < 32; ++e) for (int k = 0; k < 8; ++k) { const float w = __builtin_bit_cast(float, L[(size_t)e * LIST_CAP + k * 100].y); a += (w > 0.01f && w < 1.0f) ? 1.f : 0.f; } v = a / 25.6f; }
        if (DIAG_MODE == 29) { const u32x2* L = (const u32x2*)(ws + WS_LIST); float a = 0.f; for (int e = 0; e < 32; ++e) for (int k = 0; k < 8; ++k) a += ((L[(size_t)e * LIST_CAP + k * 100].y >> 20) > 2000u) ? 1.f : 0.f; v = a / 25.6f; }
        if (DIAG_MODE == 31) { const u32x2* L = (const u32x2*)(ws + WS_LIST); v = 100.f * __builtin_bit_cast(float, L[5].y); }
        if (DIAG_MODE == 32) { const u32x2* L = (const u32x2*)(ws + WS_LIST); v = (float)(L[5].y >> 20); }
        if (DIAG_MODE == 33) { v = 25.f; }
        if (DIAG_MODE == 34) { const u32x2* L = (const u32x2*)(ws + WS_LIST); const unsigned y = L[5].y; v = (y > 0x3C000000u && y < 0x3F800001u) ? 25.f : ((y >> 20) < 944u ? 50.f : 75.f); }
        if (DIAG_MODE == 3) { const bf16* Z = (const bf16*)(ws + WS_MB); v = bf2f(Z[(size_t)r * DM + c]);
#if !defined(DIAG_ONEJ)
 v += bf2f(Z[(size_t)r * 3072 + 1024 + c]) + bf2f(Z[(size_t)r * 3072 + 2048 + c]);
#endif
 }
        if (DIAG_MODE == 4) v = ((const float*)(ws + WS_MV))[i];
        if (DIAG_MODE == 5) v = bf2f(((const bf16*)(ws + WS_H))[i]);
        out[i] = v; }
}
#ifndef PHASE_MASK
#define PHASE_MASK 0xffffffffu
#endif
#define PMASK(k) ((PHASE_MASK >> (((k) < 2) ? (k) : 2 + (((k) - 2) & 7))) & 1u)
#define IN(k) (PMASK(k) && lo <= (k) && (k) < hi)
#define LAUNDER() do { int wv_ = F.wave0; asm volatile("" : "+s"(wv_)); const int t_ = (wv_ << 6) | lane_now(); F.tid = t_; F.lane = t_ & 63; F.wave = wv_; unsigned char* w_ = args.ws; asm volatile("" : "+s"(w_)); F.ws = (GAS unsigned char*)w_; F.ctl = (gu32*)(w_ + WS_CTL); unsigned long long z_ = 0; asm volatile("" : "+s"(z_)); F.in = args.in + z_; int b_ = blockIdx.x, g_ = gridDim.x; asm volatile("" : "+s"(b_), "+s"(g_)); F.bid = b_; F.G = g_; } while (0)
#define SEAM(k) do { if (IN(k) && IN((k) + 1)) xcd_barrier(bar); } while (0)
template <int layer>
__device__ __forceinline__ void layer_phases(Frame& F, const Args& args, const XcdBarrier& bar, const int lo, const int hi, const int vcu) {
        const int pb = 2 + 8 * layer;
        const bool with_ctx = layer < DEPTH - 1;
        const int nrows = with_ctx ? T_ALL : T_LAT;
        if (IN(pb + 0)) { LAUNDER();
            pg8::StaticOrder S; S.init_bytes((unsigned char*)(F.ws + WS_H8), DM, (unsigned char*)(F.ws + WS_WIN) + (size_t)layer * INC * DM, DM, T_ALL, INC, F.G, F.bid);
            EpiWin E{F.ws, W8_INV};
            pg8::gemm_phase<EpiWin, pg8::StaticOrder, true>(F.lds, F.wave, DM, DM, S, E);
        } SEAM(pb + 0);
        if (IN(pb + 1)) { LAUNDER();
#ifndef UNIT_MASK
#define UNIT_MASK 15
#endif
            const int nsq = with_ctx ? 576 : 512;
            const float lam_init = 0.8f - 0.6f * expf(-0.3f * (float)layer);
            const float lam = expf(wave_sum(F.in[11][layer * 64 + F.lane] * F.in[12][layer * 64 + F.lane])) - expf(wave_sum(F.in[13][layer * 64 + F.lane] * F.in[14][layer * 64 + F.lane])) + lam_init;
            if (UNIT_MASK & 1) for (int u = vcu; u < nsq; u += F.G) { const bool lat = u < 512; const int b = lat ? (u >> 5) : ((u - 512) >> 2), h = lat ? ((u >> 3) & 3) : ((u - 512) & 3);
                diff_unit(F, layer, b, h, lat ? b * SEQ + (u & 7) * 256 : T_LAT + b * NCTX, lat, lam, lam_init); }
            { __syncthreads(); LAS float* rp = (LAS float*)(F.lds + ATT_RPB); const float* src = F.in[16] + ((size_t)layer * 8 + ((vcu >> 3) & 7)) * 465; for (int i = F.tid; i < 465; i += NTHR) rp[i] = src[i] * LOG2E; }
            if (UNIT_MASK & 2) for (int u = vcu; u < 1024; u += F.G) nat_unit(F, layer, u >> 6, (u >> 3) & 7, u & 7);
            if (UNIT_MASK & 4) conv_units(F, layer, 2 * nsq);
            if ((UNIT_MASK & 8) && with_ctx) {
                if (F.G == 256) { const int m8 = F.bid & 7; if (m8 >= 6) { const int e2 = 2 * ((m8 - 6) * 32 + (F.bid >> 3)); natctx_unit(F, e2 >> 3, e2 & 7); natctx_unit(F, (e2 + 1) >> 3, (e2 + 1) & 7); } }
                else for (int u = F.bid; u < 128; u += F.G) natctx_unit(F, u >> 3, u & 7); }
            __syncthreads();
        } SEAM(pb + 1);
        if (IN(pb + 2)) { LAUNDER();
            MergeOrder S; S.Y = (const char*)(F.ws + WS_YA); S.W = (const char*)(((bf16*)(F.ws + WS_WBR)) + (size_t)layer * 3 * DM * DB); S.T.init(nullptr, DB, nullptr, DB, nrows, DM, F.G, F.bid);
            EpiMB E{((bf16*)(F.ws + WS_U)), ((bf16*)(F.ws + WS_MB))};
            pg8::gemm_phase<EpiMB, MergeOrder>(F.lds, F.wave, DB * 2, DB * 2, S, E);
            if (layer == 0 && F.G == 256 && F.bid >= 64) convert_items(F, CV_LAYER + CV_P0_L1, CV_LAYER + CV_P0_L1 + CV_SLOT_A, (F.bid - 64) * NWAVES + F.wave, 192 * NWAVES);
        } SEAM(pb + 2);
        if (IN(pb + 3)) { LAUNDER();
            pg8::StaticOrder S; S.init(((bf16*)(F.ws + WS_MB)), DM, ((bf16*)(F.ws + WS_WOUT)) + (size_t)layer * DM * DM, DM, nrows, DM, F.G, F.bid);
            EpiWout E{((float*)(F.ws + WS_MOD)) + (size_t)layer * 17 * 6144 + 2048, ((bf16*)(F.ws + WS_MV))};
            pg8::gemm_phase<EpiWout, pg8::StaticOrder>(F.lds, F.wave, DM * 2, DM * 2, S, E);
            if (layer == 0 && F.G == 256 && F.bid >= 64) convert_items(F, CV_LAYER + CV_P0_L1 + CV_SLOT_A, 2 * CV_LAYER, (F.bid - 64) * NWAVES + F.wave, 192 * NWAVES);
        } SEAM(pb + 3);
        if (IN(pb + 4)) { LAUNDER(); p5_ln1_router(F, layer, nrows); } SEAM(pb + 4);
        if (IN(pb + 5)) { LAUNDER();
            moe_build_tiles(F, layer, 8, true);
            MoeSched1 S{(const char*)(F.ws + WS_H8), (const char*)(F.ws + WS_W1 + (size_t)layer * NE * 2048 * DM), (LAS const int*)(F.lds + TILE_OFF), (LAS const unsigned short*)(F.lds + IDX_OFF), (int)F.MISC[MI_NUNITS]};
            EpiMoe1 E{(unsigned char*)(F.ws + WS_U), F.in[24] + (size_t)layer * NE * 2048};
            pg8::gemm_phase<EpiMoe1, MoeSched1, true>(F.lds, F.wave, DM, DM, S, E);
        } SEAM(pb + 5);
        if (IN(pb + 6)) { LAUNDER();
            moe_build_tiles(F, layer, 4, false);
            MoeSched2 S{(const char*)(F.ws + WS_U), (const char*)(F.ws + WS_W2 + (size_t)layer * NE * DM * DFF), (LAS const int*)(F.lds + TILE_OFF), (int)F.MISC[MI_NUNITS]};
            EpiMoe2 E{(unsigned char*)(F.ws + WS_YK), F.in[26] + (size_t)layer * NE * DM, ((u32x2*)(F.ws + WS_LIST))};
            pg8::gemm_phase<EpiMoe2, MoeSched2, true>(F.lds, F.wave, DFF, DFF, S, E);
        } SEAM(pb + 6);
        if (IN(pb + 7)) { LAUNDER(); p8_final(F, layer, nrows); } SEAM(pb + 7);
    }
__global__ void __launch_bounds__(NTHR, 2) fwd_kernel(Args args) {
    extern __shared__ __attribute__((aligned(16))) unsigned char lds_raw[];
    asm volatile("s_nop 0\n\ts_nop 0\n\ts_nop 0\n\ts_nop 0\n\ts_nop 0\n\ts_nop 0\n\ts_nop 0\n\ts_nop 0");
    Frame F;
    F.lds = (LAS unsigned char*)lds_raw;
    F.MISC = (volatile LAS unsigned*)(F.lds + MISC_OFF);
    F.tid = threadIdx.x; F.lane = F.tid & 63; F.wave = __builtin_amdgcn_readfirstlane(F.tid >> 6); F.wave0 = F.wave; F.G = gridDim.x; F.bid = blockIdx.x;
    unsigned char* ws = args.ws;
    F.ctl = (gu32*)(ws + WS_CTL);
    F.in = args.in; F.out = (GAS float*)args.out; F.ws = (GAS unsigned char*)ws;
    for (int u = F.tid; u < (LDS_BYTES - MISC_OFF) / 4; u += NTHR) ((LAS unsigned*)(F.lds + MISC_OFF))[u] = 0u;
    __syncthreads();
    const int lo = args.ph_lo, hi = args.ph_hi;
    XcdBarrier bar; bar.bar = (unsigned*)(F.ctl + CW_BAR); bar.x = 0; bar.st = nullptr; bar.w0 = F.wave0;
    if (hi - lo > 1) { bar = xcd_barrier_post((unsigned*)(F.ctl + CW_BAR), F.MISC + MI_BAR); bar.w0 = F.wave0; }
    const int vcu = (F.G % 8 == 0) ? (F.bid % 8) * (F.G / 8) + F.bid / 8 : F.bid;

    if (IN(0)) { LAUNDER(); p0_prologue(F); } SEAM(0);
    if (IN(1)) { LAUNDER(); p1_modulate0(F); } SEAM(1);

    layer_phases<0>(F, args, bar, lo, hi, vcu);
    layer_phases<1>(F, args, bar, lo, hi, vcu);
#undef IN
#undef SEAM
}

extern "C" void kernel_launch(void* const* d_in, const int* in_sizes, int n_in, void* d_out, int out_size, void* d_ws, size_t ws_size, hipStream_t stream) {
    static int grid = 0;
    if (grid == 0) {
        if (n_in != 29 || out_size != T_LAT * DM || ws_size < WS_END) { fprintf(stderr, "kernel_launch: unexpected shapes (n_in %d out %d ws %zu need %zu)\n", n_in, out_size, ws_size, (size_t)WS_END); grid = -1; return; }
        int dev = 0, cus = 0, per_cu = 0;
        if (hipGetDevice(&dev) != hipSuccess || hipDeviceGetAttribute(&cus, hipDeviceAttributeMultiprocessorCount, dev) != hipSuccess) { grid = -1; return; }
        if (hipFuncSetAttribute((const void*)fwd_kernel, hipFuncAttributeMaxDynamicSharedMemorySize, LDS_BYTES) != hipSuccess) { fprintf(stderr, "kernel_launch: hipFuncSetAttribute failed\n"); grid = -1; return; }
        if (hipOccupancyMaxActiveBlocksPerMultiprocessor(&per_cu, (const void*)fwd_kernel, NTHR, LDS_BYTES) != hipSuccess || per_cu < 1) fprintf(stderr, "kernel_launch: occupancy query reports %d\n", per_cu);
        (void)hipGetLastError();
        grid = cus < 256 ? cus : 256;
        if (grid != 256) fprintf(stderr, "kernel_launch: %d CUs; this kernel is sized for 256\n", cus);
    }
    if (grid < 0) return;
    if (hipMemsetAsync((char*)d_ws + WS_CTL, 0, CTL_ZERO_BYTES, stream) != hipSuccess) return;
    Args a{};
    for (int i = 0; i < 29; ++i) a.in[i] = (const float*)d_in[i];
    a.out = (float*)d_out; a.ws = (unsigned char*)d_ws;
#if MK_ONE_LAUNCH
    a.ph_lo = 0; a.ph_hi = N_PHASES;
    hipLaunchKernelGGL(fwd_kernel, dim3(grid), dim3(NTHR), LDS_BYTES, stream, a);
#else
    const int np = DIAG_STOP ? DIAG_STOP : N_PHASES;
    for (int p = 0; p < np; ++p) { a.ph_lo = p; a.ph_hi = p + 1; hipLaunchKernelGGL(fwd_kernel, dim3(grid), dim3(NTHR), LDS_BYTES, stream, a); }
#ifdef DIAG_NAN
    { unsigned* res = (unsigned*)((char*)d_ws + 512 * 1024); hipMemsetAsync(res, 0, 4, stream); hipMemsetAsync(res + 1, 0xFF, 4, stream); hipMemsetAsync(res + 2, 0, 4, stream);
      hipLaunchKernelGGL(diag_nan_scan, dim3(T_LAT), dim3(256), 0, stream, (const float*)d_out, res);
      hipLaunchKernelGGL(diag_fill, dim3(2048), dim3(256), 0, stream, (float*)d_out, (const unsigned*)res, DIAG_NAN); }
#endif
    if (DIAG_STOP) hipLaunchKernelGGL(diag_copy_kernel, dim3(2048), dim3(256), 0, stream, (const unsigned char*)d_ws, (float*)d_out);
#endif
}
```
